# Optimizing an MI355X kernel written in HIP

```python
import jax, jax.numpy as jnp
from jax import lax
import numpy as np

D_MODEL = 1024
BATCH = 4
SEQ = 4096
DEPTH = 4
DEC_BATCH = 128
DEC_SEQ = 8
PAST_LEN = 2048
PAGE_SIZE = 128

N_MIXERS = 2
N_GDN = (DEPTH + 1) // 2
N_NSA = DEPTH // 2
GDN_HEADS = 8
GDN_DK = 128
GDN_DV = 128
GDN_CONV = 4
GDN_CHUNK = 64
GDN_QKV = GDN_HEADS * (2 * GDN_DK + GDN_DV)
GDN_IN = GDN_QKV + GDN_HEADS * GDN_DV + 2 * GDN_HEADS
NSA_HEADS = 16
NSA_KV_GROUPS = 2
NSA_HPG = NSA_HEADS // NSA_KV_GROUPS
NSA_DH = 64
NSA_KV_DIM = NSA_KV_GROUPS * NSA_DH
CMP_LEN = 32
CMP_STRIDE = 16
CMP_HID = 256
SEL_BLOCK = 64
SEL_TOP = 16
WINDOW = 512
Q_BLOCK = 128
NSA_IN = NSA_HEADS * NSA_DH + 6 * NSA_KV_DIM + 3 * NSA_HEADS
D_FF = ((-(-8 * D_MODEL // 3) + 255) // 256) * 256
RMS_EPS = 1e-6
L2_EPS = 1e-6
NEG_BIG = -1e30

kernel_name = 'hybrid_gdn_nsa_decoder_step'


def rmsnorm(x, w):
    xf = x.astype(jnp.float32)
    y = xf * lax.rsqrt(jnp.mean(xf * xf, axis=-1, keepdims=True) + RMS_EPS)
    return (y * w.astype(jnp.float32)).astype(x.dtype)


def l2norm(x):
    xf = x.astype(jnp.float32)
    return xf * lax.rsqrt(jnp.sum(xf * xf, axis=-1, keepdims=True) + L2_EPS)


def masked_softmax(s, mask):
    p = jax.nn.softmax(jnp.where(mask, s, NEG_BIG), axis=-1)
    return jnp.where(mask, p, 0.0)


def swiglu_ffn(x, w_in, w_out):
    g, u = jnp.split(x @ w_in, 2, axis=-1)
    return (jax.nn.silu(g) * u) @ w_out


def causal_short_conv(x, buf, w):
    xp = jnp.concatenate([buf, x], axis=1)
    T = x.shape[1]
    y = xp[:, 0:T] * w[0]
    for i in range(1, GDN_CONV):
        y = y + xp[:, i:i + T] * w[i]
    return jax.nn.silu(y), xp[:, T:]


def gated_delta_chunked(q, k, v, log_a, beta, S0, chunk):
    B, T, H, dk = q.shape
    dv = v.shape[-1]
    n = T // chunk

    def to_chunks(t):
        t = t.reshape((B, n, chunk, H) + t.shape[3:])
        return jnp.moveaxis(t, (1, 3), (0, 2))

    tri = jnp.tril(jnp.ones((chunk, chunk), bool))
    strict = jnp.tril(jnp.ones((chunk, chunk), bool), -1)
    eye = jnp.eye(chunk, dtype=jnp.float32)

    def step(S, inp):
        qc, kc, vc, gc, bc = inp
        G = jnp.cumsum(gc, axis=-1)
        decay = jnp.exp(jnp.where(tri, G[..., :, None] - G[..., None, :], -jnp.inf))
        lmat = jnp.where(strict, bc[..., :, None] * jnp.einsum('bhik,bhjk->bhij', kc, kc) * decay, 0.0)
        eg = jnp.exp(G)
        rhs = bc[..., None] * (vc - eg[..., None] * jnp.einsum('bhck,bhkv->bhcv', kc, S))
        u = lax.linalg.triangular_solve(eye + lmat, rhs, left_side=True, lower=True, unit_diagonal=True)
        o = eg[..., None] * jnp.einsum('bhck,bhkv->bhcv', qc, S) + jnp.einsum(
            'bhij,bhjv->bhiv', jnp.einsum('bhik,bhjk->bhij', qc, kc) * decay, u)
        tail = jnp.exp(G[..., -1:] - G)
        S_new = jnp.exp(G[..., -1])[..., None, None] * S + jnp.einsum('bhck,bhcv->bhkv', kc * tail[..., None], u)
        return S_new, o

    S, o = lax.scan(step, S0, (to_chunks(q), to_chunks(k), to_chunks(v), to_chunks(log_a), to_chunks(beta)))
    o = jnp.moveaxis(o, (0, 2), (1, 3)).reshape(B, T, H, dv)
    return o, S


def gdn_mixer(x, S0, conv_buf, chunk, w_in, conv_w, A_log, dt_bias, norm_w, w_out):
    B, T, _ = x.shape
    h = x @ w_in
    z_end = GDN_QKV + GDN_HEADS * GDN_DV
    qkv, z, b, a = jnp.split(h, [GDN_QKV, z_end, z_end + GDN_HEADS], axis=-1)
    qkv, new_buf = causal_short_conv(qkv, conv_buf, conv_w)
    q, k, v = jnp.split(qkv, [GDN_HEADS * GDN_DK, 2 * GDN_HEADS * GDN_DK], axis=-1)
    q = l2norm(q.reshape(B, T, GDN_HEADS, GDN_DK)) * GDN_DK ** -0.5
    k = l2norm(k.reshape(B, T, GDN_HEADS, GDN_DK))
    v = v.reshape(B, T, GDN_HEADS, GDN_DV).astype(jnp.float32)
    beta = jax.nn.sigmoid(b.astype(jnp.float32))
    log_a = -jnp.exp(A_log.astype(jnp.float32)) * jax.nn.softplus(a.astype(jnp.float32) + dt_bias.astype(jnp.float32))
    o, S = gated_delta_chunked(q, k, v, log_a, beta, S0.astype(jnp.float32), chunk)
    o = rmsnorm(o, norm_w) * jax.nn.silu(z.reshape(B, T, GDN_HEADS, GDN_DV).astype(jnp.float32))
    o = o.reshape(B, T, GDN_HEADS * GDN_DV).astype(x.dtype) @ w_out
    return o, S.astype(S0.dtype), new_buf


def nsa_project(x, w_in):
    B, T, _ = x.shape
    h = x @ w_in
    qd = NSA_HEADS * NSA_DH
    q = h[..., :qd].reshape(B, T, NSA_HEADS, NSA_DH) * NSA_DH ** -0.5
    kv = h[..., qd:qd + 4 * NSA_KV_DIM].reshape(B, T, 4, NSA_KV_GROUPS, NSA_DH)
    win = h[..., qd + 4 * NSA_KV_DIM:qd + 6 * NSA_KV_DIM].reshape(B, T, 2, NSA_KV_GROUPS, NSA_DH)
    gates = jax.nn.sigmoid(h[..., qd + 6 * NSA_KV_DIM:])
    return q, kv, win, gates


def compress_blocks(kv, pe, w1, w2):
    B, L = kv.shape[:2]
    n = (L - CMP_LEN) // CMP_STRIDE + 1
    idx = jnp.arange(n)[:, None] * CMP_STRIDE + jnp.arange(CMP_LEN)[None, :]
    blk = kv[:, idx] + pe[:, None, :]
    blk = jnp.moveaxis(blk, 3, 2).reshape(B, n, NSA_KV_GROUPS, CMP_LEN * NSA_DH)
    return jax.nn.silu(blk @ w1) @ w2


def selection_blocks(k):
    B, L = k.shape[:2]
    n_sel = -(-L // SEL_BLOCK)
    k = jnp.pad(k, ((0, 0), (0, n_sel * SEL_BLOCK - L), (0, 0), (0, 0)))
    return jnp.transpose(k.reshape(B, n_sel, SEL_BLOCK, NSA_KV_GROUPS, NSA_DH), (0, 3, 1, 2, 4))


def cmp_to_sel_overlap(n_cmp, n_sel):
    cs = jnp.arange(n_cmp)[:, None] * CMP_STRIDE
    ss = jnp.arange(n_sel)[None, :] * SEL_BLOCK
    return ((cs < ss + SEL_BLOCK) & (cs + CMP_LEN > ss)).astype(jnp.float32)


def branch_keys(kv_rows, pe_k, pe_v, w1k, w2k, w1v, w2v):
    kc = compress_blocks(kv_rows[:, :, 0], pe_k, w1k, w2k)
    vc = compress_blocks(kv_rows[:, :, 1], pe_v, w1v, w2v)
    k_sel = selection_blocks(kv_rows[:, :, 2])
    v_sel = selection_blocks(kv_rows[:, :, 3])
    overlap = cmp_to_sel_overlap(kc.shape[1], k_sel.shape[2])
    return kc, vc, k_sel, v_sel, overlap


def nsa_attend(q, q_pos, kc, vc, k_sel, v_sel, overlap, k_win, v_win, win_pos, gates):
    B, Tq = q.shape[:2]
    qg = q.reshape(B, Tq, NSA_KV_GROUPS, NSA_HPG, NSA_DH)
    cmp_end = jnp.arange(kc.shape[1]) * CMP_STRIDE + CMP_LEN - 1
    m_c = cmp_end[None, :] <= q_pos[:, None]
    s_c = jnp.einsum('bqghd,bngd->bghqn', qg, kc).astype(jnp.float32)
    p_c = masked_softmax(s_c, m_c)
    o_c = jnp.einsum('bghqn,bngd->bqghd', p_c.astype(vc.dtype), vc)
    n_sel = k_sel.shape[2]
    imp = jnp.einsum('bghqn,nj->bgqj', p_c, overlap)
    cur = q_pos // SEL_BLOCK
    j = jnp.arange(n_sel)[None, :]
    forced = (j == 0) | (j == cur[:, None]) | (j == cur[:, None] - 1)
    score = jnp.where(j > cur[:, None], -jnp.inf, jnp.where(forced, jnp.inf, imp))
    _, idx = lax.top_k(score, min(SEL_TOP, n_sel))
    n_top = idx.shape[-1]
    b_ix = jnp.arange(B)[:, None, None, None]
    g_ix = jnp.arange(NSA_KV_GROUPS)[None, :, None, None]
    ks = k_sel[b_ix, g_ix, idx].reshape(B, NSA_KV_GROUPS, Tq, n_top * SEL_BLOCK, NSA_DH)
    vs = v_sel[b_ix, g_ix, idx].reshape(B, NSA_KV_GROUPS, Tq, n_top * SEL_BLOCK, NSA_DH)
    pos = (idx[..., None] * SEL_BLOCK + jnp.arange(SEL_BLOCK)).reshape(B, NSA_KV_GROUPS, Tq, n_top * SEL_BLOCK)
    m_s = (pos <= q_pos[:, None])[:, :, None]
    s_s = jnp.einsum('bqghd,bgqkd->bghqk', qg, ks).astype(jnp.float32)
    p_s = masked_softmax(s_s, m_s)
    o_s = jnp.einsum('bghqk,bgqkd->bqghd', p_s.astype(vs.dtype), vs)
    m_w = (win_pos[None, :] <= q_pos[:, None]) & (win_pos[None, :] >= q_pos[:, None] - WINDOW) & (win_pos[None, :] >= 0)
    s_w = jnp.einsum('bqghd,bkgd->bghqk', qg, k_win).astype(jnp.float32)
    p_w = masked_softmax(s_w, m_w)
    o_w = jnp.einsum('bghqk,bkgd->bqghd', p_w.astype(v_win.dtype), v_win)
    g = gates.reshape(B, Tq, NSA_KV_GROUPS, NSA_HPG, 3)
    o = g[..., 0:1] * o_c + g[..., 1:2] * o_s + g[..., 2:3] * o_w
    return o.reshape(B, Tq, NSA_HEADS * NSA_DH)


def nsa_prompt(x, win_buf_len, w_in, pe_k, pe_v, w1k, w2k, w1v, w2v, w_out):
    B, T, _ = x.shape
    q, kv_rows, win_rows, gates = nsa_project(x, w_in)
    kc, vc, k_sel, v_sel, overlap = branch_keys(kv_rows, pe_k, pe_v, w1k, w2k, w1v, w2v)
    zpad = jnp.zeros((B, WINDOW, NSA_KV_GROUPS, NSA_DH), x.dtype)
    kw_pad = jnp.concatenate([zpad, win_rows[:, :, 0]], axis=1)
    vw_pad = jnp.concatenate([zpad, win_rows[:, :, 1]], axis=1)
    nb = T // Q_BLOCK
    qb = jnp.moveaxis(q.reshape(B, nb, Q_BLOCK, NSA_HEADS, NSA_DH), 1, 0)
    gb = jnp.moveaxis(gates.reshape(B, nb, Q_BLOCK, 3 * NSA_HEADS), 1, 0)

    def block(inp):
        qi, gi, i = inp
        start = i * Q_BLOCK
        q_pos = start + jnp.arange(Q_BLOCK)
        kw = lax.dynamic_slice_in_dim(kw_pad, start, WINDOW + Q_BLOCK, axis=1)
        vw = lax.dynamic_slice_in_dim(vw_pad, start, WINDOW + Q_BLOCK, axis=1)
        win_pos = start - WINDOW + jnp.arange(WINDOW + Q_BLOCK)
        return nsa_attend(qi, q_pos, kc, vc, k_sel, v_sel, overlap, kw, vw, win_pos, gi)

    o = lax.map(block, (qb, gb, jnp.arange(nb)))
    o = jnp.moveaxis(o, 0, 1).reshape(B, T, NSA_HEADS * NSA_DH) @ w_out
    wbuf = jnp.concatenate([jnp.zeros((B, win_buf_len, 2, NSA_KV_GROUPS, NSA_DH), x.dtype), win_rows], axis=1)[:, T:]
    return o, kv_rows, wbuf


def nsa_sample(x, kv_pool, win_cache, page_table, w_in, pe_k, pe_v, w1k, w2k, w1v, w2v, w_out):
    B, T, _ = x.shape
    q, kv_new, win_new, gates = nsa_project(x, w_in)
    past = kv_pool[page_table]
    past = past.reshape((B, -1) + past.shape[3:])
    past_len = past.shape[1]
    kv_all = jnp.concatenate([past, kv_new], axis=1)
    kc, vc, k_sel, v_sel, overlap = branch_keys(kv_all, pe_k, pe_v, w1k, w2k, w1v, w2v)
    win_all = jnp.concatenate([win_cache, win_new], axis=1)
    win_buf_len = win_cache.shape[1]
    win_pos = past_len - win_buf_len + jnp.arange(win_buf_len + T)
    q_pos = past_len + jnp.arange(T)
    o = nsa_attend(q, q_pos, kc, vc, k_sel, v_sel, overlap, win_all[:, :, 0], win_all[:, :, 1], win_pos, gates)
    return o @ w_out, kv_new, win_all[:, T:]


def setup_inputs(seed: int = 0) -> dict:
    key = jax.random.key(seed)
    ks = jax.random.split(key, 32)
    f32 = jnp.float32
    n_pages = PAST_LEN // PAGE_SIZE
    n_phys = (DEC_BATCH * n_pages * 5) // 4
    win_buf = min(WINDOW, PAST_LEN)

    def nrm(k, shape, scale):
        return jax.random.normal(k, shape, f32) * scale

    dt = jnp.exp(jax.random.uniform(ks[10], (N_GDN, GDN_HEADS), f32, np.log(1e-3), np.log(1e-1)))
    page_table = jax.random.permutation(ks[6], n_phys)[:DEC_BATCH * n_pages].reshape(DEC_BATCH, n_pages).astype(jnp.int32)
    return {
        'x_prompt': nrm(ks[0], (BATCH, SEQ, D_MODEL), 1.0),
        'x_sample': nrm(ks[1], (DEC_BATCH, DEC_SEQ, D_MODEL), 1.0),
        'cache_nsa_kv': nrm(ks[2], (N_NSA, n_phys, PAGE_SIZE, 4, NSA_KV_GROUPS, NSA_DH), 1.0),
        'cache_nsa_win': nrm(ks[3], (N_NSA, DEC_BATCH, win_buf, 2, NSA_KV_GROUPS, NSA_DH), 1.0),
        'state_gdn': nrm(ks[4], (N_GDN, DEC_BATCH, GDN_HEADS, GDN_DK, GDN_DV), 0.1),
        'state_gdn_conv': nrm(ks[5], (N_GDN, DEC_BATCH, GDN_CONV - 1, GDN_QKV), 1.0),
        'page_table': page_table,
        'norm1_w': 1.0 + nrm(ks[7], (DEPTH, D_MODEL), 0.02),
        'norm2_w': 1.0 + nrm(ks[8], (DEPTH, D_MODEL), 0.02),
        'final_norm_w': 1.0 + nrm(ks[9], (D_MODEL,), 0.02),
        'gdn_w_in': nrm(ks[11], (N_GDN, D_MODEL, GDN_IN), D_MODEL ** -0.5),
        'gdn_conv_w': nrm(ks[12], (N_GDN, GDN_CONV, GDN_QKV), GDN_CONV ** -0.5),
        'gdn_A_log': jnp.log(jax.random.uniform(ks[13], (N_GDN, GDN_HEADS), f32, 1.0, 16.0)),
        'gdn_dt_bias': dt + jnp.log(-jnp.expm1(-dt)),
        'gdn_norm_w': 1.0 + nrm(ks[14], (N_GDN, GDN_DV), 0.02),
        'gdn_w_out': nrm(ks[15], (N_GDN, GDN_HEADS * GDN_DV, D_MODEL), (GDN_HEADS * GDN_DV) ** -0.5),
        'nsa_w_in': nrm(ks[16], (N_NSA, D_MODEL, NSA_IN), D_MODEL ** -0.5),
        'nsa_pe_k': nrm(ks[17], (N_NSA, CMP_LEN, NSA_DH), 0.1),
        'nsa_pe_v': nrm(ks[18], (N_NSA, CMP_LEN, NSA_DH), 0.1),
        'nsa_cmp_w1_k': nrm(ks[19], (N_NSA, CMP_LEN * NSA_DH, CMP_HID), (CMP_LEN * NSA_DH) ** -0.5),
        'nsa_cmp_w2_k': nrm(ks[20], (N_NSA, CMP_HID, NSA_DH), CMP_HID ** -0.5),
        'nsa_cmp_w1_v': nrm(ks[21], (N_NSA, CMP_LEN * NSA_DH, CMP_HID), (CMP_LEN * NSA_DH) ** -0.5),
        'nsa_cmp_w2_v': nrm(ks[22], (N_NSA, CMP_HID, NSA_DH), CMP_HID ** -0.5),
        'nsa_w_out': nrm(ks[23], (N_NSA, NSA_HEADS * NSA_DH, D_MODEL), (NSA_HEADS * NSA_DH) ** -0.5),
        'ffn_w_in': nrm(ks[24], (DEPTH, D_MODEL, 2 * D_FF), D_MODEL ** -0.5),
        'ffn_w_out': nrm(ks[25], (DEPTH, D_FF, D_MODEL), D_FF ** -0.5),
    }


def reference(x_prompt, x_sample, cache_nsa_kv, cache_nsa_win, state_gdn, state_gdn_conv, page_table,
              norm1_w, norm2_w, final_norm_w, gdn_w_in, gdn_conv_w, gdn_A_log, gdn_dt_bias, gdn_norm_w, gdn_w_out,
              nsa_w_in, nsa_pe_k, nsa_pe_v, nsa_cmp_w1_k, nsa_cmp_w2_k, nsa_cmp_w1_v, nsa_cmp_w2_v, nsa_w_out,
              ffn_w_in, ffn_w_out):
    xp, xs = x_prompt, x_sample
    bp, tp = xp.shape[:2]
    win_buf_len = cache_nsa_win.shape[2]
    kv_p, kv_s, win_p, win_s = [], [], [], []
    gs_p, gs_s, gc_p, gc_s = [], [], [], []
    for i in range(DEPTH):
        li = i // N_MIXERS
        hp = rmsnorm(xp, norm1_w[i])
        hs = rmsnorm(xs, norm1_w[i])
        if i % N_MIXERS == 0:
            gw = (gdn_w_in[li], gdn_conv_w[li], gdn_A_log[li], gdn_dt_bias[li], gdn_norm_w[li], gdn_w_out[li])
            s0 = jnp.zeros((bp, GDN_HEADS, GDN_DK, GDN_DV), xp.dtype)
            c0 = jnp.zeros((bp, GDN_CONV - 1, GDN_QKV), xp.dtype)
            mp, sp, cp = gdn_mixer(hp, s0, c0, min(GDN_CHUNK, tp), *gw)
            ms, ss, cs = gdn_mixer(hs, state_gdn[li], state_gdn_conv[li], xs.shape[1], *gw)
            gs_p.append(sp)
            gs_s.append(ss)
            gc_p.append(cp)
            gc_s.append(cs)
        else:
            nw = (nsa_w_in[li], nsa_pe_k[li], nsa_pe_v[li], nsa_cmp_w1_k[li], nsa_cmp_w2_k[li],
                  nsa_cmp_w1_v[li], nsa_cmp_w2_v[li], nsa_w_out[li])
            mp, kp, wp = nsa_prompt(hp, win_buf_len, *nw)
            ms, ksm, wsm = nsa_sample(hs, cache_nsa_kv[li], cache_nsa_win[li], page_table, *nw)
            kv_p.append(kp)
            kv_s.append(ksm)
            win_p.append(wp)
            win_s.append(wsm)
        xp = xp + mp
        xs = xs + ms
        xp = xp + swiglu_ffn(rmsnorm(xp, norm2_w[i]), ffn_w_in[i], ffn_w_out[i])
        xs = xs + swiglu_ffn(rmsnorm(xs, norm2_w[i]), ffn_w_in[i], ffn_w_out[i])
    y_prompt = rmsnorm(xp, final_norm_w)
    y_sample = rmsnorm(xs, final_norm_w)
    return (y_prompt, y_sample, jnp.stack(kv_p), jnp.stack(kv_s), jnp.stack(win_p), jnp.stack(win_s),
            jnp.stack(gs_p), jnp.stack(gs_s), jnp.stack(gc_p), jnp.stack(gc_s))
```

```cpp
#include <hip/hip_runtime.h>
#include <cstdio>

#define DI __device__ __forceinline__
#define LAS __attribute__((address_space(3)))
#define GAS __attribute__((address_space(1)))
typedef unsigned short bf16;
typedef short bf16x8 __attribute__((ext_vector_type(8)));
typedef short s16x4 __attribute__((ext_vector_type(4)));
typedef float f32x4 __attribute__((ext_vector_type(4)));
typedef float f32x2 __attribute__((ext_vector_type(2)));
typedef float f32x16 __attribute__((ext_vector_type(16)));
typedef unsigned u32x4 __attribute__((ext_vector_type(4)));
typedef unsigned u32x2 __attribute__((ext_vector_type(2)));

constexpr int DM = 1024, NB = 4, SEQ = 4096, DB = 128, DS = 8, PAST = 2048, PAGE = 128, NPAGE = 16, NPHYS = 2560;
constexpr int MP = NB * SEQ, MS = DB * DS, M = MP + MS;
constexpr int GH = 8, GDK = 128, GQKV = 3072, GIN = 4112, GINP = 4352;
constexpr int NIN = 1840, NINP = 2048;
constexpr int FF = 2816, FF2 = 5632;
constexpr int NCMP_P = 255, NCMP_S = 127, NSEL_P = 64, NSEL_S = 33;
constexpr int SLC_S_ROWS = 2112, WIN_S_ROWS = 576;
constexpr int NCHUNK = NB * GH * 64;

constexpr size_t O_Y = 0, O_KVP = 17825792, O_KVS = 34603008, O_WINP = 35651584, O_WINS = 36700160, O_GSP = 70254592, O_GSS = 71303168, O_GCP = 104857600, O_GCS = 104931328;

constexpr size_t al256(size_t x) { return (x + 255) & ~(size_t)255; }
constexpr size_t WS_CTL = 0, CTL_BYTES = 1u << 20;
constexpr size_t SZ_WG_IN = (size_t)GINP * DM * 2, SZ_W1K = (size_t)DM * DM * 2, SZ_WN_IN = (size_t)NINP * DM * 2, SZ_WF_IN = (size_t)FF2 * DM * 2, SZ_WF_OUT = (size_t)DM * FF * 2, SZ_WC1 = (size_t)512 * 1024 * 2;
constexpr size_t WS_WG_IN = WS_CTL + CTL_BYTES;
constexpr size_t WS_WG_OUT = WS_WG_IN + 2 * SZ_WG_IN;
constexpr size_t WS_WN_IN = WS_WG_OUT + 2 * SZ_W1K;
constexpr size_t WS_WN_OUT = WS_WN_IN + 2 * SZ_WN_IN;
constexpr size_t WS_WF_IN = WS_WN_OUT + 2 * SZ_W1K;
constexpr size_t WS_WF_OUT = WS_WF_IN + 4 * SZ_WF_IN;
constexpr size_t WS_WC1 = WS_WF_OUT + 4 * SZ_WF_OUT;
constexpr size_t WS_CBIAS = WS_WC1 + 4 * SZ_WC1;
constexpr size_t WS_X = WS_CBIAS + 4096;
constexpr size_t WS_XN = WS_X + (size_t)M * DM * 4;
constexpr size_t WS_H = WS_XN + (size_t)M * DM * 2;
constexpr size_t WS_FFH = WS_H + (size_t)M * GINP * 2;
constexpr size_t WS_AO = WS_FFH + (size_t)M * FF * 2;
constexpr size_t WS_QH = WS_AO + (size_t)M * DM * 2;
constexpr size_t WS_KH = WS_QH + (size_t)M * DM * 2;
constexpr size_t WS_VH = WS_KH + (size_t)M * DM * 2;
constexpr size_t WS_BETA = WS_VH + (size_t)M * DM * 2;
constexpr size_t WS_LOGA = WS_BETA + (size_t)M * 8 * 4;
constexpr size_t WS_OG = WS_LOGA + (size_t)M * 8 * 4;
constexpr size_t WS_CW = WS_OG + (size_t)M * DM * 4;
constexpr size_t WS_CUT = WS_CW + (size_t)NCHUNK * 64 * 128 * 2;
constexpr size_t WS_CAQK = WS_CUT + (size_t)NCHUNK * 128 * 64 * 4;
constexpr size_t WS_CQT = WS_CAQK + (size_t)NCHUNK * 64 * 64 * 2;
constexpr size_t WS_CKTT = WS_CQT + (size_t)NCHUNK * 64 * 128 * 2;
constexpr size_t WS_CEGL = WS_CKTT + (size_t)NCHUNK * 128 * 64 * 2;
constexpr size_t WS_CMPP = WS_CEGL + (size_t)NCHUNK * 4;
constexpr size_t SZ_CMPS = (size_t)DB * PAST * 256 * 2;
constexpr size_t WS_CMPS = WS_CMPP + (size_t)MP * 256 * 2;
constexpr size_t SZ_SLC_S = (size_t)DB * 2 * SLC_S_ROWS * 64 * 2;
constexpr size_t WS_KSLC_S = WS_CMPS + 2 * SZ_CMPS;
constexpr size_t WS_VSLCT_S = WS_KSLC_S + 2 * SZ_SLC_S;
constexpr size_t SZ_WIN_S = (size_t)DB * 2 * WIN_S_ROWS * 64 * 2;
constexpr size_t WS_KWIN_S = WS_VSLCT_S + 2 * SZ_SLC_S;
constexpr size_t WS_VWINT_S = WS_KWIN_S + 2 * SZ_WIN_S;
constexpr size_t WS_VSLCT_P = WS_VWINT_S + 2 * SZ_WIN_S;
constexpr size_t WS_VWINT_P = WS_VSLCT_P + (size_t)NB * 2 * 64 * SEQ * 2;
constexpr size_t WS_PC_P = WS_VWINT_P + (size_t)NB * 2 * 64 * SEQ * 2;
constexpr size_t WS_PC_S = WS_PC_P + (size_t)4 * 1024 * 512 * 2;
constexpr size_t WS_KC_P = WS_PC_S + (size_t)4 * 16384 * 512 * 2;
constexpr size_t WS_VCT_P = WS_KC_P + (size_t)NB * 2 * 256 * 64 * 2;
constexpr size_t WS_KC_S = WS_VCT_P + (size_t)NB * 2 * 256 * 64 * 2;
constexpr size_t WS_VCT_S = WS_KC_S + (size_t)DB * 2 * 128 * 64 * 2;
constexpr size_t WS_END = WS_VCT_S + (size_t)DB * 2 * 128 * 64 * 2;

constexpr int CW_BAR = 4096;

constexpr int RING_BYTES = 131072, MISC_OFF = RING_BYTES + 320, LDS_BYTES = 147456;
constexpr int PTAB_OFF = RING_BYTES + 1024;

typedef __bf16 hwbf16x2 __attribute__((ext_vector_type(2)));
DI unsigned pk2(float lo, float hi) { const f32x2 v = {lo, hi}; return __builtin_bit_cast(unsigned, __builtin_convertvector(v, hwbf16x2)); }
DI unsigned f2bf(float f) { return pk2(f, f) & 0xffffu; }
DI float bf2f(unsigned b) { return __builtin_bit_cast(float, b << 16); }
DI float bflo(unsigned w) { return __builtin_bit_cast(float, w << 16); }
DI float bfhi(unsigned w) { return __builtin_bit_cast(float, w & 0xffff0000u); }
template <int CTRL> DI float dppf(float x) { return __builtin_bit_cast(float, __builtin_amdgcn_update_dpp(0, __builtin_bit_cast(int, x), CTRL, 0xF, 0xF, true)); }
DI float sum16(float x) { x += dppf<0xB1>(x); x += dppf<0x4E>(x); x += dppf<0x141>(x); x += dppf<0x140>(x); return x; }
DI float xor16_sum(float x) { auto s = __builtin_amdgcn_permlane16_swap(__float_as_uint(x), __float_as_uint(x), false, false); const unsigned s0 = s[0], s1 = s[1];
    return __uint_as_float(s0) + __uint_as_float(s1); }
DI float xor32_sum(float x) { auto s = __builtin_amdgcn_permlane32_swap(__float_as_uint(x), __float_as_uint(x), false, false); const unsigned s0 = s[0], s1 = s[1];
    return __uint_as_float(s0) + __uint_as_float(s1); }
DI float xor32_max(float x) { auto s = __builtin_amdgcn_permlane32_swap(__float_as_uint(x), __float_as_uint(x), false, false); const unsigned s0 = s[0], s1 = s[1];
    return fmaxf(__uint_as_float(s0), __uint_as_float(s1)); }
DI float sum32(float x) { return xor16_sum(sum16(x)); }
DI float wave_sum(float v) { return xor32_sum(sum32(v)); }
DI float sigmoidf_(float x) { return __builtin_amdgcn_rcpf(1.f + __expf(-x)); }
DI float siluf_(float x) { return x * __builtin_amdgcn_rcpf(1.f + __expf(-x)); }
#define LDS_WAIT() asm volatile("s_waitcnt lgkmcnt(0)" ::: "memory")
#define VM_WAIT() asm volatile("s_waitcnt vmcnt(0)" ::: "memory")

namespace pg8 {
constexpr int BM = 256, BK = 64, HALF = 128, HTB = HALF * BK * 2, STAGE_BYTES = 8 * HTB, NXCD = 8, WGM = 8;
DI int lds_byte(int r, int c) { const int st = (r >> 4) * 2 + (c >> 5), rr = r & 15, cc = c & 31, ob = rr * 64 + cc * 2; return st * 1024 + (ob ^ (((ob >> 9) & 1) << 5)); }
DI void stage_rc(int b, int& R, int& C) { const int st = b / 1024, sb = b % 1024, swz = sb ^ (((sb >> 9) & 1) << 5); R = (st >> 1) * 16 + swz / 64; C = (st & 1) * 32 + (swz % 64) / 2; }
DI int perm32(int rho) { const int n = rho >> 4, i = rho & 15; return 8 * (i >> 2) + 4 * n + (i & 3); }

struct Unit { int pm, pn, z; const char* A; const char* B; char* C; };
struct Gemm { int K; int lda; int kstepA; };

struct StaticOrder {
    int nM, nN, nwg, G, c, K, lda; const char* A; const char* B; char* C;
    DI void init(int M_, int N_, int G_, int c_, const void* A_, const void* B_, void* C_, int K_, int lda_) { nM = M_ / BM; nN = N_ / BM; nwg = nM * nN; G = G_; c = c_; A = (const char*)A_; B = (const char*)B_; C = (char*)C_; K = K_; lda = lda_; }
    DI bool next(int i, Unit& u) const {
        const long L = (long)i * G + c; if (L >= nwg) return false;
        int wgid = (int)L; { const int q = nwg / NXCD, r = nwg % NXCD, xcd = wgid % NXCD, off = wgid / NXCD; wgid = (xcd < r ? xcd * (q + 1) : r * (q + 1) + (xcd - r) * q) + off; }
        const int nig = WGM * nN, gid = wgid / nig, fm = gid * WGM, gsz = (nM - fm) < WGM ? (nM - fm) : WGM;
        u.pm = fm + ((wgid % nig) % gsz); u.pn = (wgid % nig) / gsz; u.z = 0;
        u.A = A + (size_t)u.pm * BM * lda * 2; u.B = B + (size_t)u.pn * BM * K * 2; u.C = C; return true;
    }
};

DI unsigned cvt_pk_bf16(float lo, float hi) { unsigned r; asm volatile("v_cvt_pk_bf16_f32 %0, %1, %2" : "=v"(r) : "v"(lo), "v"(hi)); return r; }

struct EpiBf16 {
    static constexpr bool PERM = true;
    int ldc;
    DI void operator()(const f32x4 (&acc)[2][2][4][2], const Unit& u, int wr, int wc, int fr, int fq) const {
        const int row0 = u.pm * BM + wr * 64 + fr, col0 = u.pn * BM + wc * 32 + 8 * fq;
#pragma unroll
        for (int ai = 0; ai < 2; ++ai)
#pragma unroll
            for (int m = 0; m < 4; ++m) { bf16* rowp = (bf16*)u.C + (size_t)(row0 + ai * HALF + m * 16) * ldc + col0;
#pragma unroll
                for (int bj = 0; bj < 2; ++bj) { const f32x4 v0 = acc[ai][bj][m][0], v1 = acc[ai][bj][m][1];
                    u32x4 w; w.x = cvt_pk_bf16(v0[0], v0[1]); w.y = cvt_pk_bf16(v0[2], v0[3]); w.z = cvt_pk_bf16(v1[0], v1[1]); w.w = cvt_pk_bf16(v1[2], v1[3]);
                    *(u32x4*)(rowp + bj * HALF) = w; } }
    }
};
struct EpiSwiglu {
    static constexpr bool PERM = true;
    bf16* O; int ldc;
    DI void operator()(const f32x4 (&acc)[2][2][4][2], const Unit& u, int wr, int wc, int fr, int fq) const {
        const int row0 = u.pm * BM + wr * 64 + fr, col0 = u.pn * HALF + wc * 32 + 8 * fq;
#pragma unroll
        for (int ai = 0; ai < 2; ++ai)
#pragma unroll
            for (int m = 0; m < 4; ++m) { bf16* rowp = O + (size_t)(row0 + ai * HALF + m * 16) * ldc + col0;
                float o[8];
#pragma unroll
                for (int n = 0; n < 2; ++n)
#pragma unroll
                    for (int e = 0; e < 4; ++e) { const float g = acc[ai][0][m][n][e], uu = acc[ai][1][m][n][e]; o[n * 4 + e] = g * __builtin_amdgcn_rcpf(1.f + __expf(-g)) * uu; }
                u32x4 w; w.x = cvt_pk_bf16(o[0], o[1]); w.y = cvt_pk_bf16(o[2], o[3]); w.z = cvt_pk_bf16(o[4], o[5]); w.w = cvt_pk_bf16(o[6], o[7]);
                *(u32x4*)rowp = w; }
    }
};
struct EpiResid {
    static constexpr bool PERM = false;
    float* X;
    DI void operator()(const f32x4 (&acc)[2][2][4][2], const Unit& u, int wr, int wc, int fr, int fq) const {
        const int row0 = u.pm * BM + wr * 64 + fr, col0 = u.pn * BM + wc * 32 + 4 * fq;
#pragma unroll
        for (int ai = 0; ai < 2; ++ai)
#pragma unroll
            for (int m = 0; m < 4; ++m) { float* rowp = X + (size_t)(row0 + ai * HALF + m * 16) * DM + col0;
#pragma unroll
                for (int bj = 0; bj < 2; ++bj)
#pragma unroll
                    for (int n = 0; n < 2; ++n) { f32x4* p = (f32x4*)(rowp + bj * HALF + n * 16); *p = *p + acc[ai][bj][m][n]; } }
    }
};
struct EpiNsaIn {
    static constexpr bool PERM = true;
    bf16* H; float* out; bf16* cmpp; int li;
    DI void operator()(const f32x4 (&acc)[2][2][4][2], const Unit& u, int wr, int wc, int fr, int fq) const {
        const int row0 = u.pm * BM + wr * 64 + fr, col0 = u.pn * BM + wc * 32 + 8 * fq;
        const bool smp = u.pm >= MP / BM;
#pragma unroll
        for (int ai = 0; ai < 2; ++ai)
#pragma unroll
            for (int m = 0; m < 4; ++m) { const int row = row0 + ai * HALF + m * 16; bf16* rowp = H + (size_t)row * NINP + col0;
                float* o = nullptr;
                if (u.pn == 4 || u.pn == 5) o = (smp ? out + O_KVS + (size_t)li * MS * 512 + (size_t)(row - MP) * 512 : out + O_KVP + (size_t)li * MP * 512 + (size_t)row * 512) + (col0 - 1024);
                else if (u.pn == 6) {
                    if (smp) { const int rs = row - MP; o = out + O_WINS + ((size_t)(li * DB + (rs >> 3)) * 512 + 504 + (rs & 7)) * 256 + (col0 - 1536); }
                    else { const int t = row & 4095; if (t >= SEQ - 512) o = out + O_WINP + ((size_t)(li * NB + (row >> 12)) * 512 + (t - (SEQ - 512))) * 256 + (col0 - 1536); } }
#pragma unroll
                for (int bj = 0; bj < 2; ++bj) { const float qs = u.pn < 4 ? 0.18033688011112042f : 1.f;
                    const f32x4 v0 = acc[ai][bj][m][0] * qs, v1 = acc[ai][bj][m][1] * qs;
                    u32x4 w; w.x = cvt_pk_bf16(v0[0], v0[1]); w.y = cvt_pk_bf16(v0[2], v0[3]); w.z = cvt_pk_bf16(v1[0], v1[1]); w.w = cvt_pk_bf16(v1[2], v1[3]);
                    *(u32x4*)(rowp + bj * HALF) = w;
                    if (o) { *(f32x4*)(o + bj * HALF) = v0; *(f32x4*)(o + bj * HALF + 4) = v1; }
                    if (u.pn == 4 && !smp) *(u32x4*)(cmpp + (size_t)row * 256 + (col0 - 1024) + bj * HALF) = w; } }
    }
};

template <class Epi, class Sched>
DI void gemm_phase(LAS unsigned char* lds, const Gemm g, const Sched& S, const Epi& E) {
    int tid_ = threadIdx.x; asm volatile("" : "+v"(tid_)); const int tid = tid_, wid = __builtin_amdgcn_readfirstlane(tid >> 6), lane = tid & 63, wr = wid >> 2, wc = wid & 3, fr = lane & 15, fq = lane >> 4;
    const int K = g.K, nt = K / BK;
    unsigned voffA[2], voffB[2];
#pragma unroll
    for (int i = 0; i < 2; ++i) { int R, C; stage_rc(tid * 16 + i * 8192, R, C); const int Rb = Epi::PERM ? ((R & ~31) + perm32(R & 31)) : R;
        voffA[i] = (unsigned)(R * g.lda + C) * 2u; voffB[i] = (unsigned)(Rb * K + C) * 2u; }
    const size_t kstepA = (size_t)g.kstepA, kstepB = (size_t)(BK * 2);
    const size_t hstepA = (size_t)HALF * g.lda * 2, hstepB = (size_t)HALF * K * 2;
    const unsigned ldsw = (unsigned)wid * 1024u;
    const int aoff = lds_byte(wr * 64 + fr, fq * 8), boff = lds_byte(wc * 32 + fr, fq * 8);
#define PG8_SA(b, h) (((b) * 2 + (h)) * HTB)
#define PG8_SB(b, h) ((4 + (b) * 2 + (h)) * HTB)
#define PG8_STAGE(bufoff, gbase, voff) do { _Pragma("unroll") for (int _i = 0; _i < 2; ++_i) \
        __builtin_amdgcn_global_load_lds((const unsigned*)((const char*)(gbase) + (voff)[_i]), (LAS unsigned*)(lds + (bufoff) + ldsw + _i * 8192), 16, 0, 0); } while (0)
#define PG8_LDA(dst, b, h) do { _Pragma("unroll") for (int m = 0; m < 4; ++m) _Pragma("unroll") for (int k = 0; k < 2; ++k) dst[m][k] = *(const LAS bf16x8*)(lds + PG8_SA(b, h) + aoff + m * 2048 + k * 1024); } while (0)
#define PG8_LDB(dst, b, h) do { _Pragma("unroll") for (int n = 0; n < 2; ++n) _Pragma("unroll") for (int k = 0; k < 2; ++k) dst[n][k] = *(const LAS bf16x8*)(lds + PG8_SB(b, h) + boff + n * 2048 + k * 1024); } while (0)
#define PG8_MMA(ai, bj, At, Bt) do { __builtin_amdgcn_s_setprio(1); _Pragma("unroll") for (int m = 0; m < 4; ++m) _Pragma("unroll") for (int n = 0; n < 2; ++n) _Pragma("unroll") for (int k = 0; k < 2; ++k) \
        acc[ai][bj][m][n] = __builtin_amdgcn_mfma_f32_16x16x32_bf16(Bt[n][k], At[m][k], acc[ai][bj][m][n], 0, 0, 0); __builtin_amdgcn_s_setprio(0); } while (0)
#define PG8_WAIT_V(n) asm volatile("s_waitcnt vmcnt(" #n ")" ::: "memory")
#define PG8_WAIT_L(n) asm volatile("s_waitcnt lgkmcnt(" #n ")" ::: "memory")
#define PG8_BAR __builtin_amdgcn_s_barrier()
#define PG8_SCHED __builtin_amdgcn_sched_barrier(0)
    Unit cur, nxt; int ui = 0;
    if (!S.next(0, cur)) return;
    f32x4 acc[2][2][4][2];
#pragma unroll
    for (int a = 0; a < 2; ++a)
#pragma unroll
        for (int b = 0; b < 2; ++b)
#pragma unroll
            for (int m = 0; m < 4; ++m)
#pragma unroll
                for (int n = 0; n < 2; ++n) acc[a][b][m][n] = (f32x4){0.f, 0.f, 0.f, 0.f};
    bf16x8 At[4][2], B0[2][2], B1[2][2];
    const char* cA = cur.A; const char* cB = cur.B;
    PG8_STAGE(PG8_SB(0, 0), cB, voffB); PG8_STAGE(PG8_SA(0, 0), cA, voffA); PG8_STAGE(PG8_SB(0, 1), cB + hstepB, voffB); PG8_STAGE(PG8_SA(0, 1), cA + hstepA, voffA);
    if (wr == 1) PG8_BAR;
    PG8_WAIT_V(4); PG8_BAR;
    PG8_STAGE(PG8_SB(1, 0), cB + kstepB, voffB); PG8_STAGE(PG8_SA(1, 0), cA + kstepA, voffA); PG8_STAGE(PG8_SB(1, 1), cB + hstepB + kstepB, voffB);
    PG8_WAIT_V(6); PG8_BAR;
    for (;;) {
        const bool has_next = S.next(ui + 1, nxt);
        const char* nA = has_next ? nxt.A : cA; const char* nB = has_next ? nxt.B : cB;
        for (int t = 0; t < nt; t += 2) {
            const bool last = (t == nt - 2);
            const char* a1 = cA + (size_t)(t + 1) * kstepA;
            const char* a2 = last ? nA : cA + (size_t)(t + 2) * kstepA; const char* b2 = last ? nB : cB + (size_t)(t + 2) * kstepB;
            const char* a3 = a2 + kstepA; const char* b3 = b2 + kstepB;
            PG8_LDB(B0, 0, 0); PG8_SCHED; PG8_LDA(At, 0, 0); PG8_STAGE(PG8_SA(1, 1), a1 + hstepA, voffA);
            PG8_WAIT_L(8); PG8_BAR; PG8_WAIT_L(0); PG8_MMA(0, 0, At, B0); PG8_BAR; PG8_SCHED;
            PG8_LDB(B1, 0, 1); PG8_STAGE(PG8_SB(0, 0), b2, voffB);
            PG8_BAR; PG8_WAIT_L(0); PG8_MMA(0, 1, At, B1); PG8_BAR;
            PG8_LDA(At, 0, 1); PG8_STAGE(PG8_SA(0, 0), a2, voffA);
            PG8_BAR; PG8_WAIT_L(0); PG8_MMA(1, 0, At, B0); PG8_BAR; PG8_SCHED;
            PG8_STAGE(PG8_SB(0, 1), b2 + hstepB, voffB);
            PG8_WAIT_V(6); PG8_BAR; PG8_MMA(1, 1, At, B1); PG8_BAR;
            PG8_LDB(B0, 1, 0); PG8_SCHED; PG8_LDA(At, 1, 0); PG8_STAGE(PG8_SA(0, 1), a2 + hstepA, voffA);
            PG8_WAIT_L(8); PG8_BAR; PG8_WAIT_L(0); PG8_MMA(0, 0, At, B0); PG8_BAR; PG8_SCHED;
            PG8_LDB(B1, 1, 1); PG8_STAGE(PG8_SB(1, 0), b3, voffB);
            PG8_BAR; PG8_WAIT_L(0); PG8_MMA(0, 1, At, B1); PG8_BAR;
            PG8_LDA(At, 1, 1); PG8_STAGE(PG8_SA(1, 0), a3, voffA);
            PG8_BAR; PG8_WAIT_L(0); PG8_MMA(1, 0, At, B0); PG8_BAR; PG8_SCHED;
            PG8_STAGE(PG8_SB(1, 1), b3 + hstepB, voffB);
            PG8_WAIT_V(6); PG8_BAR; PG8_MMA(1, 1, At, B1); PG8_BAR;
        }
        E(acc, cur, wr, wc, fr, fq);
        if (!has_next) break;
#pragma unroll
        for (int a = 0; a < 2; ++a)
#pragma unroll
            for (int b = 0; b < 2; ++b)
#pragma unroll
                for (int m = 0; m < 4; ++m)
#pragma unroll
                    for (int n = 0; n < 2; ++n) acc[a][b][m][n] = (f32x4){0.f, 0.f, 0.f, 0.f};
        cur = nxt; cA = nA; cB = nB; ++ui;
    }
    PG8_WAIT_V(0);
    if (wr == 0) PG8_BAR;
    PG8_BAR;
#undef PG8_SA
#undef PG8_SB
#undef PG8_STAGE
#undef PG8_LDA
#undef PG8_LDB
#undef PG8_MMA
#undef PG8_WAIT_V
#undef PG8_WAIT_L
#undef PG8_BAR
#undef PG8_SCHED
}
}

#define XB_TMO      128
#define XB_XCNT(j)  (256  + 64 * (j))
#define XB_XSUB(j)  (1280 + 64 * (j))
#define XB_XGEN(j)  (2304 + 64 * (j))
#define XB_TOP      3328
#define XB_TOPGEN   3392
#define XCD_BAR_WORDS 3456
#define XB_SPIN_CAP (1u << 18)
DI unsigned xb_ld(unsigned* p)              { return __hip_atomic_load(p, __ATOMIC_RELAXED, __HIP_MEMORY_SCOPE_AGENT); }
DI unsigned xb_add(unsigned* p, unsigned v) { return __hip_atomic_fetch_add(p, v, __ATOMIC_RELAXED, __HIP_MEMORY_SCOPE_AGENT); }
DI unsigned xb_xcc_id() { return (unsigned)__builtin_amdgcn_s_getreg((3 << 11) | 20) & 0xFu; }
#define XB_SPIN(cond, bar) do { unsigned _sp = 0; while (cond) { __builtin_amdgcn_s_sleep(1); \
    if ((++_sp & 255u) == 0u) { if (xb_ld(&(bar)[XB_TMO])) break; if (_sp > XB_SPIN_CAP) { atomicAdd(&(bar)[XB_TMO], 1u); break; } } } } while (0)
struct XcdBarrier { unsigned* bar; unsigned x; volatile LAS unsigned* st; };
DI XcdBarrier xcd_barrier_post(unsigned* bar, volatile LAS unsigned* st) {
    XcdBarrier b; b.bar = bar; b.x = xb_xcc_id(); b.st = st;
    if (threadIdx.x == 0) (void)xb_add(&bar[XB_XCNT(b.x)], 1u);
    return b;
}
DI void xcd_barrier_complete(unsigned* bar, unsigned x, unsigned& nloc, unsigned& nx) {
    const unsigned G = gridDim.x * gridDim.y * gridDim.z;
    unsigned sum, cnt, mine, sp = 0u;
    for (;;) {
        sum = 0u; cnt = 0u; mine = 0u;
#pragma unroll
        for (unsigned j = 0; j < 16; ++j) { const unsigned c = xb_ld(&bar[XB_XCNT(j)]); sum += c; cnt += (c > 0u) ? 1u : 0u; mine = (j == x) ? c : mine; }
        if (sum == G) break;
        __builtin_amdgcn_s_sleep(1);
        if ((++sp & 255u) == 0u) { if (xb_ld(&bar[XB_TMO])) break; if (sp > XB_SPIN_CAP) { atomicAdd(&bar[XB_TMO], 1u); break; } }
    }
    nloc = mine > 0u ? mine : 1u; nx = cnt > 0u ? cnt : 1u;
}
DI void xcd_barrier(const XcdBarrier& b) {
    asm volatile("s_waitcnt vmcnt(0)" ::: "memory");
    __syncthreads();
    if (threadIdx.x == 0) {
        unsigned* bar = b.bar;
        __builtin_amdgcn_s_waitcnt(0);
        unsigned nloc = b.st[0], nx = b.st[1];
        if (nloc == 0u) { xcd_barrier_complete(bar, b.x, nloc, nx); b.st[0] = nloc; b.st[1] = nx; }
        const unsigned old = xb_add(&bar[XB_XSUB(b.x)], 1u);
        const unsigned gen = old / nloc;
        if (old + 1u == (gen + 1u) * nloc) {
            __builtin_amdgcn_fence(__ATOMIC_RELEASE, "agent");
            asm volatile("s_waitcnt vmcnt(0)" ::: "memory");
            const unsigned og = xb_add(&bar[XB_TOP], 1u);
            const unsigned tg = og / nx;
            if (og + 1u == (tg + 1u) * nx) xb_add(&bar[XB_TOPGEN], 1u);
            else XB_SPIN(xb_ld(&bar[XB_TOPGEN]) == tg, bar);
            __builtin_amdgcn_fence(__ATOMIC_ACQUIRE, "agent");
            xb_add(&bar[XB_XGEN(b.x)], 1u);
            asm volatile("s_waitcnt vmcnt(0)" ::: "memory");
        } else {
            XB_SPIN(xb_ld(&bar[XB_XGEN(b.x)]) == gen, bar);
            __builtin_amdgcn_fence(__ATOMIC_ACQUIRE, "agent");
            asm volatile("s_waitcnt vmcnt(0)" ::: "memory");
        }
    }
    __syncthreads();
}

struct P { const void* in[26]; float* out; unsigned char* ws; };
struct Frame { LAS unsigned char* lds; int tid, lane, wave, bid, G, gw, ngw; };
#define MFMA32(a, b, c) __builtin_amdgcn_mfma_f32_32x32x16_bf16((a), (b), (c), 0, 0, 0)
#define MFMA16(a, b, c) __builtin_amdgcn_mfma_f32_16x16x32_bf16((a), (b), (c), 0, 0, 0)
DI int crow(int reg, int h) { return (reg & 3) + 8 * (reg >> 2) + 4 * h; }
DI u32x2 pack4(f32x4 v) { u32x2 w; w.x = pk2(v[0], v[1]); w.y = pk2(v[2], v[3]); return w; }

DI void tr_item(const float* W, int K, int N, int ldw, bf16* WT, int dst_row0, LAS float* scr, int k0, int n0, int lane) {
    const int nn = n0 + (lane & 31); const bool ok = nn < N;
    float tv[32];
#pragma unroll
    for (int i = 0; i < 32; ++i) tv[i] = ok ? W[(size_t)(k0 + 2 * i + (lane >> 5)) * ldw + nn] : 0.f;
#pragma unroll
    for (int i = 0; i < 32; ++i) scr[(2 * i + (lane >> 5)) * 33 + (lane & 31)] = tv[i];
    LDS_WAIT();
    const int c = lane & 7;
#pragma unroll
    for (int j = 0; j < 4; ++j) { const int n = (lane >> 3) + 8 * j; const LAS float* s = scr + (8 * c) * 33 + n;
        u32x4 o; o.x = pk2(s[0 * 33], s[1 * 33]); o.y = pk2(s[2 * 33], s[3 * 33]); o.z = pk2(s[4 * 33], s[5 * 33]); o.w = pk2(s[6 * 33], s[7 * 33]);
        *(u32x4*)(WT + (size_t)(dst_row0 + n) * K + k0 + 8 * c) = o; }
    LDS_WAIT();
}
DI void p0_weights(const P& p, const Frame& F, int which) {
    LAS float* scr = (LAS float*)(F.lds + F.wave * 16384);
    constexpr int C_GIN = 16 * (GINP / 32), C_SQ = 16 * 32, C_NIN = 16 * (NINP / 32), C_FIN = 16 * (FF2 / 32), C_FOUT = (FF / 64) * 32, C_C1 = 16 * 8;
    constexpr int TOT = 2 * C_GIN + 2 * C_SQ + 2 * C_NIN + 2 * C_SQ + 4 * C_FIN + 4 * C_FOUT + 8 * C_C1;
    for (int it = F.gw; it < TOT; it += F.ngw) {
        int r = it; const float* W; int K = DM, N, Npad, ldw; bf16* WT; int mode = 0, rowoff = 0;
        bool l0 = false;
        if (r < 2 * C_GIN) { const int li = r / C_GIN; r -= li * C_GIN; l0 = li == 0; W = (const float*)p.in[10] + (size_t)li * DM * GIN; N = GIN; Npad = GINP; ldw = GIN; WT = (bf16*)(p.ws + WS_WG_IN + li * SZ_WG_IN); }
        else if ((r -= 2 * C_GIN) < 2 * C_SQ) { const int li = r / C_SQ; r -= li * C_SQ; l0 = li == 0; W = (const float*)p.in[15] + (size_t)li * DM * DM; N = DM; Npad = DM; ldw = DM; WT = (bf16*)(p.ws + WS_WG_OUT + li * SZ_W1K); }
        else if ((r -= 2 * C_SQ) < 2 * C_NIN) { const int li = r / C_NIN; r -= li * C_NIN; W = (const float*)p.in[16] + (size_t)li * DM * NIN; N = NIN; Npad = NINP; ldw = NIN; WT = (bf16*)(p.ws + WS_WN_IN + li * SZ_WN_IN); }
        else if ((r -= 2 * C_NIN) < 2 * C_SQ) { const int li = r / C_SQ; r -= li * C_SQ; W = (const float*)p.in[23] + (size_t)li * DM * DM; N = DM; Npad = DM; ldw = DM; WT = (bf16*)(p.ws + WS_WN_OUT + li * SZ_W1K); }
        else if ((r -= 2 * C_SQ) < 4 * C_FIN) { const int i = r / C_FIN; r -= i * C_FIN; l0 = i == 0; W = (const float*)p.in[24] + (size_t)i * DM * FF2; N = FF2; Npad = FF2; ldw = FF2; WT = (bf16*)(p.ws + WS_WF_IN + i * SZ_WF_IN); mode = 1; }
        else if ((r -= 4 * C_FIN) < 4 * C_FOUT) { const int i = r / C_FOUT; r -= i * C_FOUT; l0 = i == 0; W = (const float*)p.in[25] + (size_t)i * FF * DM; K = FF; N = DM; Npad = DM; ldw = DM; WT = (bf16*)(p.ws + WS_WF_OUT + i * SZ_WF_OUT); }
        else { r -= 4 * C_FOUT; const int id = r / C_C1; r -= id * C_C1; const int li = id >> 2, kv = (id >> 1) & 1, half = id & 1;
            W = (const float*)(kv ? p.in[21] : p.in[19]) + (size_t)li * 2048 * 256 + (size_t)half * 1024 * 256; N = 256; Npad = 256; ldw = 256; WT = (bf16*)(p.ws + WS_WC1 + (li * 2 + kv) * SZ_WC1); rowoff = half * 256; }
        if (l0 != (which == 0)) continue;
        const int nblk = Npad / 32, kb = r / nblk, nb = r % nblk, n0 = nb * 32;
        int drow = n0 + rowoff;
        if (mode == 1) { const int j = n0 < FF ? n0 : n0 - FF; drow = 256 * (j >> 7) + (j & 127) + (n0 < FF ? 0 : 128); }
        tr_item(W, K, N, ldw, WT, drow, scr, kb * 64, n0, F.lane);
    }
}
DI void p0_cbias(const P& p, const Frame& F) {
    LAS float* red = (LAS float*)F.lds;
    float* part = (float*)(p.ws + WS_PC_P);
    for (int t = F.bid; t < 256; t += F.G) {
        const int id = t >> 6, sl = t & 63, li = id >> 1, kv = id & 1, c = F.tid & 255, half = F.tid >> 8;
        const float* w1 = (const float*)(kv ? p.in[21] : p.in[19]) + (size_t)li * 2048 * 256; const float* pe = (const float*)(kv ? p.in[18] : p.in[17]) + (size_t)li * 2048;
        const int k0 = sl * 32 + half * 16; float acc = 0.f;
#pragma unroll
        for (int kk = 0; kk < 16; ++kk) acc += pe[k0 + kk] * w1[(size_t)(k0 + kk) * 256 + c];
        red[F.tid] = acc; __syncthreads();
        if (F.tid < 256) part[(size_t)t * 256 + c] = red[F.tid] + red[F.tid + 256];
        __syncthreads();
    }
}
DI void p0_cbias2(const P& p, const Frame& F) {
    const float* part = (const float*)(p.ws + WS_PC_P);
    for (int id = F.bid; id < 4; id += F.G) if (F.tid < 256) { float acc = 0.f;
#pragma unroll 16
        for (int sl = 0; sl < 64; ++sl) acc += part[(size_t)(id * 64 + sl) * 256 + F.tid];
        ((float*)(p.ws + WS_CBIAS))[id * 256 + F.tid] = acc; }
}
DI void cache_kv_item(const P& p, int li, int id, int lane, int phys_in = -1) {
    const int* pt = (const int*)p.in[6];
    bf16* cmps = (bf16*)(p.ws + WS_CMPS + li * SZ_CMPS); bf16* kslc = (bf16*)(p.ws + WS_KSLC_S + li * SZ_SLC_S); bf16* vslc = (bf16*)(p.ws + WS_VSLCT_S + li * SZ_SLC_S);
    const int b = id >> 8, pg = (id >> 4) & 15, s8 = id & 15;
    const int phys = phys_in >= 0 ? phys_in : pt[b * NPAGE + pg];
    const float* src = (const float*)p.in[2] + (((size_t)li * NPHYS + phys) * PAGE + s8 * 8) * 512;
    f32x4 a[8], c[8];
#pragma unroll
    for (int rr = 0; rr < 8; ++rr) { a[rr] = *(const f32x4*)(src + (size_t)rr * 512 + lane * 4); c[rr] = *(const f32x4*)(src + (size_t)rr * 512 + 256 + lane * 4); }
    const int kind = lane >> 5, g = (lane >> 4) & 1, d = (lane & 15) * 4;
    bf16* dst2 = (kind ? vslc : kslc) + (size_t)(b * 2 + g) * SLC_S_ROWS * 64 + d;
#pragma unroll
    for (int rr = 0; rr < 8; ++rr) { const int pos = pg * PAGE + s8 * 8 + rr;
        *(u32x2*)(cmps + ((size_t)b * PAST + pos) * 256 + lane * 4) = pack4(a[rr]);
        *(u32x2*)(dst2 + (size_t)pos * 64) = pack4(c[rr]); }
}
DI void p0_cache_win(const P& p, const Frame& F, int li) {
    bf16* kwin = (bf16*)(p.ws + WS_KWIN_S + li * SZ_WIN_S); bf16* vwin = (bf16*)(p.ws + WS_VWINT_S + li * SZ_WIN_S);
    for (int id = F.gw; id < DB * 64; id += F.ngw) {
        const int b = id >> 6, r8 = id & 63;
        const float* src = (const float*)p.in[3] + (((size_t)li * DB + b) * 512 + r8 * 8) * 256;
        float* outw = p.out + O_WINS + (size_t)(li * DB + b) * 512 * 256;
        f32x4 a[8];
#pragma unroll
        for (int rr = 0; rr < 8; ++rr) a[rr] = *(const f32x4*)(src + (size_t)rr * 256 + F.lane * 4);
        const int kind = F.lane >> 5, g = (F.lane >> 4) & 1, d = (F.lane & 15) * 4;
        bf16* dst2 = (kind ? vwin : kwin) + (size_t)(b * 2 + g) * WIN_S_ROWS * 64 + d;
#pragma unroll
        for (int rr = 0; rr < 8; ++rr) { const int idx = r8 * 8 + rr;
            if (idx >= 8) *(f32x4*)(outw + (size_t)(idx - 8) * 256 + F.lane * 4) = a[rr];
            *(u32x2*)(dst2 + (size_t)idx * 64) = pack4(a[rr]); }
    }
}
template <int MODE> DI void rms_phase(const P& p, const Frame& F, const float* w) {
    float* X = (float*)(p.ws + WS_X); bf16* XN = (bf16*)(p.ws + WS_XN);
    f32x4 wv[4];
#pragma unroll
    for (int j = 0; j < 4; ++j) wv[j] = ((const f32x4*)w)[F.lane + 64 * j];
    for (int row = F.gw; row < M; row += F.ngw) {
        const float* src = MODE == 0 ? (row < MP ? (const float*)p.in[0] + (size_t)row * DM : (const float*)p.in[1] + (size_t)(row - MP) * DM) : X + (size_t)row * DM;
        f32x4 v[4]; float ss = 0.f;
#pragma unroll
        for (int j = 0; j < 4; ++j) { v[j] = ((const f32x4*)src)[F.lane + 64 * j]; ss += (v[j][0] * v[j][0] + v[j][1] * v[j][1]) + (v[j][2] * v[j][2] + v[j][3] * v[j][3]); }
        const float rstd = __builtin_amdgcn_rsqf(wave_sum(ss) * (1.f / DM) + 1e-6f);
#pragma unroll
        for (int j = 0; j < 4; ++j) { const f32x4 o = v[j] * rstd * wv[j];
            if (MODE == 2) ((f32x4*)(p.out + O_Y + (size_t)row * DM))[F.lane + 64 * j] = o;
            else ((u32x2*)(XN + (size_t)row * DM))[F.lane + 64 * j] = pack4(o);
            if (MODE == 0) ((f32x4*)(X + (size_t)row * DM))[F.lane + 64 * j] = v[j]; }
    }
}

DI void gdn_prep(const P& p, const Frame& F, int li) {
    const bf16* H = (const bf16*)(p.ws + WS_H);
    bf16* QH = (bf16*)(p.ws + WS_QH); bf16* KH = (bf16*)(p.ws + WS_KH); bf16* VH = (bf16*)(p.ws + WS_VH);
    float* BETA = (float*)(p.ws + WS_BETA); float* LOGA = (float*)(p.ws + WS_LOGA);
    const float* cw = (const float*)p.in[11] + (size_t)li * 4 * GQKV;
    const float* cbuf = (const float*)p.in[5] + (size_t)li * DB * 3 * GQKV;
    const float* Alog = (const float*)p.in[12] + li * 8; const float* dtb = (const float*)p.in[13] + li * 8;
    LAS float* wl = (LAS float*)F.lds;
    for (int i = F.tid; i < 4 * GQKV / 4; i += 512) ((LAS f32x4*)wl)[i] = ((const f32x4*)cw)[i];
    __syncthreads();
    for (int row = F.gw; row < M; row += F.ngw) {
        int b, t; const bool smp = row >= MP;
        if (!smp) { b = row >> 12; t = row & 4095; } else { b = (row - MP) >> 3; t = (row - MP) & 7; }
        u32x4 xr[4][6];
#pragma unroll
        for (int k = 0; k < 4; ++k) { const int tt = t - 3 + k;
#pragma unroll
            for (int cc = 0; cc < 6; ++cc) { const int c = (cc >> 1) * 1024 + ((cc & 1) * 64 + F.lane) * 8;
                if (tt >= 0) xr[k][cc] = *(const u32x4*)(H + (size_t)(row - 3 + k) * GINP + c);
                else if (smp) { const float* s = cbuf + ((size_t)b * 3 + (3 + tt)) * GQKV + c; const f32x4 v0 = *(const f32x4*)s, v1 = *(const f32x4*)(s + 4);
                    xr[k][cc] = (u32x4){pk2(v0[0], v0[1]), pk2(v0[2], v0[3]), pk2(v1[0], v1[1]), pk2(v1[2], v1[3])}; }
                else xr[k][cc] = (u32x4){0u, 0u, 0u, 0u}; } }
#pragma unroll
        for (int part = 0; part < 3; ++part) {
            asm volatile("" ::: "memory");
            float y[2][8]; float ss[2];
#pragma unroll
            for (int k2 = 0; k2 < 2; ++k2) { const int cc = part * 2 + k2, c = part * 1024 + (k2 * 64 + F.lane) * 8;
#pragma unroll
                for (int e = 0; e < 8; ++e) y[k2][e] = 0.f;
#pragma unroll
                for (int k = 0; k < 4; ++k) { const f32x4 w0 = *(const LAS f32x4*)(wl + k * GQKV + c), w1 = *(const LAS f32x4*)(wl + k * GQKV + c + 4); const u32x4 x = xr[k][cc];
                    y[k2][0] += w0[0] * bflo(x.x); y[k2][1] += w0[1] * bfhi(x.x); y[k2][2] += w0[2] * bflo(x.y); y[k2][3] += w0[3] * bfhi(x.y);
                    y[k2][4] += w1[0] * bflo(x.z); y[k2][5] += w1[1] * bfhi(x.z); y[k2][6] += w1[2] * bflo(x.w); y[k2][7] += w1[3] * bfhi(x.w); }
                float s2 = 0.f;
#pragma unroll
                for (int e = 0; e < 8; ++e) { y[k2][e] = siluf_(y[k2][e]); s2 += y[k2][e] * y[k2][e]; }
                s2 = sum16(s2);
                ss[k2] = s2;
                const int jo = smp ? t - (DS - 3) : t - (SEQ - 3);
                if (jo >= 0) { float* o = p.out + (smp ? O_GCS + ((size_t)(li * DB + b) * 3 + jo) * GQKV : O_GCP + ((size_t)(li * NB + b) * 3 + jo) * GQKV) + c; const u32x4 x = xr[3][cc];
                    *(f32x4*)o = (f32x4){bflo(x.x), bfhi(x.x), bflo(x.y), bfhi(x.y)}; *(f32x4*)(o + 4) = (f32x4){bflo(x.z), bfhi(x.z), bflo(x.w), bfhi(x.w)}; }
            }
            bf16* dst = part == 0 ? QH : (part == 1 ? KH : VH);
#pragma unroll
            for (int k2 = 0; k2 < 2; ++k2) { const float sc = part == 0 ? __builtin_amdgcn_rsqf(ss[k2] + 1e-6f) * 0.08838834764831845f : (part == 1 ? __builtin_amdgcn_rsqf(ss[k2] + 1e-6f) : 1.f);
                *(u32x4*)(dst + (size_t)row * DM + (k2 * 64 + F.lane) * 8) = (u32x4){pk2(y[k2][0] * sc, y[k2][1] * sc), pk2(y[k2][2] * sc, y[k2][3] * sc), pk2(y[k2][4] * sc, y[k2][5] * sc), pk2(y[k2][6] * sc, y[k2][7] * sc)}; }
        }
        if (F.lane < 8) { const int hh = F.lane;
            const float bb = bf2f(H[(size_t)row * GINP + 4096 + hh]), aa = bf2f(H[(size_t)row * GINP + 4104 + hh]) + dtb[hh];
            const float sp = aa > 20.f ? aa : log1pf(__expf(aa));
            BETA[(size_t)row * 8 + hh] = sigmoidf_(bb); LOGA[(size_t)row * 8 + hh] = -__expf(Alog[hh]) * sp; }
    }
}
DI void gdn_chunk(const P& p, const Frame& F, int li) {
    const bf16* QH = (const bf16*)(p.ws + WS_QH); const bf16* KH = (const bf16*)(p.ws + WS_KH); const bf16* VH = (const bf16*)(p.ws + WS_VH);
    const float* BETA = (const float*)(p.ws + WS_BETA); const float* LOGA = (const float*)(p.ws + WS_LOGA);
    bf16* CW = (bf16*)(p.ws + WS_CW); float* CUT = (float*)(p.ws + WS_CUT); bf16* CAQK = (bf16*)(p.ws + WS_CAQK); bf16* CQT = (bf16*)(p.ws + WS_CQT); bf16* CKTT = (bf16*)(p.ws + WS_CKTT); float* CEGL = (float*)(p.ws + WS_CEGL);
    LAS float* Gs = (LAS float*)F.lds; LAS float* bs = Gs + 64; LAS float* Lm = Gs + 128;
    for (int task = F.bid; task < NCHUNK; task += F.G) {
        const int b = task >> 9, hh = (task >> 6) & 7, c = task & 63, r0 = b * SEQ + c * 64;
        if (F.wave == 0) { float la = LOGA[(size_t)(r0 + F.lane) * 8 + hh];
#pragma unroll
            for (int o = 1; o < 64; o <<= 1) { const float tq = __shfl_up(la, o); if (F.lane >= o) la += tq; }
            const float bt = BETA[(size_t)(r0 + F.lane) * 8 + hh]; Gs[F.lane] = la; bs[F.lane] = bt; Gs[64 * 66 + F.lane] = bt * __expf(la); }
        __syncthreads();
        { const int which = F.wave >> 2, ti = (F.wave >> 1) & 1, tj = F.wave & 1, r = F.lane & 31, h = F.lane >> 5;
          const bf16* Ar = (which ? QH : KH) + (size_t)(r0 + 32 * ti + r) * DM + hh * 128 + 8 * h;
          const bf16* Br = KH + (size_t)(r0 + 32 * tj + r) * DM + hh * 128 + 8 * h;
          f32x16 cc; for (int e = 0; e < 16; ++e) cc[e] = 0.f;
#pragma unroll
          for (int ks = 0; ks < 8; ++ks) cc = MFMA32(*(const bf16x8*)(Ar + 16 * ks), *(const bf16x8*)(Br + 16 * ks), cc);
          const int j = 32 * tj + r; const float Gj = Gs[j];
#pragma unroll
          for (int reg = 0; reg < 16; ++reg) { const int i = 32 * ti + crow(reg, h); const float dec = (j <= i) ? __expf(Gs[i] - Gj) : 0.f;
              if (which == 0) Lm[i * 64 + j] = (j < i) ? bs[i] * cc[reg] * dec : 0.f;
              else CAQK[(size_t)task * 4096 + i * 64 + j] = (bf16)f2bf(cc[reg] * dec); } }
        __syncthreads();
        if (F.tid < 256) {
            const int col = F.tid; const bool isk = col < 128;
            const bf16* src = (isk ? KH : VH) + (size_t)r0 * DM + hh * 128 + (col & 127);
            const LAS float* sc2 = isk ? (Gs + 64 * 66) : bs;
            float x[64];
#pragma unroll
            for (int i = 0; i < 64; ++i) x[i] = bf2f(src[(size_t)i * DM]);
            asm volatile("" ::: "memory");
#pragma unroll
            for (int i = 0; i < 64; ++i) { float acc = x[i] * sc2[i];
#pragma unroll
                for (int j4 = 0; j4 < (i + 3) / 4; ++j4) { const f32x4 L4 = *(const LAS f32x4*)(Lm + i * 64 + 4 * j4);
                    acc -= L4[0] * x[4 * j4] + L4[1] * x[4 * j4 + 1] + L4[2] * x[4 * j4 + 2] + L4[3] * x[4 * j4 + 3]; }
                x[i] = acc; if ((i & 3) == 3) asm volatile("" ::: "memory"); }
            if (isk) {
#pragma unroll
                for (int i = 0; i < 64; ++i) CW[(size_t)task * 8192 + i * 128 + col] = (bf16)f2bf(x[i]); }
            else { float* d = CUT + ((size_t)task * 128 + (col - 128)) * 64;
#pragma unroll
                for (int i4 = 0; i4 < 16; ++i4) *(f32x4*)(d + 4 * i4) = (f32x4){x[4 * i4], x[4 * i4 + 1], x[4 * i4 + 2], x[4 * i4 + 3]}; }
        } else {
            const int t2 = F.tid - 256, dk = t2 & 127, half = t2 >> 7;
            { const bf16* sp = (half == 0 ? QH : KH) + (size_t)r0 * DM + hh * 128 + dk; const float Gl = Gs[63];
#pragma unroll
              for (int hb = 0; hb < 2; ++hb) { bf16 raw[32];
#pragma unroll
                for (int i = 0; i < 32; ++i) raw[i] = sp[(size_t)(32 * hb + i) * DM];
                if (half == 0) {
#pragma unroll
                    for (int i = 0; i < 32; ++i) CQT[(size_t)task * 8192 + (32 * hb + i) * 128 + dk] = (bf16)f2bf(__expf(Gs[32 * hb + i]) * bf2f(raw[i]));
                } else {
#pragma unroll
                    for (int i8 = 0; i8 < 4; ++i8) { float v[8];
#pragma unroll
                        for (int e = 0; e < 8; ++e) v[e] = bf2f(raw[8 * i8 + e]) * __expf(Gl - Gs[32 * hb + 8 * i8 + e]);
                        *(u32x4*)(CKTT + ((size_t)task * 128 + dk) * 64 + 32 * hb + 8 * i8) = (u32x4){pk2(v[0], v[1]), pk2(v[2], v[3]), pk2(v[4], v[5]), pk2(v[6], v[7])}; } }
                asm volatile("" ::: "memory"); } }
            if (t2 == 0) CEGL[task] = __expf(Gs[63]);
{ const int id0 = (task * 4 + (F.wave - 4)) * 4; const int ph = ((const int*)p.in[6])[(id0 >> 8) * NPAGE + ((id0 >> 4) & 15)];
#pragma unroll 1
            for (int k = 0; k < 4; ++k) cache_kv_item(p, li, id0 + k, F.lane, ph); }
        }
        __syncthreads();
    }
}
DI int sw16(int row, int ch) { return row * 256 + ((ch ^ (row & 15)) << 4); }
DI int sw8(int row, int ch) { return row * 128 + ((ch ^ ((row >> 1) & 7)) << 4); }
DI void gdn_scan(const P& p, const Frame& F, int li, int sid) {
    const bf16* CW = (const bf16*)(p.ws + WS_CW); const float* CUT = (const float*)(p.ws + WS_CUT); const bf16* CAQK = (const bf16*)(p.ws + WS_CAQK); const bf16* CQT = (const bf16*)(p.ws + WS_CQT); const bf16* CKTT = (const bf16*)(p.ws + WS_CKTT); const float* CEGL = (const float*)(p.ws + WS_CEGL);
    float* OG = (float*)(p.ws + WS_OG);
    constexpr int SBUF = 57344;
    LAS bf16* St = (LAS bf16*)(F.lds + ((F.wave & 3) < 2 ? 2 * SBUF + (F.wave & 3) * 6656 : PTAB_OFF + 256 + ((F.wave & 3) - 2) * 6656)); LAS bf16* uT = St + 16 * 136;
    const int a16 = F.lane & 15, kg = F.lane >> 4, sl = (sid & 1) * 4 + (F.wave & 3), b = sid >> 4, hh = (sid >> 1) & 7; const bool cwv = F.wave < 4;
    sid >>= 1;
    int so[4];
    { const int q0 = F.tid, q1 = F.tid + 512;
      so[0] = (q0 >> 4) * 128 + (((q0 & 15) ^ ((q0 >> 4) & 15)) << 3); so[1] = (q1 >> 4) * 128 + (((q1 & 15) ^ ((q1 >> 4) & 15)) << 3);
      so[2] = (q0 >> 3) * 64 + (((q0 & 7) ^ ((q0 >> 4) & 7)) << 3); so[3] = (q1 >> 3) * 64 + (((q1 & 7) ^ ((q1 >> 4) & 7)) << 3); }
    const unsigned wbase = (unsigned)F.wave * 1024u;
    f32x4 utn[4]; float egn;
#define SCAN_G2L(srcp, off) __builtin_amdgcn_global_load_lds((const unsigned*)(srcp), (LAS unsigned*)(F.lds + (off) + wbase), 16, 0, 0)
#define SCAN_DMA(c_, buf_) do { const size_t task_ = (size_t)sid * 64 + (c_); const int bo_ = (buf_) * SBUF; \
        SCAN_G2L(CW + task_ * 8192 + so[0], bo_); SCAN_G2L(CW + task_ * 8192 + so[1], bo_ + 8192); \
        SCAN_G2L(CQT + task_ * 8192 + so[0], bo_ + 16384); SCAN_G2L(CQT + task_ * 8192 + so[1], bo_ + 16384 + 8192); \
        SCAN_G2L(CKTT + task_ * 8192 + so[2], bo_ + 32768); SCAN_G2L(CKTT + task_ * 8192 + so[3], bo_ + 32768 + 8192); \
        SCAN_G2L(CAQK + task_ * 4096 + so[2], bo_ + 49152); } while (0)
#define SCAN_UT(c_) do { const size_t task_ = (size_t)sid * 64 + (c_); \
        _Pragma("unroll") for (int mt = 0; mt < 4; ++mt) utn[mt] = *(const f32x4*)(CUT + task_ * 8192 + (16 * sl + a16) * 64 + 16 * mt + 4 * kg); \
        egn = CEGL[task_]; } while (0)
    f32x4 S[8];
#pragma unroll
    for (int m = 0; m < 8; ++m) { S[m] = (f32x4){0.f, 0.f, 0.f, 0.f}; if (cwv) *(LAS u32x2*)(St + a16 * 136 + 16 * m + 4 * kg) = (u32x2){0u, 0u}; }
    SCAN_DMA(0, 0);
    if (cwv) SCAN_UT(0);
    __builtin_amdgcn_s_waitcnt(0x0070);
    f32x4 ut[4]; float egl;
    if (!cwv) {
        for (int c = 0; c < 64; ++c) {
            asm volatile("" ::: "memory"); __builtin_amdgcn_s_waitcnt(0x0070); __builtin_amdgcn_s_barrier(); asm volatile("" ::: "memory");
            if (c + 1 < 64) SCAN_DMA(c + 1, (c + 1) & 1);
        }
    } else
    for (int c = 0; c < 64; ++c) {
        asm volatile("" ::: "memory"); __builtin_amdgcn_s_waitcnt(0x0070); __builtin_amdgcn_s_barrier(); asm volatile("" ::: "memory");
        if (c + 1 < 64) SCAN_DMA(c + 1, (c + 1) & 1);
        {
#pragma unroll
        for (int mt = 0; mt < 4; ++mt)
#pragma unroll
            for (int e = 0; e < 4; ++e) { float t_; asm volatile("v_mov_b32 %0, %1" : "=v"(t_) : "v"(utn[mt][e])); ut[mt][e] = t_; }
        { float t_; asm volatile("v_mov_b32 %0, %1" : "=v"(t_) : "v"(egn)); egl = t_; }
        if (c + 1 < 64) SCAN_UT(c + 1);
        LAS unsigned char* sW = F.lds + (c & 1) * SBUF; LAS unsigned char* sQ = sW + 16384; LAS unsigned char* sK = sW + 32768; LAS unsigned char* sA = sW + 49152;
        bf16x8 sb[4];
#pragma unroll
        for (int ks = 0; ks < 4; ++ks) sb[ks] = *(const LAS bf16x8*)(St + a16 * 136 + 32 * ks + 8 * kg);
        f32x4 u[4];
#pragma unroll
        for (int mt = 0; mt < 4; ++mt) { f32x4 acc = (f32x4){0.f, 0.f, 0.f, 0.f};
#pragma unroll
            for (int ks = 0; ks < 4; ++ks) acc = MFMA16(*(const LAS bf16x8*)(sW + sw16(16 * mt + a16, 4 * ks + kg)), sb[ks], acc);
            u[mt] = ut[mt] - acc; }
#pragma unroll
        for (int mt = 0; mt < 4; ++mt) *(LAS u32x2*)(uT + a16 * 72 + 16 * mt + 4 * kg) = pack4(u[mt]);
        bf16x8 ub[2];
#pragma unroll
        for (int k2 = 0; k2 < 2; ++k2) ub[k2] = *(const LAS bf16x8*)(uT + a16 * 72 + 32 * k2 + 8 * kg);
#pragma unroll
        for (int mt = 0; mt < 4; ++mt) { f32x4 acc = (f32x4){0.f, 0.f, 0.f, 0.f};
#pragma unroll
            for (int ks = 0; ks < 4; ++ks) acc = MFMA16(*(const LAS bf16x8*)(sQ + sw16(16 * mt + a16, 4 * ks + kg)), sb[ks], acc);
#pragma unroll
            for (int k2 = 0; k2 < 2; ++k2) acc = MFMA16(*(const LAS bf16x8*)(sA + sw8(16 * mt + a16, 4 * k2 + kg)), ub[k2], acc);
#pragma unroll
            for (int e = 0; e < 4; ++e) OG[(size_t)(b * SEQ + 64 * c + 16 * mt + 4 * kg + e) * DM + hh * 128 + 16 * sl + a16] = acc[e]; }
#pragma unroll
        for (int m = 0; m < 8; ++m) { f32x4 acc = S[m] * egl;
#pragma unroll
            for (int k2 = 0; k2 < 2; ++k2) acc = MFMA16(*(const LAS bf16x8*)(sK + sw8(16 * m + a16, 4 * k2 + kg)), ub[k2], acc);
            S[m] = acc; *(LAS u32x2*)(St + a16 * 136 + 16 * m + 4 * kg) = pack4(acc); }
        }
    }
#undef SCAN_DMA
#undef SCAN_UT
#undef SCAN_G2L
    asm volatile("s_waitcnt vmcnt(0) lgkmcnt(0)" ::: "memory"); __builtin_amdgcn_s_barrier(); asm volatile("" ::: "memory");
    float* gs = p.out + O_GSP + (size_t)((li * NB + b) * GH + hh) * 128 * 128;
    if (cwv)
#pragma unroll
    for (int m = 0; m < 8; ++m)
#pragma unroll
        for (int e = 0; e < 4; ++e) gs[(size_t)(16 * m + 4 * kg + e) * 128 + 16 * sl + a16] = S[m][e];
}
DI void gdn_sample(const P& p, const Frame& F, int li, int task) {
    const bf16* QH = (const bf16*)(p.ws + WS_QH); const bf16* KH = (const bf16*)(p.ws + WS_KH); const bf16* VH = (const bf16*)(p.ws + WS_VH);
    const float* BETA = (const float*)(p.ws + WS_BETA); const float* LOGA = (const float*)(p.ws + WS_LOGA); float* OG = (float*)(p.ws + WS_OG);
    LAS float* ks = (LAS float*)F.lds; LAS float* qs = ks + 1024; LAS float* vs = qs + 1024; LAS float* Gs = vs + 1024; LAS float* bs = Gs + 8; LAS float* KK = bs + 8; LAS float* QK = KK + 64; LAS float* red = QK + 64;
    const int b = task >> 3, hh = task & 7, rb = MP + b * 8;
#pragma unroll
    for (int e = 0; e < 6; ++e) { const int idx = F.tid + 512 * e, part = idx >> 10, i = (idx >> 7) & 7, d = idx & 127;
        const bf16* s = part == 0 ? KH : (part == 1 ? QH : VH);
        ks[idx] = bf2f(s[(size_t)(rb + i) * DM + hh * 128 + d]); }
    if (F.tid == 0) { float g = 0.f; for (int i = 0; i < 8; ++i) { g += LOGA[(size_t)(rb + i) * 8 + hh]; Gs[i] = g; bs[i] = BETA[(size_t)(rb + i) * 8 + hh]; } }
    __syncthreads();
    if (F.tid < 128) { const int which = F.tid >> 6, i = (F.tid >> 3) & 7, j = F.tid & 7; const LAS float* a = (which ? qs : ks) + i * 128; const LAS float* bb = ks + j * 128; float acc = 0.f;
        for (int d = 0; d < 128; ++d) acc += a[d] * bb[d];
        KK[which * 64 + i * 8 + j] = acc; }
    const int dv = F.tid & 127, qt = F.tid >> 7, dk0 = qt * 32;
    const float* st = (const float*)p.in[4] + ((size_t)((li * DB + b) * GH + hh) * 128 + dk0) * 128 + dv;
    float s0[32];
#pragma unroll
    for (int e = 0; e < 32; ++e) s0[e] = st[(size_t)e * 128];
    float pk[8], pq[8];
#pragma unroll
    for (int i = 0; i < 8; ++i) { pk[i] = 0.f; pq[i] = 0.f; }
#pragma unroll
    for (int e = 0; e < 32; ++e)
#pragma unroll
        for (int i = 0; i < 8; ++i) { pk[i] += ks[i * 128 + dk0 + e] * s0[e]; pq[i] += qs[i * 128 + dk0 + e] * s0[e]; }
#pragma unroll
    for (int i = 0; i < 8; ++i) { red[(qt * 16 + i) * 128 + dv] = pk[i]; red[(qt * 16 + 8 + i) * 128 + dv] = pq[i]; }
    __syncthreads();
    float u[8], eg[8];
#pragma unroll
    for (int i = 0; i < 8; ++i) { eg[i] = __expf(Gs[i]);
        const float kS = red[(0 * 16 + i) * 128 + dv] + red[(1 * 16 + i) * 128 + dv] + red[(2 * 16 + i) * 128 + dv] + red[(3 * 16 + i) * 128 + dv];
        float acc = bs[i] * (vs[i * 128 + dv] - eg[i] * kS);
#pragma unroll
        for (int j = 0; j < i; ++j) acc -= bs[i] * KK[i * 8 + j] * __expf(Gs[i] - Gs[j]) * u[j];
        u[i] = acc; }
    if (qt == 0) {
#pragma unroll
        for (int i = 0; i < 8; ++i) { const float qS = red[(0 * 16 + 8 + i) * 128 + dv] + red[(1 * 16 + 8 + i) * 128 + dv] + red[(2 * 16 + 8 + i) * 128 + dv] + red[(3 * 16 + 8 + i) * 128 + dv];
            float acc = eg[i] * qS;
#pragma unroll
            for (int j = 0; j <= i; ++j) acc += QK[i * 8 + j] * __expf(Gs[i] - Gs[j]) * u[j];
            OG[(size_t)(rb + i) * DM + hh * 128 + dv] = acc; } }
    float* so = p.out + O_GSS + ((size_t)((li * DB + b) * GH + hh) * 128 + dk0) * 128 + dv;
    float tl[8];
#pragma unroll
    for (int i = 0; i < 8; ++i) tl[i] = __expf(Gs[7] - Gs[i]) * u[i];
#pragma unroll
    for (int e = 0; e < 32; ++e) { float acc = eg[7] * s0[e];
#pragma unroll
        for (int i = 0; i < 8; ++i) acc += ks[i * 128 + dk0 + e] * tl[i];
        so[(size_t)e * 128] = acc; }
    __syncthreads();
}
DI void gdn_gate(const P& p, const Frame& F, int li) {
    const float* OG = (const float*)(p.ws + WS_OG); const bf16* H = (const bf16*)(p.ws + WS_H); bf16* AO = (bf16*)(p.ws + WS_AO);
    const f32x4 nw = *(const f32x4*)((const float*)p.in[14] + li * 128 + ((4 * F.lane) & 127));
    for (int row = F.gw; row < M; row += F.ngw) {
        f32x4 v[4]; u32x2 z[4];
#pragma unroll
        for (int k = 0; k < 4; ++k) { const int c = (k * 64 + F.lane) * 4; v[k] = *(const f32x4*)(OG + (size_t)row * DM + c); z[k] = *(const u32x2*)(H + (size_t)row * GINP + 3072 + c); }
#pragma unroll
        for (int k = 0; k < 4; ++k) { const int c = (k * 64 + F.lane) * 4;
            float s2 = (v[k][0] * v[k][0] + v[k][1] * v[k][1]) + (v[k][2] * v[k][2] + v[k][3] * v[k][3]);
            s2 = sum32(s2);
            const float rs = __builtin_amdgcn_rsqf(s2 * (1.f / 128.f) + 1e-6f);
            *(u32x2*)(AO + (size_t)row * DM + c) = (u32x2){pk2(v[k][0] * rs * nw[0] * siluf_(bflo(z[k].x)), v[k][1] * rs * nw[1] * siluf_(bfhi(z[k].x))), pk2(v[k][2] * rs * nw[2] * siluf_(bflo(z[k].y)), v[k][3] * rs * nw[3] * siluf_(bfhi(z[k].y)))}; }
    }
}

DI void nsa_transpose(const P& p, const Frame& F, int li) {
    const bf16* H = (const bf16*)(p.ws + WS_H);
    bf16* kslc = (bf16*)(p.ws + WS_KSLC_S + li * SZ_SLC_S); bf16* vslc = (bf16*)(p.ws + WS_VSLCT_S + li * SZ_SLC_S);
    bf16* kwin = (bf16*)(p.ws + WS_KWIN_S + li * SZ_WIN_S); bf16* vwin = (bf16*)(p.ws + WS_VWINT_S + li * SZ_WIN_S);
    for (int idx = F.gw * 64 + F.lane; idx < DB * DS * 512; idx += F.ngw * 64) {
        const int c = idx & 511, rs = idx >> 9, b = rs >> 3, t = rs & 7, kind = c >> 7, g = (c >> 6) & 1, d = c & 63;
        const bf16 v = H[(size_t)(MP + rs) * NINP + 1280 + c];
        if (kind == 0) kslc[((size_t)(b * 2 + g) * SLC_S_ROWS + PAST + t) * 64 + d] = v;
        else if (kind == 1) vslc[((size_t)(b * 2 + g) * SLC_S_ROWS + PAST + t) * 64 + d] = v;
        else if (kind == 2) kwin[((size_t)(b * 2 + g) * WIN_S_ROWS + 512 + t) * 64 + d] = v;
        else vwin[((size_t)(b * 2 + g) * WIN_S_ROWS + 512 + t) * 64 + d] = v;
    }
}
struct CmpOrder {
    int G, c, li; unsigned char* ws; int base, count;
    DI bool next(int i, pg8::Unit& u) const {
        const int L = base + i * G + c; if (i * G + c >= count) return false;
        if (L < 32) { u.z = L >> 3; u.pm = (L >> 1) & 3; u.pn = L & 1;
            u.A = (const char*)(ws + WS_CMPP) + ((size_t)u.pm * 256 * 4096 + (u.z >> 1) * 128 + (u.z & 1) * 64) * 2; u.C = (char*)(ws + WS_PC_P) + (size_t)u.z * 1024 * 512 * 2; }
        else { const int L2 = L - 32; u.z = L2 >> 7; u.pm = (L2 >> 1) & 63; u.pn = L2 & 1;
            u.A = (const char*)(ws + WS_CMPS + li * SZ_CMPS) + ((size_t)u.pm * 256 * 4096 + (u.z >> 1) * 128 + (u.z & 1) * 64) * 2; u.C = (char*)(ws + WS_PC_S) + (size_t)u.z * 16384 * 512 * 2; }
        u.B = (const char*)(ws + WS_WC1 + (li * 2 + (u.z >> 1)) * SZ_WC1) + (size_t)u.pn * 256 * 1024 * 2;
        return true;
    }
};
DI void nsa_cmp2(const P& p, const Frame& F, int li) {
    constexpr int WP = 264;
    LAS bf16* w2t = (LAS bf16*)F.lds;
    LAS bf16* hid = (LAS bf16*)(F.lds + 36864 + F.wave * 8704);
    const float* cb = (const float*)(p.ws + WS_CBIAS);
    constexpr int NH_P = NB * 2 * 16, NH_S = DB * 2 * 8, NH = NH_P + NH_S;
    const int a16 = F.lane & 15, kg = F.lane >> 4;
#pragma unroll 1
    for (int kv = 0; kv < 2; ++kv) {
        __syncthreads();
        { const float* w2g = (const float*)(kv ? p.in[22] : p.in[20]) + (size_t)li * 256 * 64;
          for (int i = F.tid; i < 256 * 64; i += 512) w2t[(i & 63) * WP + (i >> 6)] = (bf16)f2bf(w2g[i]); }
        __syncthreads();
        const f32x4 bv = *(const f32x4*)(cb + (li * 2 + kv) * 256 + 4 * F.lane);
        for (int id = F.gw; id < NH; id += F.ngw) {
            int b, n0, g, segs, npad, ncmp; const bf16* PC; bf16* DST;
            if (id < NH_P) { n0 = (id & 15) * 16; g = (id >> 4) & 1; b = id >> 5; segs = 256; npad = 256; ncmp = NCMP_P; PC = (const bf16*)(p.ws + WS_PC_P) + (size_t)(kv * 2 + g) * 1024 * 512; DST = (bf16*)(p.ws + (kv ? WS_VCT_P : WS_KC_P)); }
            else { const int i2 = id - NH_P; n0 = (i2 & 7) * 16; g = (i2 >> 3) & 1; b = i2 >> 4; segs = 128; npad = 128; ncmp = NCMP_S; PC = (const bf16*)(p.ws + WS_PC_S) + (size_t)(kv * 2 + g) * 16384 * 512; DST = (bf16*)(p.ws + (kv ? WS_VCT_S : WS_KC_S)); }
            const size_t ri = (size_t)b * segs + n0;
#pragma unroll
            for (int hb = 0; hb < 2; ++hb) { u32x2 a0[8], a1[8];
#pragma unroll
                for (int e = 0; e < 8; ++e) { const int n = 8 * hb + e; const bool ok = n0 + n < ncmp; a0[e] = ok ? *(const u32x2*)(PC + (ri + n) * 512 + 4 * F.lane) : (u32x2){0u, 0u}; a1[e] = ok ? *(const u32x2*)(PC + (ri + n + 1) * 512 + 256 + 4 * F.lane) : (u32x2){0u, 0u}; }
#pragma unroll
                for (int e = 0; e < 8; ++e) { const float h0 = siluf_(bflo(a0[e].x) + bflo(a1[e].x) + bv[0]), h1 = siluf_(bfhi(a0[e].x) + bfhi(a1[e].x) + bv[1]), h2 = siluf_(bflo(a0[e].y) + bflo(a1[e].y) + bv[2]), h3 = siluf_(bfhi(a0[e].y) + bfhi(a1[e].y) + bv[3]);
                    *(LAS u32x2*)(hid + (8 * hb + e) * WP + 4 * F.lane) = (u32x2){pk2(h0, h1), pk2(h2, h3)}; } }
            LDS_WAIT();
            f32x4 acc[4];
#pragma unroll
            for (int dt = 0; dt < 4; ++dt) acc[dt] = (f32x4){0.f, 0.f, 0.f, 0.f};
#pragma unroll
            for (int ks = 0; ks < 8; ++ks) { const bf16x8 af = *(const LAS bf16x8*)(hid + a16 * WP + 32 * ks + 8 * kg);
#pragma unroll
                for (int dt = 0; dt < 4; ++dt) acc[dt] = MFMA16(af, *(const LAS bf16x8*)(w2t + (16 * dt + a16) * WP + 32 * ks + 8 * kg), acc[dt]); }
#pragma unroll
            for (int dt = 0; dt < 4; ++dt)
#pragma unroll
                for (int e = 0; e < 4; ++e) { const int n = n0 + 4 * kg + e; if (n < ncmp) DST[((size_t)(b * 2 + g) * npad + n) * 64 + 16 * dt + a16] = (bf16)f2bf(acc[dt][e]); }
            LDS_WAIT();
        }
    }
}

struct AttnAcc { f32x16 o0, o1; float m, l; };
DI void attn_reset(AttnAcc& a) { for (int e = 0; e < 16; ++e) { a.o0[e] = 0.f; a.o1[e] = 0.f; } a.m = -__builtin_inff(); a.l = 0.f; }
constexpr float ATT_C = 1.0f;
constexpr float ATT_QS = 0.18033688011112042f;
DI f32x16 attn_scores(const LAS unsigned char* kt, int sb, const bf16x8 (&qf)[4], int r, int h) {
    f32x16 s; for (int e = 0; e < 16; ++e) s[e] = 0.f;
    const int row = 32 * sb + r, swz = (row >> 1) & 7; const LAS unsigned char* base = kt + row * 128;
#pragma unroll
    for (int st = 0; st < 4; ++st) s = MFMA32(*(const LAS bf16x8*)(base + (((2 * st + h) ^ swz) << 4)), qf[st], s);
    return s;
}
template <bool WIN> DI void attn_mask(f32x16& s, int hi) {
#pragma unroll
    for (int e = 0; e < 16; ++e) { const int ce = (e & 3) + 8 * (e >> 2); const bool v = WIN ? ((unsigned)(hi - ce) <= 512u) : (ce <= hi); s[e] = v ? s[e] : -__builtin_inff(); }
}
typedef short v4i16_t __attribute__((ext_vector_type(4)));
DI s16x4 vtr(const LAS unsigned char* p) { return __builtin_bit_cast(s16x4, __builtin_amdgcn_ds_read_tr16_b64_v4i16((LAS v4i16_t*)p)); }
DI void attn_pv(AttnAcc& a, const f32x16& p0, const f32x16& p1, const LAS unsigned char* vt, int r, int h) {
    const int q = (r >> 2) & 3, pp4 = r & 3, dg = r >> 4;
#pragma unroll
    for (int s4 = 0; s4 < 4; ++s4) {
        const f32x16& pp = s4 < 2 ? p0 : p1; const int o = 8 * (s4 & 1);
        u32x4 pw; pw.x = pg8::cvt_pk_bf16(pp[o], pp[o + 1]); pw.y = pg8::cvt_pk_bf16(pp[o + 2], pp[o + 3]); pw.z = pg8::cvt_pk_bf16(pp[o + 4], pp[o + 5]); pw.w = pg8::cvt_pk_bf16(pp[o + 6], pp[o + 7]);
        const bf16x8 pf = __builtin_bit_cast(bf16x8, pw);
        const int k1 = 16 * s4 + 4 * h + q, k2 = k1 + 8;
        const LAS unsigned char* r1 = vt + k1 * 128 + 8 * (pp4 & 1); const LAS unsigned char* r2 = vt + k2 * 128 + 8 * (pp4 & 1);
        const int z1 = (k1 >> 1) & 7, z2 = (k2 >> 1) & 7;
        { const int ch = 2 * dg + (pp4 >> 1);
          const s16x4 lo = vtr(r1 + ((ch ^ z1) << 4)), hi = vtr(r2 + ((ch ^ z2) << 4));
          a.o0 = MFMA32(__builtin_shufflevector(lo, hi, 0, 1, 2, 3, 4, 5, 6, 7), pf, a.o0); }
        { const int ch = 4 + 2 * dg + (pp4 >> 1);
          const s16x4 lo = vtr(r1 + ((ch ^ z1) << 4)), hi = vtr(r2 + ((ch ^ z2) << 4));
          a.o1 = MFMA32(__builtin_shufflevector(lo, hi, 0, 1, 2, 3, 4, 5, 6, 7), pf, a.o1); }
    }
}
template <bool WIN> DI void attn_chunk(AttnAcc& a, const LAS unsigned char* kt, const bf16x8 (&qf)[4], int hi0, int hi1, bool allv, bool lv, int r, int h) {
    f32x16 s0 = attn_scores(kt, 0, qf, r, h), s1 = attn_scores(kt, 1, qf, r, h);
    if (!allv) { attn_mask<WIN>(s0, hi0); attn_mask<WIN>(s1, hi1); }
    float mx = fmaxf(s0[0], s1[0]);
#pragma unroll
    for (int e = 1; e < 16; ++e) mx = fmaxf(mx, fmaxf(s0[e], s1[e]));
    mx = xor32_max(mx) * ATT_C; mx = lv ? mx : -__builtin_inff();
    const float mn = fmaxf(a.m, mx), mu = lv ? ((mn == -__builtin_inff()) ? 0.f : mn) : __builtin_inff();
    float ps = 0.f;
#pragma unroll
    for (int e = 0; e < 16; ++e) { s0[e] = __builtin_amdgcn_exp2f(__builtin_fmaf(s0[e], ATT_C, -mu)); s1[e] = __builtin_amdgcn_exp2f(__builtin_fmaf(s1[e], ATT_C, -mu)); ps += s0[e] + s1[e]; }
    ps = xor32_sum(ps);
    if (__ballot(mn != a.m) != 0ull) {
        const float sc = (a.m == -__builtin_inff()) ? 0.f : __builtin_amdgcn_exp2f(a.m - mn);
        a.l = a.l * sc + ps; a.o0 = a.o0 * sc; a.o1 = a.o1 * sc;
    } else a.l += ps;
    a.m = mn;
    attn_pv(a, s0, s1, kt + 8192, r, h);
}

namespace nb {
typedef __attribute__((address_space(3))) const char* lds_cptr;
constexpr int NSLOT = 3, SLOTB = 8192;
constexpr int LDS_K = 0, LDS_V = NSLOT * SLOTB, LDS_WS = 2 * NSLOT * SLOTB, LDS_OST = 65536, LDS_END = LDS_OST + 8 * 4096;
constexpr int LDS_TL = 98304 + 256;
#define NB_SBAR() __builtin_amdgcn_sched_barrier(0)
#define NB_WAIT_BAR(N) asm volatile("s_waitcnt vmcnt(" #N ") lgkmcnt(0)\n\ts_barrier" ::: "memory")
DI void glds16(const void* gsrc, unsigned lds_dst) { unsigned keep;
    asm volatile("s_mov_b32 %0, m0\n\ts_mov_b32 m0, %2\n\ts_nop 0\n\tglobal_load_lds_dwordx4 %1, off\n\ts_mov_b32 m0, %0" : "=&s"(keep) : "v"(gsrc), "s"(lds_dst) : "memory"); }
DI float max3f(float a, float b, float c) { float r; asm("v_max3_f32 %0, %1, %2, %3" : "=v"(r) : "v"(a), "v"(b), "v"(c)); return r; }
DI float max2f(float a, float b) { float r; asm("v_max_f32_e32 %0, %1, %2" : "=v"(r) : "v"(a), "v"(b)); return r; }
DI float fadd_s(float a, float b) { float r; asm("v_add_f32_e32 %0, %1, %2" : "=v"(r) : "v"(a), "v"(b)); return r; }
DI float fsub_s(float a, float b) { float r; asm("v_sub_f32_e32 %0, %1, %2" : "=v"(r) : "v"(a), "v"(b)); return r; }
typedef float f32x2_t __attribute__((ext_vector_type(2))); typedef __bf16 bf16x2_t __attribute__((ext_vector_type(2)));
DI unsigned cvtpk_s(float lo, float hi) { f32x2_t v = {lo, hi}; bf16x2_t b = __builtin_convertvector(v, bf16x2_t); return __builtin_bit_cast(unsigned, b); }
DI void qkt(f32x16& p0, f32x16& p1, lds_cptr Kslot, const bf16x8* qr, const f32x16& negm, int r32, int hi) {
    const lds_cptr kb = Kslot + hi * 1024 + r32 * 16;
#pragma unroll
    for (int d0 = 0; d0 < 4; ++d0) {
        const bf16x8 b0 = *(const LAS bf16x8*)(kb + d0 * 2048);
        const bf16x8 b1 = *(const LAS bf16x8*)(kb + d0 * 2048 + 512);
        if (d0 == 0) { p0 = __builtin_amdgcn_mfma_f32_32x32x16_bf16(b0, qr[0], negm, 0, 0, 0); p1 = __builtin_amdgcn_mfma_f32_32x32x16_bf16(b1, qr[0], negm, 0, 0, 0); }
        else { p0 = __builtin_amdgcn_mfma_f32_32x32x16_bf16(b0, qr[d0], p0, 0, 0, 0); p1 = __builtin_amdgcn_mfma_f32_32x32x16_bf16(b1, qr[d0], p1, 0, 0, 0); } }
}
DI void kload8(bf16x8* kf, lds_cptr kp) {
    kf[0] = *(const LAS bf16x8*)(kp);        kf[1] = *(const LAS bf16x8*)(kp + 512);
    kf[2] = *(const LAS bf16x8*)(kp + 2048); kf[3] = *(const LAS bf16x8*)(kp + 2560);
    kf[4] = *(const LAS bf16x8*)(kp + 4096); kf[5] = *(const LAS bf16x8*)(kp + 4608);
    kf[6] = *(const LAS bf16x8*)(kp + 6144); kf[7] = *(const LAS bf16x8*)(kp + 6656);
}
DI void kload2(bf16x8* kf, lds_cptr kp, int j) { kf[2 * j] = *(const LAS bf16x8*)(kp + j * 2048); kf[2 * j + 1] = *(const LAS bf16x8*)(kp + j * 2048 + 512); }
typedef short v4i16_t __attribute__((ext_vector_type(4)));
DI s16x4 vtr(lds_cptr p) { return __builtin_bit_cast(s16x4, __builtin_amdgcn_ds_read_tr16_b64_v4i16((LAS v4i16_t*)p)); }
DI float rowmax(const f32x16& p0, const f32x16& p1) {
    float a = max3f(p0[0], p0[1], p1[0]), b = max3f(p0[2], p0[3], p1[1]); a = max3f(a, p1[2], p1[3]);
#pragma unroll
    for (int r = 4; r < 16; r += 4) { a = max3f(a, p0[r], p0[r + 1]); b = max3f(b, p0[r + 2], p0[r + 3]); a = max3f(a, p1[r], p1[r + 1]); b = max3f(b, p1[r + 2], p1[r + 3]); }
    const float m = max2f(a, b);
    auto rr = __builtin_amdgcn_permlane32_swap(__float_as_uint(m), __float_as_uint(m), false, false);
    return max2f(__uint_as_float(rr[0]), __uint_as_float(rr[1]));
}
DI void pv(f32x16* o, int vb, bf16x8 pa0, bf16x8 pa1, bf16x8 pa2, bf16x8 pa3) {
#pragma unroll
    for (int d0 = 0; d0 < 2; ++d0) { s16x4 lo[4], hi[4];
#pragma unroll
        for (int ks = 0; ks < 4; ++ks) {
            asm volatile("ds_read_b64_tr_b16 %0,%1 offset:%c2" : "=&v"(lo[ks]) : "v"(vb), "i"(d0 * 4096 + ks * 1024) : "memory");
            asm volatile("ds_read_b64_tr_b16 %0,%1 offset:%c2" : "=&v"(hi[ks]) : "v"(vb), "i"(d0 * 4096 + ks * 1024 + 512) : "memory"); }
        asm volatile("s_waitcnt lgkmcnt(0)" ::: "memory"); NB_SBAR();
#define NB_PK(k) (bf16x8){lo[k][0], lo[k][1], lo[k][2], lo[k][3], hi[k][0], hi[k][1], hi[k][2], hi[k][3]}
        o[d0] = __builtin_amdgcn_mfma_f32_32x32x16_bf16(pa0, NB_PK(0), o[d0], 0, 0, 0);
        o[d0] = __builtin_amdgcn_mfma_f32_32x32x16_bf16(pa1, NB_PK(1), o[d0], 0, 0, 0);
        o[d0] = __builtin_amdgcn_mfma_f32_32x32x16_bf16(pa2, NB_PK(2), o[d0], 0, 0, 0);
        o[d0] = __builtin_amdgcn_mfma_f32_32x32x16_bf16(pa3, NB_PK(3), o[d0], 0, 0, 0);
#undef NB_PK
    }
}
DI void gmask(f32x16& p0, f32x16& p1, int hl, unsigned wd) {
    const float NEG = -__builtin_inff();
#pragma unroll
    for (int r = 0; r < 16; ++r) { const int ce = (r & 3) + 8 * (r >> 2); if ((unsigned)(hl - ce) > wd) p0[r] = NEG; if ((unsigned)(hl - 32 - ce) > wd) p1[r] = NEG; }
}
template <int THRL> DI void ring_unit(const int MODE, const bool LAST, const bf16* Qw, int ldq, const bf16* Kt, const bf16* Vt, int ld, const LAS int* tl, int NT, int posbase,
                                                          int pos0w  , unsigned long long m0, unsigned long long m1, unsigned long long m2, unsigned long long m3  ,
                                                          const bf16* gatep  , int br, bool store_ok, bf16* Ow, char* shm) {
    int tid_ = threadIdx.x; asm volatile("" : "+v"(tid_));
    const int tid = tid_, lane = tid & 63, r32 = lane & 31, hi = lane >> 5; const int wid = __builtin_amdgcn_readfirstlane(tid >> 6);
    const unsigned lds0 = (unsigned)(uintptr_t)shm;
    const bf16* ksrc = Kt + (long)lane * ld + wid * 8;
    const bf16* vsrc = Vt + (long)(16 * (wid & 3) + (lane >> 2)) * ld + (wid >> 2) * 32 + (lane & 3) * 8;
    const unsigned kdst = lds0 + LDS_K + wid * 1024, vdst = lds0 + LDS_V + wid * 1024;
#define NB_TL(t) __builtin_amdgcn_readfirstlane(tl[(t)])
    int dq0, dq1, dq2, dq3;
#define NB_DMA_KD(dd, slot) do { int d_ = (dd); d_ = d_ < 0 ? 0 : d_; nb::glds16(ksrc + (long)d_ * 64 * ld, (unsigned)__builtin_amdgcn_readfirstlane(kdst + (slot))); } while (0)
#define NB_DMA_VD(dd, slot) do { int d_ = (dd); d_ = d_ < 0 ? 0 : d_; nb::glds16(vsrc + (long)d_ * 64 * ld, (unsigned)__builtin_amdgcn_readfirstlane(vdst + (slot))); } while (0)
#define NB_DMA_K(t, slot) do { int d_ = NB_TL(t); d_ = d_ < 0 ? 0 : d_; nb::glds16(ksrc + (long)d_ * 64 * ld, (unsigned)__builtin_amdgcn_readfirstlane(kdst + (slot))); } while (0)
#define NB_DMA_V(t, slot) do { int d_ = NB_TL(t); d_ = d_ < 0 ? 0 : d_; nb::glds16(vsrc + (long)d_ * 64 * ld, (unsigned)__builtin_amdgcn_readfirstlane(vdst + (slot))); } while (0)
    const int vb0 = (int)(lds0 + LDS_V) + ((lane >> 4) & 1) * 32 + (lane & 3) * 8 + (4 * hi + ((lane & 15) >> 2)) * 64;
    bf16x8 kf[8];
    const lds_cptr shm3 = (lds_cptr)shm; const lds_cptr Kbase = shm3 + LDS_K;
    LAS float* wsf = (LAS float*)((LAS char*)shm3 + LDS_WS) + wid * 64; const lds_cptr kp0 = shm3 + LDS_K + hi * 1024 + r32 * 16; const lds_cptr vp0 = shm3 + LDS_V + ((lane >> 4) & 1) * 32 + (lane & 3) * 8 + (4 * hi + ((lane & 15) >> 2)) * 64;
    NB_DMA_K(0, 0); NB_DMA_V(0, 0); NB_DMA_K(1, SLOTB);
    bf16x8 qr[4];
    { const bf16* qp = Qw + (long)(r32 >> 3) * ldq + (r32 & 7) * 64 + hi * 8;
#pragma unroll
      for (int d0 = 0; d0 < 4; ++d0) qr[d0] = *reinterpret_cast<const bf16x8*>(qp + d0 * 16); }
    float mhat = 0.f, l_reg = 0.f; f32x16 o[2]; o[0] = f32x16{}; o[1] = f32x16{}; f32x16 negm = f32x16{}; asm volatile("" : "+v"(negm));
#define NB_CMASK(P0, P1, t) NB_CMASKD(P0, P1, NB_TL(t))
#define NB_CMASKD(P0, P1, dd) do { const int d_ = (dd); int hl_; unsigned wd_; bool full_; \
        const int trow_ = pos0w + (r32 >> 3); \
        if (MODE == 0) { const int pb_ = 64 * d_ + posbase; full_ = d_ >= 0 && pb_ + 63 <= pos0w && pb_ >= pos0w + 3 - 512; } \
        else { const int ds_ = d_ & 63; full_ = d_ >= 0 && ((m0 & m1 & m2 & m3) >> ds_ & 1ull) && 64 * d_ + 63 <= pos0w; } \
        if (full_) break; \
        if (MODE == 0) { hl_ = d_ < 0 ? -1 : trow_ - (64 * d_ + posbase) - 4 * hi; wd_ = 512u; } \
        else { const int ds_ = d_ & 63; const unsigned b4_ = (unsigned)((m0 >> ds_) & 1ull) | ((unsigned)((m1 >> ds_) & 1ull) << 1) | ((unsigned)((m2 >> ds_) & 1ull) << 2) | ((unsigned)((m3 >> ds_) & 1ull) << 3); \
               const bool mine_ = d_ >= 0 && ((b4_ >> (r32 >> 3)) & 1u); hl_ = mine_ ? trow_ - 64 * d_ - 4 * hi : -1; wd_ = 0x7fffffffu; } \
        nb::gmask(P0, P1, hl_, wd_); } while (0)
    bool resc = false;
#define NB_START(P0, P1) do { const float rm = nb::rowmax(P0, P1); resc = false; \
    { const float dl = (rm == -__builtin_inff()) ? 0.f : rm; mhat = nb::fadd_s(mhat, dl); \
      _Pragma("unroll") for (int r = 0; r < 16; ++r) { P0[r] = nb::fsub_s(P0[r], dl); P1[r] = nb::fsub_s(P1[r], dl); } \
      _Pragma("unroll") for (int r = 0; r < 16; ++r) negm[r] = -mhat; asm volatile("" : "+v"(negm)); } \
    _Pragma("unroll") for (int r = 0; r < 16; ++r) P0[r] = __builtin_amdgcn_exp2f(P0[r]); } while (0)
#define NB_RESC() do { if (resc) { asm volatile("s_waitcnt lgkmcnt(0)" ::: "memory"); \
      _Pragma("unroll") for (int d_ = 0; d_ < 2; ++d_) _Pragma("unroll") for (int r = 0; r < 16; ++r) o[d_][r] *= wsf[crow(r, hi)]; } } while (0)
    f32x16 pA0, pA1, pB0, pB1;
    int sl_prev = 0, sl_cur = 0, sl_next = SLOTB;
#define NB_ROT() do { sl_prev = sl_cur; sl_cur = sl_next; sl_next = (sl_next == (NSLOT - 1) * SLOTB) ? 0 : sl_next + SLOTB; } while (0)
#define NB_SHIFT(tn) do { dq0 = dq1; dq1 = dq2; dq2 = dq3; dq3 = NB_TL((tn) + 3 < 95 ? (tn) + 3 : 95); } while (0)
    NB_DMA_K(2, 2 * SLOTB);
    NB_WAIT_BAR(3);
    nb::qkt(pA0, pA1, Kbase, qr, negm, r32, hi); asm volatile("s_nop 15\n\ts_nop 7" : "+v"(pA0), "+v"(pA1)); NB_CMASK(pA0, pA1, 0);
    NB_START(pA0, pA1);
    _Pragma("unroll") for (int r = 0; r < 16; ++r) pA1[r] = __builtin_amdgcn_exp2f(pA1[r]);
    NB_WAIT_BAR(0);
    NB_DMA_K(3, 0); NB_DMA_V(1, SLOTB);
    NB_ROT();
    nb::kload8(kf, kp0 + sl_cur);
    NB_WAIT_BAR(2);
    dq0 = NB_TL(1); dq1 = NB_TL(2); dq2 = NB_TL(3); dq3 = NB_TL(4);
    s16x4 vlo[8], vhi[8]; u32x4 pw0, pw1, pw2, pw3;
#define NB_PKW(P, B) nb::cvtpk_s(P[B], P[B + 1])
#define NB_PAF(k) __builtin_bit_cast(bf16x8, pw##k)
#define NB_VFR(i) (bf16x8){vlo[i][0], vlo[i][1], vlo[i][2], vlo[i][3], vhi[i][0], vhi[i][1], vhi[i][2], vhi[i][3]}
#define NB_PIN(x) asm volatile("" : "+v"(x))
#define NB_MX3(a, b, c) __builtin_fmaxf(__builtin_fmaxf((a), (b)), (c))
#define NB_GAPA(MF, A0, A1, A2, A3, W0, W1, PW) do { MF; sacc += A0; sacc += A1; sacc += A2; sacc += A3; NB_PIN(sacc); W0; W1; NB_PIN(PW); NB_SBAR(); } while (0)
#define NB_EX(v) __builtin_amdgcn_exp2f(v)
#define NB_GAPB(MF, X, B) do { MF; X[B] = NB_EX(X[B]); X[B + 1] = NB_EX(X[B + 1]); X[B + 2] = NB_EX(X[B + 2]); X[B + 3] = NB_EX(X[B + 3]); NB_PIN(X); NB_SBAR(); } while (0)
#define NB_VRD(i) do { vlo[i] = nb::vtr(vp_ + (((i) >> 2) * 4096 + ((i) & 3) * 1024)); vhi[i] = nb::vtr(vp_ + (((i) >> 2) * 4096 + ((i) & 3) * 1024 + 512)); } while (0)
#define NB_KRD(G, j) do { if (G) { nb::kload2(kf, kp0 + sl_next, j); NB_SBAR(); } } while (0)
#define NB_MF(...) __builtin_amdgcn_mfma_f32_32x32x16_bf16(__VA_ARGS__, 0, 0, 0)
#define NB_STEP(C0, C1, P0, P1, t, GK, GV, GL) do { NB_SBAR(); \
    const lds_cptr vp_ = vp0 + sl_prev; \
    NB_VRD(0); NB_SBAR(); float sacc = (P0[0] + P0[1]); \
    NB_GAPA(C0 = NB_MF(kf[0], qr[0], negm), P0[2], P0[3], P0[4], P0[5],     pw0[0] = NB_PKW(P0, 0), pw0[1] = NB_PKW(P0, 2), pw0); \
    NB_VRD(4); NB_SBAR(); NB_GAPA(C1 = NB_MF(kf[1], qr[0], negm), P0[6], P0[7], P0[8], P0[9],     pw0[2] = NB_PKW(P0, 4), pw0[3] = NB_PKW(P0, 6), pw0); \
    NB_VRD(1); NB_SBAR(); NB_GAPA(C0 = NB_MF(kf[2], qr[1], C0),   P0[10], P0[11], P0[12], P0[13], pw1[0] = NB_PKW(P0, 8), pw1[1] = NB_PKW(P0, 10), pw1); \
    NB_VRD(5); NB_SBAR(); NB_GAPA(C1 = NB_MF(kf[3], qr[1], C1),   P0[14], P0[15], P1[0], P1[1],   pw1[2] = NB_PKW(P0, 12), pw1[3] = NB_PKW(P0, 14), pw1); \
    NB_VRD(2); NB_SBAR(); NB_GAPA(C0 = NB_MF(kf[4], qr[2], C0),   P1[2], P1[3], P1[4], P1[5],     pw2[0] = NB_PKW(P1, 0), pw2[1] = NB_PKW(P1, 2), pw2); \
    NB_VRD(6); NB_SBAR(); NB_GAPA(C1 = NB_MF(kf[5], qr[2], C1),   P1[6], P1[7], P1[8], P1[9],     pw2[2] = NB_PKW(P1, 4), pw2[3] = NB_PKW(P1, 6), pw2); \
    NB_VRD(3); NB_SBAR(); NB_GAPA(C0 = NB_MF(kf[6], qr[3], C0),   P1[10], P1[11], P1[12], P1[13], pw3[0] = NB_PKW(P1, 8), pw3[1] = NB_PKW(P1, 10), pw3); \
    NB_VRD(7); NB_SBAR(); NB_GAPA(C1 = NB_MF(kf[7], qr[3], C1),   P1[14], P1[15], 0.f, 0.f,       pw3[2] = NB_PKW(P1, 12), pw3[3] = NB_PKW(P1, 14), pw3); \
    l_reg += sacc; \
    if (GK) { NB_DMA_KD(dq3, sl_cur); } if (GV) { NB_DMA_VD(dq1, sl_next); } \
    NB_CMASKD(C0, C1, dq0); \
    { float a = NB_MX3(C0[0], C0[1], C1[0]), b = NB_MX3(C0[2], C0[3], C1[1]); a = NB_MX3(a, C1[2], C1[3]); \
      _Pragma("unroll") for (int r = 4; r < 16; r += 4) { a = NB_MX3(a, C0[r], C0[r + 1]); b = NB_MX3(b, C0[r + 2], C0[r + 3]); a = NB_MX3(a, C1[r], C1[r + 1]); b = NB_MX3(b, C1[r + 2], C1[r + 3]); } \
      float rm = __builtin_fmaxf(a, b); { auto rr = __builtin_amdgcn_permlane32_swap(__float_as_uint(rm), __float_as_uint(rm), false, false); rm = __builtin_fmaxf(__uint_as_float(rr[0]), __uint_as_float(rr[1])); } \
      resc = false; \
      if (__builtin_expect(__any(rm > (float)THRL), 0)) { const float dl = __builtin_fmaxf(rm, 0.f); mhat += dl; \
        _Pragma("unroll") for (int r = 0; r < 16; ++r) { C0[r] -= dl; C1[r] -= dl; } \
        _Pragma("unroll") for (int r = 0; r < 16; ++r) negm[r] = -mhat; asm volatile("" : "+v"(negm)); \
        const float f = __builtin_amdgcn_exp2f(-dl); l_reg *= f; if (hi == 0) wsf[r32] = f; resc = true; } } \
    NB_SBAR(); \
    NB_GAPB(o[0] = NB_MF(NB_PAF(0), NB_VFR(0), o[0]), C0, 0); \
    NB_GAPB(o[1] = NB_MF(NB_PAF(0), NB_VFR(4), o[1]), C0, 4); \
    NB_KRD(GL, 0); NB_GAPB(o[0] = NB_MF(NB_PAF(1), NB_VFR(1), o[0]), C0, 8); \
    NB_KRD(GL, 1); NB_GAPB(o[1] = NB_MF(NB_PAF(1), NB_VFR(5), o[1]), C0, 12); \
    NB_KRD(GL, 2); NB_GAPB(o[0] = NB_MF(NB_PAF(2), NB_VFR(2), o[0]), C1, 0); \
    NB_KRD(GL, 3); NB_GAPB(o[1] = NB_MF(NB_PAF(2), NB_VFR(6), o[1]), C1, 4); \
    NB_GAPB(o[0] = NB_MF(NB_PAF(3), NB_VFR(3), o[0]), C1, 8); \
    NB_GAPB(o[1] = NB_MF(NB_PAF(3), NB_VFR(7), o[1]), C1, 12); \
    } while (0)
    int t = 1;
    for (; t + 5 < NT; t += 2) {
        NB_STEP(pB0, pB1, pA0, pA1, t, true, true, true);     NB_WAIT_BAR(2); NB_SHIFT(t + 1); NB_RESC(); NB_ROT();
        NB_STEP(pA0, pA1, pB0, pB1, t + 1, true, true, true); NB_WAIT_BAR(2); NB_SHIFT(t + 2); NB_RESC(); NB_ROT();
    }
#define NB_ENDW(tt) do { if ((tt) + 3 < NT) { NB_WAIT_BAR(2); } else if ((tt) + 2 < NT) { NB_WAIT_BAR(1); } else { NB_WAIT_BAR(0); } } while (0)
    for (; t + 1 < NT; t += 2) {
        NB_STEP(pB0, pB1, pA0, pA1, t, (t + 3 < NT), (t + 1 < NT), (t + 1 < NT));         NB_ENDW(t);     NB_SHIFT(t + 1); NB_RESC(); NB_ROT();
        NB_STEP(pA0, pA1, pB0, pB1, t + 1, (t + 4 < NT), (t + 2 < NT), (t + 2 < NT));     NB_ENDW(t + 1); NB_SHIFT(t + 2); NB_RESC(); NB_ROT();
    }
    NB_STEP(pB0, pB1, pA0, pA1, NT - 1, false, false, false); NB_RESC();
    { float sacc = pB0[0] + pB0[1]; _Pragma("unroll") for (int r = 2; r < 16; ++r) sacc += pB0[r]; _Pragma("unroll") for (int r = 0; r < 16; ++r) sacc += pB1[r]; l_reg += sacc;
      pw0 = (u32x4){NB_PKW(pB0, 0), NB_PKW(pB0, 2), NB_PKW(pB0, 4), NB_PKW(pB0, 6)}; pw1 = (u32x4){NB_PKW(pB0, 8), NB_PKW(pB0, 10), NB_PKW(pB0, 12), NB_PKW(pB0, 14)};
      pw2 = (u32x4){NB_PKW(pB1, 0), NB_PKW(pB1, 2), NB_PKW(pB1, 4), NB_PKW(pB1, 6)}; pw3 = (u32x4){NB_PKW(pB1, 8), NB_PKW(pB1, 10), NB_PKW(pB1, 12), NB_PKW(pB1, 14)};
      NB_SBAR(); nb::pv(o, vb0 + sl_cur, NB_PAF(0), NB_PAF(1), NB_PAF(2), NB_PAF(3)); }
    { auto rr = __builtin_amdgcn_permlane32_swap(__float_as_uint(l_reg), __float_as_uint(l_reg), false, false); l_reg = __uint_as_float(rr[0]) + __uint_as_float(rr[1]); }
    if (hi == 0) { const float gate = sigmoidf_(bf2f(gatep[(long)(r32 >> 3) * ldq + (r32 & 7) * 3 + br])); wsf[32 + r32] = l_reg > 0.f ? gate / l_reg : 0.f; } asm volatile("s_waitcnt lgkmcnt(0)" ::: "memory");
    float rli[16];
#pragma unroll
    for (int r = 0; r < 16; ++r) rli[r] = wsf[32 + crow(r, hi)];
    { LAS bf16* stg = (LAS bf16*)((LAS char*)shm3 + LDS_OST) + wid * 2048;
#pragma unroll
      for (int r = 0; r < 16; ++r) { const int orow = crow(r, hi);
#pragma unroll
          for (int d0 = 0; d0 < 2; ++d0) { LAS bf16* sp = stg + orow * 64 + d0 * 32 + r32; *sp = (bf16)f2bf(bf2f(*sp) + o[d0][r] * rli[r]); } }
      asm volatile("s_waitcnt lgkmcnt(0)" ::: "memory");
      if (LAST && store_ok) {
#pragma unroll
          for (int i = 0; i < 4; ++i) { const int row = i * 8 + (lane >> 3), ch = lane & 7; const u32x4 v = *(const LAS u32x4*)(stg + row * 64 + ch * 8); *(u32x4*)(Ow + (long)(row >> 3) * DM + (row & 7) * 64 + ch * 8) = v; } } }
    asm volatile("s_waitcnt lgkmcnt(0)\n\ts_barrier" ::: "memory");
#undef NB_TL
#undef NB_DMA_K
#undef NB_DMA_KD
#undef NB_DMA_VD
#undef NB_CMASKD
#undef NB_SHIFT
#undef NB_DMA_V
#undef NB_CMASK
#undef NB_START
#undef NB_RESC
#undef NB_ROT
#undef NB_PKW
#undef NB_PAF
#undef NB_VFR
#undef NB_PIN
#undef NB_MX3
#undef NB_GAPA
#undef NB_EX
#undef NB_GAPB
#undef NB_VRD
#undef NB_KRD
#undef NB_MF
#undef NB_STEP
#undef NB_ENDW
}
}
struct WTask {
    const bf16* Q; int ldq;
    const bf16* gate;
    int pos0, ncw;
    const bf16 *Kc, *Vc; int ncmp;
    const bf16 *Ks, *Vs; int ldks, nsel;
    const bf16 *Kw, *Vw; int ldkw, winbase;
    bf16* O;
};
DI float head_sum8(float x) {
    x += __builtin_bit_cast(float, __builtin_amdgcn_update_dpp(0, __builtin_bit_cast(int, x), 0xB1, 0xF, 0xF, true));
    x += __builtin_bit_cast(float, __builtin_amdgcn_update_dpp(0, __builtin_bit_cast(int, x), 0x4E, 0xF, 0xF, true));
    x += __builtin_bit_cast(float, __builtin_amdgcn_update_dpp(0, __builtin_bit_cast(int, x), 0x141, 0xF, 0xF, true));
    return x;
}
DI void nsa_attend_wg(const WTask& T, const Frame& F) {
    LAS unsigned char* lds = F.lds;
    LAS float* PS = (LAS float*)(lds + 65536 + F.wave * 4096);
    volatile LAS unsigned* UM = (volatile LAS unsigned*)(lds + 98304);
    int lane_ = F.lane; asm volatile("" : "+v"(lane_));
    const int lane = lane_, r = lane & 31, h = lane >> 5, tok = r >> 3, head = r & 7;
    const bool cw = F.wave < T.ncw;
    const int wtok = cw ? 4 * F.wave : 0;
    const int pos0w = T.pos0 + wtok, t = pos0w + tok, tlast = T.pos0 + 4 * T.ncw - 1;
    const int tidl = F.wave * 64 + lane, srow = tidl >> 3, sch = (tidl & 7) ^ ((srow >> 1) & 7);
    const unsigned wbase = (unsigned)F.wave * 1024u;
#define AT_DMA(kp, ldk, vp, ldv, buf) do { \
        __builtin_amdgcn_global_load_lds((const unsigned*)((kp) + (size_t)srow * (ldk) + sch * 8), (LAS unsigned*)(lds + (buf) * 16384 + wbase), 16, 0, 0); \
        __builtin_amdgcn_global_load_lds((const unsigned*)((vp) + (size_t)srow * (ldv) + sch * 8), (LAS unsigned*)(lds + (buf) * 16384 + 8192 + wbase), 16, 0, 0); } while (0)
#define AT_WAITV(n) asm volatile("s_waitcnt vmcnt(" #n ")" ::: "memory")
#define AT_BAR() do { asm volatile("" ::: "memory"); __builtin_amdgcn_s_barrier(); asm volatile("" ::: "memory"); } while (0)
    bf16x8 qf[4];
    { const bf16* qp = T.Q + (size_t)(wtok + tok) * T.ldq + head * 64 + 8 * h;
#pragma unroll
      for (int st = 0; st < 4; ++st) qf[st] = *(const bf16x8*)(qp + 16 * st); }
    float gt[3];
#pragma unroll
    for (int br = 0; br < 3; ++br) gt[br] = sigmoidf_(bf2f(T.gate[(size_t)(wtok + tok) * T.ldq + head * 3 + br]));
    f32x16 out0, out1; for (int e = 0; e < 16; ++e) { out0[e] = 0.f; out1[e] = 0.f; }
    AttnAcc A; attn_reset(A);
    const int nc64 = tlast >= 31 ? ((((tlast - 31) >> 4) >> 6) + 1) : 0;
    for (int i = 0; i < nc64; ++i) AT_DMA(T.Kc + (size_t)i * 64 * 64, 64, T.Vc + (size_t)i * 64 * 64, 64, i);
    for (int n = lane; n < 1024; n += 64) PS[n] = 0.f;
    AT_WAITV(0); LDS_WAIT(); AT_BAR();
    if (cw) {
        float cm = -__builtin_inff(), cl = 0.f;
        const int nmaxl = t >= 31 ? (((t - 31) >> 4) < T.ncmp - 1 ? ((t - 31) >> 4) : T.ncmp - 1) : -1;
        for (int i = 0; i < nc64; ++i) {
            const LAS unsigned char* kt = lds + i * 16384;
            f32x16 s0 = attn_scores(kt, 0, qf, r, h), s1 = attn_scores(kt, 1, qf, r, h);
            attn_mask<false>(s0, nmaxl - 64 * i - 4 * h); attn_mask<false>(s1, nmaxl - 64 * i - 32 - 4 * h);
            float mx = fmaxf(s0[0], s1[0]);
#pragma unroll
            for (int e = 1; e < 16; ++e) mx = fmaxf(mx, fmaxf(s0[e], s1[e]));
            mx = xor32_max(mx) * ATT_C;
            const float mn = fmaxf(cm, mx), mu = (mn == -__builtin_inff()) ? 0.f : mn; float ps = 0.f;
#pragma unroll
            for (int e = 0; e < 16; ++e) ps += __builtin_amdgcn_exp2f(__builtin_fmaf(s0[e], ATT_C, -mu)) + __builtin_amdgcn_exp2f(__builtin_fmaf(s1[e], ATT_C, -mu));
            ps = xor32_sum(ps);
            cl = (cm == -__builtin_inff() ? 0.f : cl * __builtin_amdgcn_exp2f(cm - mn)) + ps; cm = mn;
        }
        const float linv = cl > 0.f ? 1.f / cl : 0.f, cmu = (cm == -__builtin_inff()) ? 0.f : cm;
        for (int i = 0; i < nc64; ++i) {
            const LAS unsigned char* kt = lds + i * 16384;
            f32x16 s0 = attn_scores(kt, 0, qf, r, h), s1 = attn_scores(kt, 1, qf, r, h);
            attn_mask<false>(s0, nmaxl - 64 * i - 4 * h); attn_mask<false>(s1, nmaxl - 64 * i - 32 - 4 * h);
#pragma unroll
            for (int e = 0; e < 16; ++e) { s0[e] = __builtin_amdgcn_exp2f(__builtin_fmaf(s0[e], ATT_C, -cmu)) * linv; s1[e] = __builtin_amdgcn_exp2f(__builtin_fmaf(s1[e], ATT_C, -cmu)) * linv; }
            attn_pv(A, s0, s1, kt + 8192, r, h);
#pragma unroll
            for (int e = 0; e < 16; ++e) { const float pe = head_sum8(s0[e]), pf2 = head_sum8(s1[e]);
                if (head == 0) { PS[tok * 256 + 64 * i + crow(e, h)] = pe; PS[tok * 256 + 64 * i + 32 + crow(e, h)] = pf2; } }
        }
        out0 = A.o0 * gt[0]; out1 = A.o1 * gt[0];
    }
    LDS_WAIT(); __builtin_amdgcn_wave_barrier();
    unsigned long long msk[4] = {0ull, 0ull, 0ull, 0ull};
    if (cw) {
#pragma unroll
        for (int tk = 0; tk < 4; ++tk) {
            const int tt = pos0w + tk, cur = tt >> 6, j = lane;
            float imp = 0.f;
#pragma unroll
            for (int dn = -1; dn <= 3; ++dn) { const int n = 4 * j + dn; if (n >= 0 && n < T.ncmp) imp += PS[tk * 256 + n]; }
            const bool valid = (j <= cur) && (j < T.nsel), forced = (j == 0) || (j == cur) || (j == cur - 1);
            const unsigned key = !valid ? 0u : (forced ? 0xffffffffu : __builtin_bit_cast(unsigned, imp) + 1u);
            unsigned thr = 0u;
#pragma unroll 1
            for (int bit = 31; bit >= 0; --bit) { const unsigned cand = thr | (1u << bit); if (__builtin_popcountll(__ballot(key >= cand)) >= 16) thr = cand; }
            const int need = 16 - __builtin_popcountll(__ballot(key > thr));
            const unsigned long long ties = __ballot(key == thr);
            const bool tie_ok = key == thr && __builtin_popcountll(ties & ((1ull << j) - 1ull)) < need;
            msk[tk] = __ballot(valid && (key > thr || tie_ok));
        }
    }
    { const unsigned long long wu = msk[0] | msk[1] | msk[2] | msk[3];
      if (lane == 0) { UM[2 * F.wave] = (unsigned)wu; UM[2 * F.wave + 1] = (unsigned)(wu >> 32); } }
    LDS_WAIT(); AT_BAR();
    unsigned long long un = 0ull;
#pragma unroll
    for (int w = 0; w < 8; ++w) un |= (unsigned long long)UM[2 * w] | ((unsigned long long)UM[2 * w + 1] << 32);
    un = ((unsigned long long)__builtin_amdgcn_readfirstlane((unsigned)(un >> 32)) << 32) | (unsigned long long)__builtin_amdgcn_readfirstlane((unsigned)un);
    {   int lo = T.pos0 - 512 - T.winbase; lo = lo < 0 ? 0 : lo;
        const int c0 = lo >> 6, nW = ((tlast - T.winbase) >> 6) - c0 + 1;
        int ntw = (nW + 1) & ~1; ntw = ntw < 4 ? 4 : ntw;
        LAS int* tlw = (LAS int*)(lds + nb::LDS_TL);
        { LAS bf16* stg = (LAS bf16*)(lds + nb::LDS_OST + F.wave * 4096) + r * 64 + 4 * h;
#pragma unroll
          for (int q4 = 0; q4 < 4; ++q4) {
              *(LAS u32x2*)(stg + 8 * q4) = (u32x2){pg8::cvt_pk_bf16(out0[4 * q4], out0[4 * q4 + 1]), pg8::cvt_pk_bf16(out0[4 * q4 + 2], out0[4 * q4 + 3])};
              *(LAS u32x2*)(stg + 32 + 8 * q4) = (u32x2){pg8::cvt_pk_bf16(out1[4 * q4], out1[4 * q4 + 1]), pg8::cvt_pk_bf16(out1[4 * q4 + 2], out1[4 * q4 + 3])}; } }
        if (F.wave == 0) for (int i = lane; i < 96; i += 64) tlw[i] = i < nW ? c0 + i : -1;
        asm volatile("s_waitcnt vmcnt(0) lgkmcnt(0)\n\ts_barrier" ::: "memory");
        const int p0w = cw ? pos0w : -(1 << 24);
        nb::ring_unit<8>(0, false, T.Q + (size_t)wtok * T.ldq, T.ldq, T.Kw, T.Vw, T.ldkw, tlw, ntw, T.winbase, p0w, 0ull, 0ull, 0ull, 0ull, T.gate + (size_t)wtok * T.ldq, 2, cw, T.O + (size_t)wtok * DM, (char*)lds);
    }
    { const bf16* qp = T.Q + (size_t)(wtok + tok) * T.ldq + head * 64 + 8 * h; asm volatile("" : "+v"(qp));
#pragma unroll
      for (int st = 0; st < 4; ++st) qf[st] = *(const bf16x8*)(qp + 16 * st); }
    const int nCh = __builtin_popcountll(un);
    unsigned long long rem_i = un, rem_c = un;
#define AT_ISSUE(q) do { const int j_ = __builtin_ctzll(rem_i); rem_i &= rem_i - 1ull; AT_DMA(T.Ks + (size_t)j_ * 64 * T.ldks, T.ldks, T.Vs + (size_t)j_ * 64 * T.ldks, T.ldks, (q) & 3); } while (0)
    for (int q = 0; q < 3 && q < nCh; ++q) AT_ISSUE(q);
    attn_reset(A);
    const unsigned long long mym = tok == 0 ? msk[0] : (tok == 1 ? msk[1] : (tok == 2 ? msk[2] : msk[3]));
    const unsigned long long wany = msk[0] | msk[1] | msk[2] | msk[3];
    for (int i = 0; i < nCh; ++i) {
        const int left = nCh - 1 - i;
        if (left >= 2) AT_WAITV(4); else if (left == 1) AT_WAITV(2); else AT_WAITV(0);
        AT_BAR();
        if (i + 3 < nCh) AT_ISSUE(i + 3);
        const LAS unsigned char* kt = lds + (i & 3) * 16384;
        const int j = __builtin_ctzll(rem_c); rem_c &= rem_c - 1ull;
        if (cw && ((wany >> j) & 1ull) && 64 * j <= pos0w + 3) {
            const bool mine = (mym >> j) & 1ull;
            const bool allv = 64 * j + 63 <= pos0w;
            const int hi = mine ? t - 64 * j - 4 * h : -1;
            attn_chunk<false>(A, kt, qf, hi, mine ? hi - 32 : -1, allv, mine, r, h);
        }
    }
#undef AT_DMA
#undef AT_ISSUE
#undef AT_WAITV
#undef AT_BAR
    if (cw) {
        const float inv = A.l > 0.f ? gt[1] / A.l : 0.f;
        const LAS bf16* stg = (const LAS bf16*)(lds + nb::LDS_OST + F.wave * 4096) + r * 64 + 4 * h;
        bf16* op = T.O + (size_t)(wtok + tok) * DM + head * 64;
#pragma unroll
        for (int q4 = 0; q4 < 4; ++q4) {
            const u32x2 w0 = *(const LAS u32x2*)(stg + 8 * q4), w1 = *(const LAS u32x2*)(stg + 32 + 8 * q4);
            *(u32x2*)(op + 8 * q4 + 4 * h) = (u32x2){pk2(bflo(w0.x) + A.o0[4 * q4] * inv, bfhi(w0.x) + A.o0[4 * q4 + 1] * inv), pk2(bflo(w0.y) + A.o0[4 * q4 + 2] * inv, bfhi(w0.y) + A.o0[4 * q4 + 3] * inv)};
            *(u32x2*)(op + 32 + 8 * q4 + 4 * h) = (u32x2){pk2(bflo(w1.x) + A.o1[4 * q4] * inv, bfhi(w1.x) + A.o1[4 * q4 + 1] * inv), pk2(bflo(w1.y) + A.o1[4 * q4 + 2] * inv, bfhi(w1.y) + A.o1[4 * q4 + 3] * inv)}; }
    }
}
DI void nsa_attention(const P& p, const Frame& F, int li) {
    const bf16* H = (const bf16*)(p.ws + WS_H); bf16* AO = (bf16*)(p.ws + WS_AO);
    constexpr int NT_P = NB * 2 * (SEQ / 32), NT_S = DB * 2;
    for (int id = F.bid; id < NT_P + NT_S; id += F.G) {
        WTask T;
        if (id < NT_P) {
            int g, b, tq; if (F.G == 256) { const int k = id >> 8, w = (id & 255) >> 3; g = id & 1; b = (id & 7) >> 1; tq = k == 0 ? w : (k == 1 ? 63 - w : (k == 2 ? 64 + w : 127 - w)); }
            else { const int q = id >> 1; g = id & 1; b = q >> 7; tq = (b & 1) ? 127 - (q & 127) : (q & 127); }
            const size_t row = (size_t)b * SEQ + 32 * tq;
            T.Q = H + row * NINP + g * 512; T.ldq = NINP; T.gate = H + row * NINP + 1792 + g * 24; T.pos0 = 32 * tq; T.ncw = 8;
            T.Kc = (const bf16*)(p.ws + WS_KC_P) + (size_t)(b * 2 + g) * 256 * 64; T.Vc = (const bf16*)(p.ws + WS_VCT_P) + (size_t)(b * 2 + g) * 256 * 64; T.ncmp = NCMP_P;
            T.Ks = H + (size_t)b * SEQ * NINP + 1280 + g * 64; T.ldks = NINP; T.Vs = H + (size_t)b * SEQ * NINP + 1408 + g * 64; T.nsel = NSEL_P;
            T.Kw = H + (size_t)b * SEQ * NINP + 1536 + g * 64; T.ldkw = NINP; T.Vw = H + (size_t)b * SEQ * NINP + 1664 + g * 64; T.winbase = 0;
            T.O = AO + row * DM + g * 512; }
        else { const int i2 = id - NT_P, g = i2 & 1, b = i2 >> 1; const size_t row = (size_t)MP + b * DS;
            T.Q = H + row * NINP + g * 512; T.ldq = NINP; T.gate = H + row * NINP + 1792 + g * 24; T.pos0 = PAST; T.ncw = 2;
            T.Kc = (const bf16*)(p.ws + WS_KC_S) + (size_t)(b * 2 + g) * 128 * 64; T.Vc = (const bf16*)(p.ws + WS_VCT_S) + (size_t)(b * 2 + g) * 128 * 64; T.ncmp = NCMP_S;
            T.Ks = (const bf16*)(p.ws + WS_KSLC_S + li * SZ_SLC_S) + (size_t)(b * 2 + g) * SLC_S_ROWS * 64; T.ldks = 64; T.Vs = (const bf16*)(p.ws + WS_VSLCT_S + li * SZ_SLC_S) + (size_t)(b * 2 + g) * SLC_S_ROWS * 64; T.nsel = NSEL_S;
            T.Kw = (const bf16*)(p.ws + WS_KWIN_S + li * SZ_WIN_S) + (size_t)(b * 2 + g) * WIN_S_ROWS * 64; T.ldkw = 64; T.Vw = (const bf16*)(p.ws + WS_VWINT_S + li * SZ_WIN_S) + (size_t)(b * 2 + g) * WIN_S_ROWS * 64; T.winbase = PAST - 512;
            T.O = AO + row * DM + g * 512; }
        nsa_attend_wg(T, F);
        __syncthreads();
    }
}

DI void small_gemm_resid(const Frame& F, const bf16* A, const bf16* Bt, int K, float* X) {
    LAS unsigned char* lds = F.lds; LAS float* red = (LAS float*)(F.lds + 98304);
    const int r = F.lane & 31, h = F.lane >> 5, mi = F.wave & 1, ni = (F.wave >> 1) & 1, kh = F.wave >> 2, nst = K >> 7;
    const int p0 = F.tid, p1 = F.tid + 512;
    const int r0 = p0 >> 4, c0 = (p0 & 15) ^ (r0 & 15), r1 = p1 >> 4, c1 = (p1 & 15) ^ (r1 & 15);
    const unsigned wb = (unsigned)F.wave * 1024u;
    for (int tile = F.bid; tile < 256; tile += F.G) {
        const int row0 = MP + (tile >> 4) * 64, col0 = (tile & 15) * 64;
        const bf16* a0 = A + (size_t)(row0 + r0) * K + c0 * 8; const bf16* a1 = A + (size_t)(row0 + r1) * K + c1 * 8;
        const bf16* b0 = Bt + (size_t)(col0 + r0) * K + c0 * 8; const bf16* b1 = Bt + (size_t)(col0 + r1) * K + c1 * 8;
#define SG_DMA(s_) do { const int k_ = (s_) * 128; LAS unsigned char* d_ = lds + ((s_) % 3) * 32768 + wb; \
        __builtin_amdgcn_global_load_lds((const unsigned*)(a0 + k_), (LAS unsigned*)d_, 16, 0, 0); __builtin_amdgcn_global_load_lds((const unsigned*)(a1 + k_), (LAS unsigned*)(d_ + 8192), 16, 0, 0); \
        __builtin_amdgcn_global_load_lds((const unsigned*)(b0 + k_), (LAS unsigned*)(d_ + 16384), 16, 0, 0); __builtin_amdgcn_global_load_lds((const unsigned*)(b1 + k_), (LAS unsigned*)(d_ + 24576), 16, 0, 0); } while (0)
        f32x16 acc; for (int e = 0; e < 16; ++e) acc[e] = 0.f;
        SG_DMA(0); if (nst > 1) SG_DMA(1);
        for (int s = 0; s < nst; ++s) {
            if (s + 1 < nst) asm volatile("s_waitcnt vmcnt(4)" ::: "memory"); else asm volatile("s_waitcnt vmcnt(0)" ::: "memory");
            asm volatile("" ::: "memory"); __builtin_amdgcn_s_barrier(); asm volatile("" ::: "memory");
            if (s + 2 < nst) SG_DMA(s + 2);
            const LAS unsigned char* ia = lds + (s % 3) * 32768; const LAS unsigned char* ib = ia + 16384;
            const int ra = 32 * mi + r, rb = 32 * ni + r;
#pragma unroll
            for (int u = 0; u < 4; ++u) { const int ch = 8 * kh + 2 * u + h;
                acc = MFMA32(*(const LAS bf16x8*)(ia + ra * 256 + ((ch ^ (ra & 15)) << 4)), *(const LAS bf16x8*)(ib + rb * 256 + ((ch ^ (rb & 15)) << 4)), acc); }
        }
#undef SG_DMA
        if (kh == 1) {
#pragma unroll
            for (int e = 0; e < 16; ++e) red[((F.wave & 3) * 16 + e) * 64 + F.lane] = acc[e]; }
        __syncthreads();
        if (kh == 0) {
#pragma unroll
            for (int e = 0; e < 16; ++e) { float* xp = X + (size_t)(row0 + 32 * mi + crow(e, h)) * DM + col0 + 32 * ni + r; *xp = *xp + acc[e] + red[((F.wave & 3) * 16 + e) * 64 + F.lane]; } }
        __syncthreads();
    }
}

DI P load_ptrs(LAS unsigned char* lds) {
    unsigned off = PTAB_OFF; asm volatile("" : "+s"(off));
    const LAS unsigned* t = (const LAS unsigned*)(lds + off);
    P q;
#pragma unroll
    for (int k = 0; k < 28; ++k) { const unsigned lo = __builtin_amdgcn_readfirstlane(t[2 * k]), hi = __builtin_amdgcn_readfirstlane(t[2 * k + 1]);
        void* v = (void*)(GAS char*)(((unsigned long long)hi << 32) | lo);
        if (k < 26) q.in[k] = v; else if (k == 26) q.out = (float*)v; else q.ws = (unsigned char*)v; }
    return q;
}
__global__ void __launch_bounds__(512, 2) hybrid_fwd(P parg) {
    extern __shared__ __attribute__((aligned(16))) unsigned char lds_raw[];
    Frame F;
    F.lds = (LAS unsigned char*)lds_raw; F.tid = threadIdx.x; F.lane = F.tid & 63; F.wave = __builtin_amdgcn_readfirstlane(F.tid >> 6);
    F.bid = blockIdx.x; F.G = gridDim.x; F.gw = F.bid * 8 + F.wave; F.ngw = F.G * 8;
    volatile LAS unsigned* MISC = (volatile LAS unsigned*)(F.lds + MISC_OFF);
    for (int u = F.tid; u < (LDS_BYTES - RING_BYTES) / 4; u += 512) ((LAS unsigned*)(F.lds + RING_BYTES))[u] = 0u;
    __syncthreads();
    if (F.tid < 28) { const void* v = F.tid < 26 ? parg.in[F.tid] : (F.tid == 26 ? (const void*)parg.out : (const void*)parg.ws);
        const unsigned long long w = (unsigned long long)v; LAS unsigned* t = (LAS unsigned*)(F.lds + PTAB_OFF); t[2 * F.tid] = (unsigned)w; t[2 * F.tid + 1] = (unsigned)(w >> 32); }
    __syncthreads();
    XcdBarrier bar = xcd_barrier_post((unsigned*)(parg.ws + WS_CTL) + CW_BAR, MISC + 8);
#define REFRESH() do { int t_ = threadIdx.x, b_ = __builtin_amdgcn_readfirstlane(F.bid), g_ = __builtin_amdgcn_readfirstlane(F.G); asm volatile("" : "+v"(t_), "+s"(b_), "+s"(g_)); F.tid = t_; F.lane = t_ & 63; F.wave = __builtin_amdgcn_readfirstlane(t_ >> 6); F.bid = b_; F.G = g_; F.gw = b_ * 8 + F.wave; F.ngw = g_ * 8; } while (0)
#define GRID_BAR() do { xcd_barrier(bar); REFRESH(); } while (0)
#define PH(...) do { const P p = load_ptrs(F.lds); unsigned char* ws = p.ws; (void)ws; __VA_ARGS__ } while (0)
    PH( p0_cbias(p, F); );
    PH( p0_weights(p, F, 0); );
    PH( rms_phase<0>(p, F, (const float*)p.in[7]); );
    GRID_BAR();
#define LAYER_BODY(layer) { const int li = (layer) >> 1;  \
        if ((layer & 1) == 0) { \
            PH( pg8::Gemm g{DM, DM, 128}; pg8::StaticOrder S; S.init(M, GINP, F.G, F.bid, ws + WS_XN, ws + WS_WG_IN + li * SZ_WG_IN, ws + WS_H, DM, DM); \
                pg8::EpiBf16 E{GINP}; pg8::gemm_phase(F.lds, g, S, E); ); \
            GRID_BAR(); \
            PH( gdn_prep(p, F, li); ); \
            GRID_BAR(); \
            PH( gdn_chunk(p, F, li); ); \
            GRID_BAR(); \
            PH( if (F.G > 64) { if (F.bid < 64) gdn_scan(p, F, li, (((F.bid & 7) + 8 * (F.bid >> 4)) << 1) | ((F.bid >> 3) & 1)); else {     for (int task = F.bid - 64; task < DB * GH; task += F.G - 64) gdn_sample(p, F, li, task); Frame F2 = F; F2.bid = F.bid - 64; F2.G = F.G - 64; F2.gw = F2.bid * 8 + F.wave; F2.ngw = F2.G * 8; p0_cache_win(p, F2, li); if (li == 0) p0_weights(p, F2, 1); } } \
                else { for (int sid = F.bid; sid < 64; sid += F.G) { gdn_scan(p, F, li, sid); __syncthreads(); } for (int task = F.bid; task < DB * GH; task += F.G) gdn_sample(p, F, li, task); p0_cache_win(p, F, li); if (li == 0) p0_weights(p, F, 1); } ); \
            GRID_BAR(); \
            PH( gdn_gate(p, F, li); if (layer == 0) p0_cbias2(p, F); ); \
            GRID_BAR(); \
        } else { \
            PH( pg8::Gemm g{DM, DM, 128}; pg8::StaticOrder S; S.init(M, NINP, F.G, F.bid, ws + WS_XN, ws + WS_WN_IN + li * SZ_WN_IN, ws + WS_H, DM, DM); \
                pg8::EpiNsaIn E{(bf16*)(ws + WS_H), p.out, (bf16*)(ws + WS_CMPP), li}; pg8::gemm_phase(F.lds, g, S, E); \
                if (F.G > 32 && F.bid >= 32) { pg8::Gemm g2{1024, 4096, 512}; CmpOrder S2{F.G - 32, F.bid - 32, li, ws, 320, 224}; pg8::EpiBf16 E2{512}; pg8::gemm_phase(F.lds, g2, S2, E2); } ); \
            GRID_BAR(); \
            PH( nsa_transpose(p, F, li); ); \
            __syncthreads(); REFRESH(); \
            PH( pg8::Gemm g{1024, 4096, 512}; CmpOrder S{F.G, F.bid, li, ws, 0, F.G > 32 ? 320 : 544}; pg8::EpiBf16 E{512}; pg8::gemm_phase(F.lds, g, S, E); ); \
            GRID_BAR(); \
            PH( nsa_cmp2(p, F, li); ); \
            GRID_BAR(); \
            PH( nsa_attention(p, F, li); ); \
            GRID_BAR(); \
        } \
        PH( const bf16* Wout = (const bf16*)(ws + ((layer & 1) ? WS_WN_OUT : WS_WG_OUT) + li * SZ_W1K); \
            pg8::Gemm g{DM, DM, 128}; pg8::StaticOrder S; S.init(MP, DM, F.G, F.bid, ws + WS_AO, Wout, nullptr, DM, DM); \
            pg8::EpiResid E{(float*)(ws + WS_X)}; pg8::gemm_phase(F.lds, g, S, E); small_gemm_resid(F, (const bf16*)(ws + WS_AO), Wout, DM, (float*)(ws + WS_X)); ); \
        GRID_BAR(); \
        PH( rms_phase<1>(p, F, (const float*)p.in[8] + layer * DM); ); \
        GRID_BAR(); \
        PH( pg8::Gemm g{DM, DM, 128}; pg8::StaticOrder S; S.init(M, FF2, F.G, F.bid, ws + WS_XN, ws + WS_WF_IN + layer * SZ_WF_IN, nullptr, DM, DM); \
            pg8::EpiSwiglu E{(bf16*)(ws + WS_FFH), FF}; pg8::gemm_phase(F.lds, g, S, E); ); \
        GRID_BAR(); \
        PH( pg8::Gemm g{FF, FF, 128}; pg8::StaticOrder S; S.init(MP, DM, F.G, F.bid, ws + WS_FFH, ws + WS_WF_OUT + layer * SZ_WF_OUT, nullptr, FF, FF); \
            pg8::EpiResid E{(float*)(ws + WS_X)}; pg8::gemm_phase(F.lds, g, S, E); small_gemm_resid(F, (const bf16*)(ws + WS_FFH), (const bf16*)(ws + WS_WF_OUT + layer * SZ_WF_OUT), FF, (float*)(ws + WS_X)); ); \
        GRID_BAR(); \
        if (layer < 3) { PH( rms_phase<1>(p, F, (const float*)p.in[7] + (layer + 1) * DM); ); GRID_BAR(); } \
     }
    LAYER_BODY(0)
    LAYER_BODY(1)
    LAYER_BODY(2)
    LAYER_BODY(3)
    PH( rms_phase<2>(p, F, (const float*)p.in[9]); );
}

extern "C" void kernel_launch(void* const* d_in, const int* in_sizes, int n_in, void* d_out, int out_size, void* d_ws, size_t ws_size, hipStream_t stream) {
    static int grid = 0;
    if (grid == 0) {
        if (n_in != 26 || ws_size < WS_END) { fprintf(stderr, "kernel_launch: unexpected n_in %d or ws_size %zu (< %zu)\n", n_in, ws_size, (size_t)WS_END); grid = -1; return; }
        int dev = 0, cus = 0, per_cu = 0;
        if (hipGetDevice(&dev) != hipSuccess || hipDeviceGetAttribute(&cus, hipDeviceAttributeMultiprocessorCount, dev) != hipSuccess) { grid = -1; return; }
        if (hipFuncSetAttribute((const void*)hybrid_fwd, hipFuncAttributeMaxDynamicSharedMemorySize, LDS_BYTES) != hipSuccess) { fprintf(stderr, "kernel_launch: hipFuncSetAttribute failed\n"); grid = -1; return; }
        if (hipOccupancyMaxActiveBlocksPerMultiprocessor(&per_cu, (const void*)hybrid_fwd, 512, LDS_BYTES) != hipSuccess || per_cu < 1) fprintf(stderr, "kernel_launch: occupancy query says %d\n", per_cu);
        (void)hipGetLastError();
        grid = cus;
    }
    if (grid < 0) return;
    (void)in_sizes; (void)out_size;
    (void)hipMemsetAsync((char*)d_ws + WS_CTL, 0, CTL_BYTES, stream);
    P p{};
    for (int i = 0; i < 26; ++i) p.in[i] = d_in[i];
    p.out = (float*)d_out; p.ws = (unsigned char*)d_ws;
    hipLaunchKernelGGL(hybrid_fwd, dim3(grid), dim3(512), LDS_BYTES, stream, p);
}
```

```cpp
#include <hip/hip_runtime.h>
#include <cstdio>

#define DI __device__ __forceinline__
#define LAS __attribute__((address_space(3)))
#define GAS __attribute__((address_space(1)))
typedef unsigned short bf16;
typedef short bf16x8 __attribute__((ext_vector_type(8)));
typedef short s16x4 __attribute__((ext_vector_type(4)));
typedef float f32x4 __attribute__((ext_vector_type(4)));
typedef float f32x2 __attribute__((ext_vector_type(2)));
typedef float f32x16 __attribute__((ext_vector_type(16)));
typedef unsigned u32x4 __attribute__((ext_vector_type(4)));
typedef unsigned u32x2 __attribute__((ext_vector_type(2)));

constexpr int DM = 1024, NB = 4, SEQ = 4096, DB = 128, DS = 8, PAST = 2048, PAGE = 128, NPAGE = 16, NPHYS = 2560;
constexpr int MP = NB * SEQ, MS = DB * DS, M = MP + MS;
constexpr int GH = 8, GDK = 128, GQKV = 3072, GIN = 4112, GINP = 4352;
constexpr int NIN = 1840, NINP = 2048;
constexpr int FF = 2816, FF2 = 5632;
constexpr int NCMP_P = 255, NCMP_S = 127, NSEL_P = 64, NSEL_S = 33;
constexpr int SLC_S_ROWS = 2112, WIN_S_ROWS = 576;
constexpr int NCHUNK = NB * GH * 64;

constexpr size_t O_Y = 0, O_KVP = 17825792, O_KVS = 34603008, O_WINP = 35651584, O_WINS = 36700160, O_GSP = 70254592, O_GSS = 71303168, O_GCP = 104857600, O_GCS = 104931328;

constexpr size_t al256(size_t x) { return (x + 255) & ~(size_t)255; }
constexpr size_t WS_CTL = 0, CTL_BYTES = 1u << 20;
constexpr size_t SZ_WG_IN = (size_t)GINP * DM * 2, SZ_W1K = (size_t)DM * DM * 2, SZ_WN_IN = (size_t)NINP * DM * 2, SZ_WF_IN = (size_t)FF2 * DM * 2, SZ_WF_OUT = (size_t)DM * FF * 2, SZ_WC1 = (size_t)512 * 1024 * 2;
constexpr size_t WS_WG_IN = WS_CTL + CTL_BYTES;
constexpr size_t WS_WG_OUT = WS_WG_IN + 2 * SZ_WG_IN;
constexpr size_t WS_WN_IN = WS_WG_OUT + 2 * SZ_W1K;
constexpr size_t WS_WN_OUT = WS_WN_IN + 2 * SZ_WN_IN;
constexpr size_t WS_WF_IN = WS_WN_OUT + 2 * SZ_W1K;
constexpr size_t WS_WF_OUT = WS_WF_IN + 4 * SZ_WF_IN;
constexpr size_t WS_WC1 = WS_WF_OUT + 4 * SZ_WF_OUT;
constexpr size_t WS_CBIAS = WS_WC1 + 4 * SZ_WC1;
constexpr size_t WS_X = WS_CBIAS + 4096;
constexpr size_t WS_XN = WS_X + (size_t)M * DM * 4;
constexpr size_t WS_H = WS_XN + (size_t)M * DM * 2;
constexpr size_t WS_FFH = WS_H + (size_t)M * GINP * 2;
constexpr size_t WS_AO = WS_FFH + (size_t)M * FF * 2;
constexpr size_t WS_QH = WS_AO + (size_t)M * DM * 2;
constexpr size_t WS_KH = WS_QH + (size_t)M * DM * 2;
constexpr size_t WS_VH = WS_KH + (size_t)M * DM * 2;
constexpr size_t WS_BETA = WS_VH + (size_t)M * DM * 2;
constexpr size_t WS_LOGA = WS_BETA + (size_t)M * 8 * 4;
constexpr size_t WS_OG = WS_LOGA + (size_t)M * 8 * 4;
constexpr size_t WS_CW = WS_OG + (size_t)M * DM * 4;
constexpr size_t WS_CUT = WS_CW + (size_t)NCHUNK * 64 * 128 * 2;
constexpr size_t WS_CAQK = WS_CUT + (size_t)NCHUNK * 128 * 64 * 4;
constexpr size_t WS_CQT = WS_CAQK + (size_t)NCHUNK * 64 * 64 * 2;
constexpr size_t WS_CKTT = WS_CQT + (size_t)NCHUNK * 64 * 128 * 2;
constexpr size_t WS_CEGL = WS_CKTT + (size_t)NCHUNK * 128 * 64 * 2;
constexpr size_t WS_CMPP = WS_CEGL + (size_t)NCHUNK * 4;
constexpr size_t SZ_CMPS = (size_t)DB * PAST * 256 * 2;
constexpr size_t WS_CMPS = WS_CMPP + (size_t)MP * 256 * 2;
constexpr size_t SZ_SLC_S = (size_t)DB * 2 * SLC_S_ROWS * 64 * 2;
constexpr size_t WS_KSLC_S = WS_CMPS + 2 * SZ_CMPS;
constexpr size_t WS_VSLCT_S = WS_KSLC_S + 2 * SZ_SLC_S;
constexpr size_t SZ_WIN_S = (size_t)DB * 2 * WIN_S_ROWS * 64 * 2;
constexpr size_t WS_KWIN_S = WS_VSLCT_S + 2 * SZ_SLC_S;
constexpr size_t WS_VWINT_S = WS_KWIN_S + 2 * SZ_WIN_S;
constexpr size_t WS_VSLCT_P = WS_VWINT_S + 2 * SZ_WIN_S;
constexpr size_t WS_VWINT_P = WS_VSLCT_P + (size_t)NB * 2 * 64 * SEQ * 2;
constexpr size_t WS_PC_P = WS_VWINT_P + (size_t)NB * 2 * 64 * SEQ * 2;
constexpr size_t WS_PC_S = WS_PC_P + (size_t)4 * 1024 * 512 * 2;
constexpr size_t WS_KC_P = WS_PC_S + (size_t)4 * 16384 * 512 * 2;
constexpr size_t WS_VCT_P = WS_KC_P + (size_t)NB * 2 * 256 * 64 * 2;
constexpr size_t WS_KC_S = WS_VCT_P + (size_t)NB * 2 * 256 * 64 * 2;
constexpr size_t WS_VCT_S = WS_KC_S + (size_t)DB * 2 * 128 * 64 * 2;
constexpr size_t WS_END = WS_VCT_S + (size_t)DB * 2 * 128 * 64 * 2;

constexpr int CW_BAR = 4096;

constexpr int RING_BYTES = 131072, MISC_OFF = RING_BYTES + 320, LDS_BYTES = 147456;
constexpr int PTAB_OFF = RING_BYTES + 1024;

typedef __bf16 hwbf16x2 __attribute__((ext_vector_type(2)));
DI unsigned pk2(float lo, float hi) { const f32x2 v = {lo, hi}; return __builtin_bit_cast(unsigned, __builtin_convertvector(v, hwbf16x2)); }
DI unsigned f2bf(float f) { return pk2(f, f) & 0xffffu; }
DI float bf2f(unsigned b) { return __builtin_bit_cast(float, b << 16); }
DI float bflo(unsigned w) { return __builtin_bit_cast(float, w << 16); }
DI float bfhi(unsigned w) { return __builtin_bit_cast(float, w & 0xffff0000u); }
template <int CTRL> DI float dppf(float x) { return __builtin_bit_cast(float, __builtin_amdgcn_update_dpp(0, __builtin_bit_cast(int, x), CTRL, 0xF, 0xF, true)); }
DI float sum16(float x) { x += dppf<0xB1>(x); x += dppf<0x4E>(x); x += dppf<0x141>(x); x += dppf<0x140>(x); return x; }
DI float xor16_sum(float x) { auto s = __builtin_amdgcn_permlane16_swap(__float_as_uint(x), __float_as_uint(x), false, false); const unsigned s0 = s[0], s1 = s[1];
    return __uint_as_float(s0) + __uint_as_float(s1); }
DI float xor32_sum(float x) { auto s = __builtin_amdgcn_permlane32_swap(__float_as_uint(x), __float_as_uint(x), false, false); const unsigned s0 = s[0], s1 = s[1];
    return __uint_as_float(s0) + __uint_as_float(s1); }
DI float xor32_max(float x) { auto s = __builtin_amdgcn_permlane32_swap(__float_as_uint(x), __float_as_uint(x), false, false); const unsigned s0 = s[0], s1 = s[1];
    return fmaxf(__uint_as_float(s0), __uint_as_float(s1)); }
DI float sum32(float x) { return xor16_sum(sum16(x)); }
DI float wave_sum(float v) { return xor32_sum(sum32(v)); }
DI float sigmoidf_(float x) { return __builtin_amdgcn_rcpf(1.f + __expf(-x)); }
DI float siluf_(float x) { return x * __builtin_amdgcn_rcpf(1.f + __expf(-x)); }
#define LDS_WAIT() asm volatile("s_waitcnt lgkmcnt(0)" ::: "memory")
#define VM_WAIT() asm volatile("s_waitcnt vmcnt(0)" ::: "memory")

namespace pg8 {
constexpr int BM = 256, BK = 64, HALF = 128, HTB = HALF * BK * 2, STAGE_BYTES = 8 * HTB, NXCD = 8, WGM = 8;
DI int lds_byte(int r, int c) { const int st = (r >> 4) * 2 + (c >> 5), rr = r & 15, cc = c & 31, ob = rr * 64 + cc * 2; return st * 1024 + (ob ^ (((ob >> 9) & 1) << 5)); }
DI void stage_rc(int b, int& R, int& C) { const int st = b / 1024, sb = b % 1024, swz = sb ^ (((sb >> 9) & 1) << 5); R = (st >> 1) * 16 + swz / 64; C = (st & 1) * 32 + (swz % 64) / 2; }
DI int perm32(int rho) { const int n = rho >> 4, i = rho & 15; return 8 * (i >> 2) + 4 * n + (i & 3); }

struct Unit { int pm, pn, z; const char* A; const char* B; char* C; };
struct Gemm { int K; int lda; int kstepA; };

struct StaticOrder {
    int nM, nN, nwg, G, c, K, lda; const char* A; const char* B; char* C;
    DI void init(int M_, int N_, int G_, int c_, const void* A_, const void* B_, void* C_, int K_, int lda_) { nM = M_ / BM; nN = N_ / BM; nwg = nM * nN; G = G_; c = c_; A = (const char*)A_; B = (const char*)B_; C = (char*)C_; K = K_; lda = lda_; }
    DI bool next(int i, Unit& u) const {
        const long L = (long)i * G + c; if (L >= nwg) return false;
        int wgid = (int)L; { const int q = nwg / NXCD, r = nwg % NXCD, xcd = wgid % NXCD, off = wgid / NXCD; wgid = (xcd < r ? xcd * (q + 1) : r * (q + 1) + (xcd - r) * q) + off; }
        const int nig = WGM * nN, gid = wgid / nig, fm = gid * WGM, gsz = (nM - fm) < WGM ? (nM - fm) : WGM;
        u.pm = fm + ((wgid % nig) % gsz); u.pn = (wgid % nig) / gsz; u.z = 0;
        u.A = A + (size_t)u.pm * BM * lda * 2; u.B = B + (size_t)u.pn * BM * K * 2; u.C = C; return true;
    }
};

DI unsigned cvt_pk_bf16(float lo, float hi) { unsigned r; asm volatile("v_cvt_pk_bf16_f32 %0, %1, %2" : "=v"(r) : "v"(lo), "v"(hi)); return r; }

struct EpiBf16 {
    static constexpr bool PERM = true;
    int ldc;
    DI void operator()(const f32x4 (&acc)[2][2][4][2], const Unit& u, int wr, int wc, int fr, int fq) const {
        const int row0 = u.pm * BM + wr * 64 + fr, col0 = u.pn * BM + wc * 32 + 8 * fq;
#pragma unroll
        for (int ai = 0; ai < 2; ++ai)
#pragma unroll
            for (int m = 0; m < 4; ++m) { bf16* rowp = (bf16*)u.C + (size_t)(row0 + ai * HALF + m * 16) * ldc + col0;
#pragma unroll
                for (int bj = 0; bj < 2; ++bj) { const f32x4 v0 = acc[ai][bj][m][0], v1 = acc[ai][bj][m][1];
                    u32x4 w; w.x = cvt_pk_bf16(v0[0], v0[1]); w.y = cvt_pk_bf16(v0[2], v0[3]); w.z = cvt_pk_bf16(v1[0], v1[1]); w.w = cvt_pk_bf16(v1[2], v1[3]);
                    *(u32x4*)(rowp + bj * HALF) = w; } }
    }
};
struct EpiSwiglu {
    static constexpr bool PERM = true;
    bf16* O; int ldc;
    DI void operator()(const f32x4 (&acc)[2][2][4][2], const Unit& u, int wr, int wc, int fr, int fq) const {
        const int row0 = u.pm * BM + wr * 64 + fr, col0 = u.pn * HALF + wc * 32 + 8 * fq;
#pragma unroll
        for (int ai = 0; ai < 2; ++ai)
#pragma unroll
            for (int m = 0; m < 4; ++m) { bf16* rowp = O + (size_t)(row0 + ai * HALF + m * 16) * ldc + col0;
                float o[8];
#pragma unroll
                for (int n = 0; n < 2; ++n)
#pragma unroll
                    for (int e = 0; e < 4; ++e) { const float g = acc[ai][0][m][n][e], uu = acc[ai][1][m][n][e]; o[n * 4 + e] = g * __builtin_amdgcn_rcpf(1.f + __expf(-g)) * uu; }
                u32x4 w; w.x = cvt_pk_bf16(o[0], o[1]); w.y = cvt_pk_bf16(o[2], o[3]); w.z = cvt_pk_bf16(o[4], o[5]); w.w = cvt_pk_bf16(o[6], o[7]);
                *(u32x4*)rowp = w; }
    }
};
struct EpiResid {
    static constexpr bool PERM = false;
    float* X;
    DI void operator()(const f32x4 (&acc)[2][2][4][2], const Unit& u, int wr, int wc, int fr, int fq) const {
        const int row0 = u.pm * BM + wr * 64 + fr, col0 = u.pn * BM + wc * 32 + 4 * fq;
#pragma unroll
        for (int ai = 0; ai < 2; ++ai)
#pragma unroll
            for (int m = 0; m < 4; ++m) { float* rowp = X + (size_t)(row0 + ai * HALF + m * 16) * DM + col0;
#pragma unroll
                for (int bj = 0; bj < 2; ++bj)
#pragma unroll
                    for (int n = 0; n < 2; ++n) { f32x4* p = (f32x4*)(rowp + bj * HALF + n * 16); *p = *p + acc[ai][bj][m][n]; } }
    }
};
struct EpiNsaIn {
    static constexpr bool PERM = true;
    bf16* H; float* out; bf16* cmpp; int li;
    DI void operator()(const f32x4 (&acc)[2][2][4][2], const Unit& u, int wr, int wc, int fr, int fq) const {
        const int row0 = u.pm * BM + wr * 64 + fr, col0 = u.pn * BM + wc * 32 + 8 * fq;
        const bool smp = u.pm >= MP / BM;
#pragma unroll
        for (int ai = 0; ai < 2; ++ai)
#pragma unroll
            for (int m = 0; m < 4; ++m) { const int row = row0 + ai * HALF + m * 16; bf16* rowp = H + (size_t)row * NINP + col0;
                float* o = nullptr;
                if (u.pn == 4 || u.pn == 5) o = (smp ? out + O_KVS + (size_t)li * MS * 512 + (size_t)(row - MP) * 512 : out + O_KVP + (size_t)li * MP * 512 + (size_t)row * 512) + (col0 - 1024);
                else if (u.pn == 6) {
                    if (smp) { const int rs = row - MP; o = out + O_WINS + ((size_t)(li * DB + (rs >> 3)) * 512 + 504 + (rs & 7)) * 256 + (col0 - 1536); }
                    else { const int t = row & 4095; if (t >= SEQ - 512) o = out + O_WINP + ((size_t)(li * NB + (row >> 12)) * 512 + (t - (SEQ - 512))) * 256 + (col0 - 1536); } }
#pragma unroll
                for (int bj = 0; bj < 2; ++bj) { const float qs = u.pn < 4 ? 0.18033688011112042f : 1.f;
                    const f32x4 v0 = acc[ai][bj][m][0] * qs, v1 = acc[ai][bj][m][1] * qs;
                    u32x4 w; w.x = cvt_pk_bf16(v0[0], v0[1]); w.y = cvt_pk_bf16(v0[2], v0[3]); w.z = cvt_pk_bf16(v1[0], v1[1]); w.w = cvt_pk_bf16(v1[2], v1[3]);
                    *(u32x4*)(rowp + bj * HALF) = w;
                    if (o) { *(f32x4*)(o + bj * HALF) = v0; *(f32x4*)(o + bj * HALF + 4) = v1; }
                    if (u.pn == 4 && !smp) *(u32x4*)(cmpp + (size_t)row * 256 + (col0 - 1024) + bj * HALF) = w; } }
    }
};

template <class Epi, class Sched>
DI void gemm_phase(LAS unsigned char* lds, const Gemm g, const Sched& S, const Epi& E) {
    int tid_ = threadIdx.x; asm volatile("" : "+v"(tid_)); const int tid = tid_, wid = __builtin_amdgcn_readfirstlane(tid >> 6), lane = tid & 63, wr = wid >> 2, wc = wid & 3, fr = lane & 15, fq = lane >> 4;
    const int K = g.K, nt = K / BK;
    unsigned voffA[2], voffB[2];
#pragma unroll
    for (int i = 0; i < 2; ++i) { int R, C; stage_rc(tid * 16 + i * 8192, R, C); const int Rb = Epi::PERM ? ((R & ~31) + perm32(R & 31)) : R;
        voffA[i] = (unsigned)(R * g.lda + C) * 2u; voffB[i] = (unsigned)(Rb * K + C) * 2u; }
    const size_t kstepA = (size_t)g.kstepA, kstepB = (size_t)(BK * 2);
    const size_t hstepA = (size_t)HALF * g.lda * 2, hstepB = (size_t)HALF * K * 2;
    const unsigned ldsw = (unsigned)wid * 1024u;
    const int aoff = lds_byte(wr * 64 + fr, fq * 8), boff = lds_byte(wc * 32 + fr, fq * 8);
#define PG8_SA(b, h) (((b) * 2 + (h)) * HTB)
#define PG8_SB(b, h) ((4 + (b) * 2 + (h)) * HTB)
#define PG8_STAGE(bufoff, gbase, voff) do { _Pragma("unroll") for (int _i = 0; _i < 2; ++_i) \
        __builtin_amdgcn_global_load_lds((const unsigned*)((const char*)(gbase) + (voff)[_i]), (LAS unsigned*)(lds + (bufoff) + ldsw + _i * 8192), 16, 0, 0); } while (0)
#define PG8_LDA(dst, b, h) do { _Pragma("unroll") for (int m = 0; m < 4; ++m) _Pragma("unroll") for (int k = 0; k < 2; ++k) dst[m][k] = *(const LAS bf16x8*)(lds + PG8_SA(b, h) + aoff + m * 2048 + k * 1024); } while (0)
#define PG8_LDB(dst, b, h) do { _Pragma("unroll") for (int n = 0; n < 2; ++n) _Pragma("unroll") for (int k = 0; k < 2; ++k) dst[n][k] = *(const LAS bf16x8*)(lds + PG8_SB(b, h) + boff + n * 2048 + k * 1024); } while (0)
#define PG8_MMA(ai, bj, At, Bt) do { __builtin_amdgcn_s_setprio(1); _Pragma("unroll") for (int m = 0; m < 4; ++m) _Pragma("unroll") for (int n = 0; n < 2; ++n) _Pragma("unroll") for (int k = 0; k < 2; ++k) \
        acc[ai][bj][m][n] = __builtin_amdgcn_mfma_f32_16x16x32_bf16(Bt[n][k], At[m][k], acc[ai][bj][m][n], 0, 0, 0); __builtin_amdgcn_s_setprio(0); } while (0)
#define PG8_WAIT_V(n) asm volatile("s_waitcnt vmcnt(" #n ")" ::: "memory")
#define PG8_WAIT_L(n) asm volatile("s_waitcnt lgkmcnt(" #n ")" ::: "memory")
#define PG8_BAR __builtin_amdgcn_s_barrier()
#define PG8_SCHED __builtin_amdgcn_sched_barrier(0)
    Unit cur, nxt; int ui = 0;
    if (!S.next(0, cur)) return;
    f32x4 acc[2][2][4][2];
#pragma unroll
    for (int a = 0; a < 2; ++a)
#pragma unroll
        for (int b = 0; b < 2; ++b)
#pragma unroll
            for (int m = 0; m < 4; ++m)
#pragma unroll
                for (int n = 0; n < 2; ++n) acc[a][b][m][n] = (f32x4){0.f, 0.f, 0.f, 0.f};
    bf16x8 At[4][2], B0[2][2], B1[2][2];
    const char* cA = cur.A; const char* cB = cur.B;
    PG8_STAGE(PG8_SB(0, 0), cB, voffB); PG8_STAGE(PG8_SA(0, 0), cA, voffA); PG8_STAGE(PG8_SB(0, 1), cB + hstepB, voffB); PG8_STAGE(PG8_SA(0, 1), cA + hstepA, voffA);
    if (wr == 1) PG8_BAR;
    PG8_WAIT_V(4); PG8_BAR;
    PG8_STAGE(PG8_SB(1, 0), cB + kstepB, voffB); PG8_STAGE(PG8_SA(1, 0), cA + kstepA, voffA); PG8_STAGE(PG8_SB(1, 1), cB + hstepB + kstepB, voffB);
    PG8_WAIT_V(6); PG8_BAR;
    for (;;) {
        const bool has_next = S.next(ui + 1, nxt);
        const char* nA = has_next ? nxt.A : cA; const char* nB = has_next ? nxt.B : cB;
        for (int t = 0; t < nt; t += 2) {
            const bool last = (t == nt - 2);
            const char* a1 = cA + (size_t)(t + 1) * kstepA;
            const char* a2 = last ? nA : cA + (size_t)(t + 2) * kstepA; const char* b2 = last ? nB : cB + (size_t)(t + 2) * kstepB;
            const char* a3 = a2 + kstepA; const char* b3 = b2 + kstepB;
            PG8_LDB(B0, 0, 0); PG8_SCHED; PG8_LDA(At, 0, 0); PG8_STAGE(PG8_SA(1, 1), a1 + hstepA, voffA);
            PG8_WAIT_L(8); PG8_BAR; PG8_WAIT_L(0); PG8_MMA(0, 0, At, B0); PG8_BAR; PG8_SCHED;
            PG8_LDB(B1, 0, 1); PG8_STAGE(PG8_SB(0, 0), b2, voffB);
            PG8_BAR; PG8_WAIT_L(0); PG8_MMA(0, 1, At, B1); PG8_BAR;
            PG8_LDA(At, 0, 1); PG8_STAGE(PG8_SA(0, 0), a2, voffA);
            PG8_BAR; PG8_WAIT_L(0); PG8_MMA(1, 0, At, B0); PG8_BAR; PG8_SCHED;
            PG8_STAGE(PG8_SB(0, 1), b2 + hstepB, voffB);
            PG8_WAIT_V(6); PG8_BAR; PG8_MMA(1, 1, At, B1); PG8_BAR;
            PG8_LDB(B0, 1, 0); PG8_SCHED; PG8_LDA(At, 1, 0); PG8_STAGE(PG8_SA(0, 1), a2 + hstepA, voffA);
            PG8_WAIT_L(8); PG8_BAR; PG8_WAIT_L(0); PG8_MMA(0, 0, At, B0); PG8_BAR; PG8_SCHED;
            PG8_LDB(B1, 1, 1); PG8_STAGE(PG8_SB(1, 0), b3, voffB);
            PG8_BAR; PG8_WAIT_L(0); PG8_MMA(0, 1, At, B1); PG8_BAR;
            PG8_LDA(At, 1, 1); PG8_STAGE(PG8_SA(1, 0), a3, voffA);
            PG8_BAR; PG8_WAIT_L(0); PG8_MMA(1, 0, At, B0); PG8_BAR; PG8_SCHED;
            PG8_STAGE(PG8_SB(1, 1), b3 + hstepB, voffB);
            PG8_WAIT_V(6); PG8_BAR; PG8_MMA(1, 1, At, B1); PG8_BAR;
        }
        E(acc, cur, wr, wc, fr, fq);
        if (!has_next) break;
#pragma unroll
        for (int a = 0; a < 2; ++a)
#pragma unroll
            for (int b = 0; b < 2; ++b)
#pragma unroll
                for (int m = 0; m < 4; ++m)
#pragma unroll
                    for (int n = 0; n < 2; ++n) acc[a][b][m][n] = (f32x4){0.f, 0.f, 0.f, 0.f};
        cur = nxt; cA = nA; cB = nB; ++ui;
    }
    PG8_WAIT_V(0);
    if (wr == 0) PG8_BAR;
    PG8_BAR;
#undef PG8_SA
#undef PG8_SB
#undef PG8_STAGE
#undef PG8_LDA
#undef PG8_LDB
#undef PG8_MMA
#undef PG8_WAIT_V
#undef PG8_WAIT_L
#undef PG8_BAR
#undef PG8_SCHED
}
}

#define XB_TMO      128
#define XB_XCNT(j)  (256  + 64 * (j))
#define XB_XSUB(j)  (1280 + 64 * (j))
#define XB_XGEN(j)  (2304 + 64 * (j))
#define XB_TOP      3328
#define XB_TOPGEN   3392
#define XCD_BAR_WORDS 3456
#define XB_SPIN_CAP (1u << 18)
DI unsigned xb_ld(unsigned* p)              { return __hip_atomic_load(p, __ATOMIC_RELAXED, __HIP_MEMORY_SCOPE_AGENT); }
DI unsigned xb_add(unsigned* p, unsigned v) { return __hip_atomic_fetch_add(p, v, __ATOMIC_RELAXED, __HIP_MEMORY_SCOPE_AGENT); }
DI unsigned xb_xcc_id() { return (unsigned)__builtin_amdgcn_s_getreg((3 << 11) | 20) & 0xFu; }
#define XB_SPIN(cond, bar) do { unsigned _sp = 0; while (cond) { __builtin_amdgcn_s_sleep(1); \
    if ((++_sp & 255u) == 0u) { if (xb_ld(&(bar)[XB_TMO])) break; if (_sp > XB_SPIN_CAP) { atomicAdd(&(bar)[XB_TMO], 1u); break; } } } } while (0)
struct XcdBarrier { unsigned* bar; unsigned x; volatile LAS unsigned* st; };
DI XcdBarrier xcd_barrier_post(unsigned* bar, volatile LAS unsigned* st) {
    XcdBarrier b; b.bar = bar; b.x = xb_xcc_id(); b.st = st;
    if (threadIdx.x == 0) (void)xb_add(&bar[XB_XCNT(b.x)], 1u);
    return b;
}
DI void xcd_barrier_complete(unsigned* bar, unsigned x, unsigned& nloc, unsigned& nx) {
    const unsigned G = gridDim.x * gridDim.y * gridDim.z;
    unsigned sum, cnt, mine, sp = 0u;
    for (;;) {
        sum = 0u; cnt = 0u; mine = 0u;
#pragma unroll
        for (unsigned j = 0; j < 16; ++j) { const unsigned c = xb_ld(&bar[XB_XCNT(j)]); sum += c; cnt += (c > 0u) ? 1u : 0u; mine = (j == x) ? c : mine; }
        if (sum == G) break;
        __builtin_amdgcn_s_sleep(1);
        if ((++sp & 255u) == 0u) { if (xb_ld(&bar[XB_TMO])) break; if (sp > XB_SPIN_CAP) { atomicAdd(&bar[XB_TMO], 1u); break; } }
    }
    nloc = mine > 0u ? mine : 1u; nx = cnt > 0u ? cnt : 1u;
}
DI void xcd_barrier(const XcdBarrier& b) {
    asm volatile("s_waitcnt vmcnt(0)" ::: "memory");
    __syncthreads();
    if (threadIdx.x == 0) {
        unsigned* bar = b.bar;
        __builtin_amdgcn_s_waitcnt(0);
        unsigned nloc = b.st[0], nx = b.st[1];
        if (nloc == 0u) { xcd_barrier_complete(bar, b.x, nloc, nx); b.st[0] = nloc; b.st[1] = nx; }
        const unsigned old = xb_add(&bar[XB_XSUB(b.x)], 1u);
        const unsigned gen = old / nloc;
        if (old + 1u == (gen + 1u) * nloc) {
            __builtin_amdgcn_fence(__ATOMIC_RELEASE, "agent");
            asm volatile("s_waitcnt vmcnt(0)" ::: "memory");
            const unsigned og = xb_add(&bar[XB_TOP], 1u);
            const unsigned tg = og / nx;
            if (og + 1u == (tg + 1u) * nx) xb_add(&bar[XB_TOPGEN], 1u);
            else XB_SPIN(xb_ld(&bar[XB_TOPGEN]) == tg, bar);
            __builtin_amdgcn_fence(__ATOMIC_ACQUIRE, "agent");
            xb_add(&bar[XB_XGEN(b.x)], 1u);
            asm volatile("s_waitcnt vmcnt(0)" ::: "memory");
        } else {
            XB_SPIN(xb_ld(&bar[XB_XGEN(b.x)]) == gen, bar);
            __builtin_amdgcn_fence(__ATOMIC_ACQUIRE, "agent");
            asm volatile("s_waitcnt vmcnt(0)" ::: "memory");
        }
    }
    __syncthreads();
}

struct P { const void* in[26]; float* out; unsigned char* ws; };
struct Frame { LAS unsigned char* lds; int tid, lane, wave, bid, G, gw, ngw; };
#define MFMA32(a, b, c) __builtin_amdgcn_mfma_f32_32x32x16_bf16((a), (b), (c), 0, 0, 0)
#define MFMA16(a, b, c) __builtin_amdgcn_mfma_f32_16x16x32_bf16((a), (b), (c), 0, 0, 0)
DI int crow(int reg, int h) { return (reg & 3) + 8 * (reg >> 2) + 4 * h; }
DI u32x2 pack4(f32x4 v) { u32x2 w; w.x = pk2(v[0], v[1]); w.y = pk2(v[2], v[3]); return w; }

DI void tr_item(const float* W, int K, int N, int ldw, bf16* WT, int dst_row0, LAS float* scr, int k0, int n0, int lane) {
    const int nn = n0 + (lane & 31); const bool ok = nn < N;
    float tv[32];
#pragma unroll
    for (int i = 0; i < 32; ++i) tv[i] = ok ? W[(size_t)(k0 + 2 * i + (lane >> 5)) * ldw + nn] : 0.f;
#pragma unroll
    for (int i = 0; i < 32; ++i) scr[(2 * i + (lane >> 5)) * 33 + (lane & 31)] = tv[i];
    LDS_WAIT();
    const int c = lane & 7;
#pragma unroll
    for (int j = 0; j < 4; ++j) { const int n = (lane >> 3) + 8 * j; const LAS float* s = scr + (8 * c) * 33 + n;
        u32x4 o; o.x = pk2(s[0 * 33], s[1 * 33]); o.y = pk2(s[2 * 33], s[3 * 33]); o.z = pk2(s[4 * 33], s[5 * 33]); o.w = pk2(s[6 * 33], s[7 * 33]);
        *(u32x4*)(WT + (size_t)(dst_row0 + n) * K + k0 + 8 * c) = o; }
    LDS_WAIT();
}
DI void p0_weights(const P& p, const Frame& F, int which) {
    LAS float* scr = (LAS float*)(F.lds + F.wave * 16384);
    constexpr int C_GIN = 16 * (GINP / 32), C_SQ = 16 * 32, C_NIN = 16 * (NINP / 32), C_FIN = 16 * (FF2 / 32), C_FOUT = (FF / 64) * 32, C_C1 = 16 * 8;
    constexpr int TOT = 2 * C_GIN + 2 * C_SQ + 2 * C_NIN + 2 * C_SQ + 4 * C_FIN + 4 * C_FOUT + 8 * C_C1;
    for (int it = F.gw; it < TOT; it += F.ngw) {
        int r = it; const float* W; int K = DM, N, Npad, ldw; bf16* WT; int mode = 0, rowoff = 0;
        bool l0 = false;
        if (r < 2 * C_GIN) { const int li = r / C_GIN; r -= li * C_GIN; l0 = li == 0; W = (const float*)p.in[10] + (size_t)li * DM * GIN; N = GIN; Npad = GINP; ldw = GIN; WT = (bf16*)(p.ws + WS_WG_IN + li * SZ_WG_IN); }
        else if ((r -= 2 * C_GIN) < 2 * C_SQ) { const int li = r / C_SQ; r -= li * C_SQ; l0 = li == 0; W = (const float*)p.in[15] + (size_t)li * DM * DM; N = DM; Npad = DM; ldw = DM; WT = (bf16*)(p.ws + WS_WG_OUT + li * SZ_W1K); }
        else if ((r -= 2 * C_SQ) < 2 * C_NIN) { const int li = r / C_NIN; r -= li * C_NIN; W = (const float*)p.in[16] + (size_t)li * DM * NIN; N = NIN; Npad = NINP; ldw = NIN; WT = (bf16*)(p.ws + WS_WN_IN + li * SZ_WN_IN); }
        else if ((r -= 2 * C_NIN) < 2 * C_SQ) { const int li = r / C_SQ; r -= li * C_SQ; W = (const float*)p.in[23] + (size_t)li * DM * DM; N = DM; Npad = DM; ldw = DM; WT = (bf16*)(p.ws + WS_WN_OUT + li * SZ_W1K); }
        else if ((r -= 2 * C_SQ) < 4 * C_FIN) { const int i = r / C_FIN; r -= i * C_FIN; l0 = i == 0; W = (const float*)p.in[24] + (size_t)i * DM * FF2; N = FF2; Npad = FF2; ldw = FF2; WT = (bf16*)(p.ws + WS_WF_IN + i * SZ_WF_IN); mode = 1; }
        else if ((r -= 4 * C_FIN) < 4 * C_FOUT) { const int i = r / C_FOUT; r -= i * C_FOUT; l0 = i == 0; W = (const float*)p.in[25] + (size_t)i * FF * DM; K = FF; N = DM; Npad = DM; ldw = DM; WT = (bf16*)(p.ws + WS_WF_OUT + i * SZ_WF_OUT); }
        else { r -= 4 * C_FOUT; const int id = r / C_C1; r -= id * C_C1; const int li = id >> 2, kv = (id >> 1) & 1, half = id & 1;
            W = (const float*)(kv ? p.in[21] : p.in[19]) + (size_t)li * 2048 * 256 + (size_t)half * 1024 * 256; N = 256; Npad = 256; ldw = 256; WT = (bf16*)(p.ws + WS_WC1 + (li * 2 + kv) * SZ_WC1); rowoff = half * 256; }
        if (l0 != (which == 0)) continue;
        const int nblk = Npad / 32, kb = r / nblk, nb = r % nblk, n0 = nb * 32;
        int drow = n0 + rowoff;
        if (mode == 1) { const int j = n0 < FF ? n0 : n0 - FF; drow = 256 * (j >> 7) + (j & 127) + (n0 < FF ? 0 : 128); }
        tr_item(W, K, N, ldw, WT, drow, scr, kb * 64, n0, F.lane);
    }
}
DI void p0_cbias(const P& p, const Frame& F) {
    LAS float* red = (LAS float*)F.lds;
    float* part = (float*)(p.ws + WS_PC_P);
    for (int t = F.bid; t < 256; t += F.G) {
        const int id = t >> 6, sl = t & 63, li = id >> 1, kv = id & 1, c = F.tid & 255, half = F.tid >> 8;
        const float* w1 = (const float*)(kv ? p.in[21] : p.in[19]) + (size_t)li * 2048 * 256; const float* pe = (const float*)(kv ? p.in[18] : p.in[17]) + (size_t)li * 2048;
        const int k0 = sl * 32 + half * 16; float acc = 0.f;
#pragma unroll
        for (int kk = 0; kk < 16; ++kk) acc += pe[k0 + kk] * w1[(size_t)(k0 + kk) * 256 + c];
        red[F.tid] = acc; __syncthreads();
        if (F.tid < 256) part[(size_t)t * 256 + c] = red[F.tid] + red[F.tid + 256];
        __syncthreads();
    }
}
DI void p0_cbias2(const P& p, const Frame& F) {
    const float* part = (const float*)(p.ws + WS_PC_P);
    for (int id = F.bid; id < 4; id += F.G) if (F.tid < 256) { float acc = 0.f;
#pragma unroll 16
        for (int sl = 0; sl < 64; ++sl) acc += part[(size_t)(id * 64 + sl) * 256 + F.tid];
        ((float*)(p.ws + WS_CBIAS))[id * 256 + F.tid] = acc; }
}
DI void cache_kv_item(const P& p, int li, int id, int lane, int phys_in = -1) {
    const int* pt = (const int*)p.in[6];
    bf16* cmps = (bf16*)(p.ws + WS_CMPS + li * SZ_CMPS); bf16* kslc = (bf16*)(p.ws + WS_KSLC_S + li * SZ_SLC_S); bf16* vslc = (bf16*)(p.ws + WS_VSLCT_S + li * SZ_SLC_S);
    const int b = id >> 8, pg = (id >> 4) & 15, s8 = id & 15;
    const int phys = phys_in >= 0 ? phys_in : pt[b * NPAGE + pg];
    const float* src = (const float*)p.in[2] + (((size_t)li * NPHYS + phys) * PAGE + s8 * 8) * 512;
    f32x4 a[8], c[8];
#pragma unroll
    for (int rr = 0; rr < 8; ++rr) { a[rr] = *(const f32x4*)(src + (size_t)rr * 512 + lane * 4); c[rr] = *(const f32x4*)(src + (size_t)rr * 512 + 256 + lane * 4); }
    const int kind = lane >> 5, g = (lane >> 4) & 1, d = (lane & 15) * 4;
    bf16* dst2 = (kind ? vslc : kslc) + (size_t)(b * 2 + g) * SLC_S_ROWS * 64 + d;
#pragma unroll
    for (int rr = 0; rr < 8; ++rr) { const int pos = pg * PAGE + s8 * 8 + rr;
        *(u32x2*)(cmps + ((size_t)b * PAST + pos) * 256 + lane * 4) = pack4(a[rr]);
        *(u32x2*)(dst2 + (size_t)pos * 64) = pack4(c[rr]); }
}
DI void p0_cache_win(const P& p, const Frame& F, int li) {
    bf16* kwin = (bf16*)(p.ws + WS_KWIN_S + li * SZ_WIN_S); bf16* vwin = (bf16*)(p.ws + WS_VWINT_S + li * SZ_WIN_S);
    for (int id = F.gw; id < DB * 64; id += F.ngw) {
        const int b = id >> 6, r8 = id & 63;
        const float* src = (const float*)p.in[3] + (((size_t)li * DB + b) * 512 + r8 * 8) * 256;
        float* outw = p.out + O_WINS + (size_t)(li * DB + b) * 512 * 256;
        f32x4 a[8];
#pragma unroll
        for (int rr = 0; rr < 8; ++rr) a[rr] = *(const f32x4*)(src + (size_t)rr * 256 + F.lane * 4);
        const int kind = F.lane >> 5, g = (F.lane >> 4) & 1, d = (F.lane & 15) * 4;
        bf16* dst2 = (kind ? vwin : kwin) + (size_t)(b * 2 + g) * WIN_S_ROWS * 64 + d;
#pragma unroll
        for (int rr = 0; rr < 8; ++rr) { const int idx = r8 * 8 + rr;
            if (idx >= 8) *(f32x4*)(outw + (size_t)(idx - 8) * 256 + F.lane * 4) = a[rr];
            *(u32x2*)(dst2 + (size_t)idx * 64) = pack4(a[rr]); }
    }
}
template <int MODE> DI void rms_phase(const P& p, const Frame& F, const float* w) {
    float* X = (float*)(p.ws + WS_X); bf16* XN = (bf16*)(p.ws + WS_XN);
    f32x4 wv[4];
#pragma unroll
    for (int j = 0; j < 4; ++j) wv[j] = ((const f32x4*)w)[F.lane + 64 * j];
    for (int row = F.gw; row < M; row += F.ngw) {
        const float* src = MODE == 0 ? (row < MP ? (const float*)p.in[0] + (size_t)row * DM : (const float*)p.in[1] + (size_t)(row - MP) * DM) : X + (size_t)row * DM;
        f32x4 v[4]; float ss = 0.f;
#pragma unroll
        for (int j = 0; j < 4; ++j) { v[j] = ((const f32x4*)src)[F.lane + 64 * j]; ss += (v[j][0] * v[j][0] + v[j][1] * v[j][1]) + (v[j][2] * v[j][2] + v[j][3] * v[j][3]); }
        const float rstd = __builtin_amdgcn_rsqf(wave_sum(ss) * (1.f / DM) + 1e-6f);
#pragma unroll
        for (int j = 0; j < 4; ++j) { const f32x4 o = v[j] * rstd * wv[j];
            if (MODE == 2) ((f32x4*)(p.out + O_Y + (size_t)row * DM))[F.lane + 64 * j] = o;
            else ((u32x2*)(XN + (size_t)row * DM))[F.lane + 64 * j] = pack4(o);
            if (MODE == 0) ((f32x4*)(X + (size_t)row * DM))[F.lane + 64 * j] = v[j]; }
    }
}

DI void gdn_prep(const P& p, const Frame& F, int li) {
    const bf16* H = (const bf16*)(p.ws + WS_H);
    bf16* QH = (bf16*)(p.ws + WS_QH); bf16* KH = (bf16*)(p.ws + WS_KH); bf16* VH = (bf16*)(p.ws + WS_VH);
    float* BETA = (float*)(p.ws + WS_BETA); float* LOGA = (float*)(p.ws + WS_LOGA);
    const float* cw = (const float*)p.in[11] + (size_t)li * 4 * GQKV;
    const float* cbuf = (const float*)p.in[5] + (size_t)li * DB * 3 * GQKV;
    const float* Alog = (const float*)p.in[12] + li * 8; const float* dtb = (const float*)p.in[13] + li * 8;
    LAS float* wl = (LAS float*)F.lds;
    for (int i = F.tid; i < 4 * GQKV / 4; i += 512) ((LAS f32x4*)wl)[i] = ((const f32x4*)cw)[i];
    __syncthreads();
    for (int row = F.gw; row < M; row += F.ngw) {
        int b, t; const bool smp = row >= MP;
        if (!smp) { b = row >> 12; t = row & 4095; } else { b = (row - MP) >> 3; t = (row - MP) & 7; }
        u32x4 xr[4][6];
#pragma unroll
        for (int k = 0; k < 4; ++k) { const int tt = t - 3 + k;
#pragma unroll
            for (int cc = 0; cc < 6; ++cc) { const int c = (cc >> 1) * 1024 + ((cc & 1) * 64 + F.lane) * 8;
                if (tt >= 0) xr[k][cc] = *(const u32x4*)(H + (size_t)(row - 3 + k) * GINP + c);
                else if (smp) { const float* s = cbuf + ((size_t)b * 3 + (3 + tt)) * GQKV + c; const f32x4 v0 = *(const f32x4*)s, v1 = *(const f32x4*)(s + 4);
                    xr[k][cc] = (u32x4){pk2(v0[0], v0[1]), pk2(v0[2], v0[3]), pk2(v1[0], v1[1]), pk2(v1[2], v1[3])}; }
                else xr[k][cc] = (u32x4){0u, 0u, 0u, 0u}; } }
#pragma unroll
        for (int part = 0; part < 3; ++part) {
            asm volatile("" ::: "memory");
            float y[2][8]; float ss[2];
#pragma unroll
            for (int k2 = 0; k2 < 2; ++k2) { const int cc = part * 2 + k2, c = part * 1024 + (k2 * 64 + F.lane) * 8;
#pragma unroll
                for (int e = 0; e < 8; ++e) y[k2][e] = 0.f;
#pragma unroll
                for (int k = 0; k < 4; ++k) { const f32x4 w0 = *(const LAS f32x4*)(wl + k * GQKV + c), w1 = *(const LAS f32x4*)(wl + k * GQKV + c + 4); const u32x4 x = xr[k][cc];
                    y[k2][0] += w0[0] * bflo(x.x); y[k2][1] += w0[1] * bfhi(x.x); y[k2][2] += w0[2] * bflo(x.y); y[k2][3] += w0[3] * bfhi(x.y);
                    y[k2][4] += w1[0] * bflo(x.z); y[k2][5] += w1[1] * bfhi(x.z); y[k2][6] += w1[2] * bflo(x.w); y[k2][7] += w1[3] * bfhi(x.w); }
                float s2 = 0.f;
#pragma unroll
                for (int e = 0; e < 8; ++e) { y[k2][e] = siluf_(y[k2][e]); s2 += y[k2][e] * y[k2][e]; }
                s2 = sum16(s2);
                ss[k2] = s2;
                const int jo = smp ? t - (DS - 3) : t - (SEQ - 3);
                if (jo >= 0) { float* o = p.out + (smp ? O_GCS + ((size_t)(li * DB + b) * 3 + jo) * GQKV : O_GCP + ((size_t)(li * NB + b) * 3 + jo) * GQKV) + c; const u32x4 x = xr[3][cc];
                    *(f32x4*)o = (f32x4){bflo(x.x), bfhi(x.x), bflo(x.y), bfhi(x.y)}; *(f32x4*)(o + 4) = (f32x4){bflo(x.z), bfhi(x.z), bflo(x.w), bfhi(x.w)}; }
            }
            bf16* dst = part == 0 ? QH : (part == 1 ? KH : VH);
#pragma unroll
            for (int k2 = 0; k2 < 2; ++k2) { const float sc = part == 0 ? __builtin_amdgcn_rsqf(ss[k2] + 1e-6f) * 0.08838834764831845f : (part == 1 ? __builtin_amdgcn_rsqf(ss[k2] + 1e-6f) : 1.f);
                *(u32x4*)(dst + (size_t)row * DM + (k2 * 64 + F.lane) * 8) = (u32x4){pk2(y[k2][0] * sc, y[k2][1] * sc), pk2(y[k2][2] * sc, y[k2][3] * sc), pk2(y[k2][4] * sc, y[k2][5] * sc), pk2(y[k2][6] * sc, y[k2][7] * sc)}; }
        }
        if (F.lane < 8) { const int hh = F.lane;
            const float bb = bf2f(H[(size_t)row * GINP + 4096 + hh]), aa = bf2f(H[(size_t)row * GINP + 4104 + hh]) + dtb[hh];
            const float sp = aa > 20.f ? aa : log1pf(__expf(aa));
            BETA[(size_t)row * 8 + hh] = sigmoidf_(bb); LOGA[(size_t)row * 8 + hh] = -__expf(Alog[hh]) * sp; }
    }
}
DI void gdn_chunk(const P& p, const Frame& F, int li) {
    const bf16* QH = (const bf16*)(p.ws + WS_QH); const bf16* KH = (const bf16*)(p.ws + WS_KH); const bf16* VH = (const bf16*)(p.ws + WS_VH);
    const float* BETA = (const float*)(p.ws + WS_BETA); const float* LOGA = (const float*)(p.ws + WS_LOGA);
    bf16* CW = (bf16*)(p.ws + WS_CW); float* CUT = (float*)(p.ws + WS_CUT); bf16* CAQK = (bf16*)(p.ws + WS_CAQK); bf16* CQT = (bf16*)(p.ws + WS_CQT); bf16* CKTT = (bf16*)(p.ws + WS_CKTT); float* CEGL = (float*)(p.ws + WS_CEGL);
    LAS float* Gs = (LAS float*)F.lds; LAS float* bs = Gs + 64; LAS float* Lm = Gs + 128;
    for (int task = F.bid; task < NCHUNK; task += F.G) {
        const int b = task >> 9, hh = (task >> 6) & 7, c = task & 63, r0 = b * SEQ + c * 64;
        if (F.wave == 0) { float la = LOGA[(size_t)(r0 + F.lane) * 8 + hh];
#pragma unroll
            for (int o = 1; o < 64; o <<= 1) { const float tq = __shfl_up(la, o); if (F.lane >= o) la += tq; }
            const float bt = BETA[(size_t)(r0 + F.lane) * 8 + hh]; Gs[F.lane] = la; bs[F.lane] = bt; Gs[64 * 66 + F.lane] = bt * __expf(la); }
        __syncthreads();
        { const int which = F.wave >> 2, ti = (F.wave >> 1) & 1, tj = F.wave & 1, r = F.lane & 31, h = F.lane >> 5;
          const bf16* Ar = (which ? QH : KH) + (size_t)(r0 + 32 * ti + r) * DM + hh * 128 + 8 * h;
          const bf16* Br = KH + (size_t)(r0 + 32 * tj + r) * DM + hh * 128 + 8 * h;
          f32x16 cc; for (int e = 0; e < 16; ++e) cc[e] = 0.f;
#pragma unroll
          for (int ks = 0; ks < 8; ++ks) cc = MFMA32(*(const bf16x8*)(Ar + 16 * ks), *(const bf16x8*)(Br + 16 * ks), cc);
          const int j = 32 * tj + r; const float Gj = Gs[j];
#pragma unroll
          for (int reg = 0; reg < 16; ++reg) { const int i = 32 * ti + crow(reg, h); const float dec = (j <= i) ? __expf(Gs[i] - Gj) : 0.f;
              if (which == 0) Lm[i * 64 + j] = (j < i) ? bs[i] * cc[reg] * dec : 0.f;
              else CAQK[(size_t)task * 4096 + i * 64 + j] = (bf16)f2bf(cc[reg] * dec); } }
        __syncthreads();
        if (F.tid < 256) {
            const int col = F.tid; const bool isk = col < 128;
            const bf16* src = (isk ? KH : VH) + (size_t)r0 * DM + hh * 128 + (col & 127);
            const LAS float* sc2 = isk ? (Gs + 64 * 66) : bs;
            float x[64];
#pragma unroll
            for (int i = 0; i < 64; ++i) x[i] = bf2f(src[(size_t)i * DM]);
            asm volatile("" ::: "memory");
#pragma unroll
            for (int i = 0; i < 64; ++i) { float acc = x[i] * sc2[i];
#pragma unroll
                for (int j4 = 0; j4 < (i + 3) / 4; ++j4) { const f32x4 L4 = *(const LAS f32x4*)(Lm + i * 64 + 4 * j4);
                    acc -= L4[0] * x[4 * j4] + L4[1] * x[4 * j4 + 1] + L4[2] * x[4 * j4 + 2] + L4[3] * x[4 * j4 + 3]; }
                x[i] = acc; if ((i & 3) == 3) asm volatile("" ::: "memory"); }
            if (isk) {
#pragma unroll
                for (int i = 0; i < 64; ++i) CW[(size_t)task * 8192 + i * 128 + col] = (bf16)f2bf(x[i]); }
            else { float* d = CUT + ((size_t)task * 128 + (col - 128)) * 64;
#pragma unroll
                for (int i4 = 0; i4 < 16; ++i4) *(f32x4*)(d + 4 * i4) = (f32x4){x[4 * i4], x[4 * i4 + 1], x[4 * i4 + 2], x[4 * i4 + 3]}; }
        } else {
            const int t2 = F.tid - 256, dk = t2 & 127, half = t2 >> 7;
            { const bf16* sp = (half == 0 ? QH : KH) + (size_t)r0 * DM + hh * 128 + dk; const float Gl = Gs[63];
#pragma unroll
              for (int hb = 0; hb < 2; ++hb) { bf16 raw[32];
#pragma unroll
                for (int i = 0; i < 32; ++i) raw[i] = sp[(size_t)(32 * hb + i) * DM];
                if (half == 0) {
#pragma unroll
                    for (int i = 0; i < 32; ++i) CQT[(size_t)task * 8192 + (32 * hb + i) * 128 + dk] = (bf16)f2bf(__expf(Gs[32 * hb + i]) * bf2f(raw[i]));
                } else {
#pragma unroll
                    for (int i8 = 0; i8 < 4; ++i8) { float v[8];
#pragma unroll
                        for (int e = 0; e < 8; ++e) v[e] = bf2f(raw[8 * i8 + e]) * __expf(Gl - Gs[32 * hb + 8 * i8 + e]);
                        *(u32x4*)(CKTT + ((size_t)task * 128 + dk) * 64 + 32 * hb + 8 * i8) = (u32x4){pk2(v[0], v[1]), pk2(v[2], v[3]), pk2(v[4], v[5]), pk2(v[6], v[7])}; } }
                asm volatile("" ::: "memory"); } }
            if (t2 == 0) CEGL[task] = __expf(Gs[63]);
{ const int id0 = (task * 4 + (F.wave - 4)) * 4; const int ph = ((const int*)p.in[6])[(id0 >> 8) * NPAGE + ((id0 >> 4) & 15)];
#pragma unroll 1
            for (int k = 0; k < 4; ++k) cache_kv_item(p, li, id0 + k, F.lane, ph); }
        }
        __syncthreads();
    }
}
DI int sw16(int row, int ch) { return row * 256 + ((ch ^ (row & 15)) << 4); }
DI int sw8(int row, int ch) { return row * 128 + ((ch ^ ((row >> 1) & 7)) << 4); }
DI void gdn_scan(const P& p, const Frame& F, int li, int sid) {
    const bf16* CW = (const bf16*)(p.ws + WS_CW); const float* CUT = (const float*)(p.ws + WS_CUT); const bf16* CAQK = (const bf16*)(p.ws + WS_CAQK); const bf16* CQT = (const bf16*)(p.ws + WS_CQT); const bf16* CKTT = (const bf16*)(p.ws + WS_CKTT); const float* CEGL = (const float*)(p.ws + WS_CEGL);
    float* OG = (float*)(p.ws + WS_OG);
    constexpr int SBUF = 57344;
    LAS bf16* St = (LAS bf16*)(F.lds + ((F.wave & 3) < 2 ? 2 * SBUF + (F.wave & 3) * 6656 : PTAB_OFF + 256 + ((F.wave & 3) - 2) * 6656)); LAS bf16* uT = St + 16 * 136;
    const int a16 = F.lane & 15, kg = F.lane >> 4, sl = (sid & 1) * 4 + (F.wave & 3), b = sid >> 4, hh = (sid >> 1) & 7; const bool cwv = F.wave < 4;
    sid >>= 1;
    int so[4];
    { const int q0 = F.tid, q1 = F.tid + 512;
      so[0] = (q0 >> 4) * 128 + (((q0 & 15) ^ ((q0 >> 4) & 15)) << 3); so[1] = (q1 >> 4) * 128 + (((q1 & 15) ^ ((q1 >> 4) & 15)) << 3);
      so[2] = (q0 >> 3) * 64 + (((q0 & 7) ^ ((q0 >> 4) & 7)) << 3); so[3] = (q1 >> 3) * 64 + (((q1 & 7) ^ ((q1 >> 4) & 7)) << 3); }
    const unsigned wbase = (unsigned)F.wave * 1024u;
    f32x4 utn[4]; float egn;
#define SCAN_G2L(srcp, off) __builtin_amdgcn_global_load_lds((const unsigned*)(srcp), (LAS unsigned*)(F.lds + (off) + wbase), 16, 0, 0)
#define SCAN_DMA(c_, buf_) do { const size_t task_ = (size_t)sid * 64 + (c_); const int bo_ = (buf_) * SBUF; \
        SCAN_G2L(CW + task_ * 8192 + so[0], bo_); SCAN_G2L(CW + task_ * 8192 + so[1], bo_ + 8192); \
        SCAN_G2L(CQT + task_ * 8192 + so[0], bo_ + 16384); SCAN_G2L(CQT + task_ * 8192 + so[1], bo_ + 16384 + 8192); \
        SCAN_G2L(CKTT + task_ * 8192 + so[2], bo_ + 32768); SCAN_G2L(CKTT + task_ * 8192 + so[3], bo_ + 32768 + 8192); \
        SCAN_G2L(CAQK + task_ * 4096 + so[2], bo_ + 49152); } while (0)
#define SCAN_UT(c_) do { const size_t task_ = (size_t)sid * 64 + (c_); \
        _Pragma("unroll") for (int mt = 0; mt < 4; ++mt) utn[mt] = *(const f32x4*)(CUT + task_ * 8192 + (16 * sl + a16) * 64 + 16 * mt + 4 * kg); \
        egn = CEGL[task_]; } while (0)
    f32x4 S[8];
#pragma unroll
    for (int m = 0; m < 8; ++m) { S[m] = (f32x4){0.f, 0.f, 0.f, 0.f}; if (cwv) *(LAS u32x2*)(St + a16 * 136 + 16 * m + 4 * kg) = (u32x2){0u, 0u}; }
    SCAN_DMA(0, 0);
    if (cwv) SCAN_UT(0);
    __builtin_amdgcn_s_waitcnt(0x0070);
    f32x4 ut[4]; float egl;
    if (!cwv) {
        for (int c = 0; c < 64; ++c) {
            asm volatile("" ::: "memory"); __builtin_amdgcn_s_waitcnt(0x0070); __builtin_amdgcn_s_barrier(); asm volatile("" ::: "memory");
            if (c + 1 < 64) SCAN_DMA(c + 1, (c + 1) & 1);
        }
    } else
    for (int c = 0; c < 64; ++c) {
        asm volatile("" ::: "memory"); __builtin_amdgcn_s_waitcnt(0x4070); __builtin_amdgcn_s_barrier(); asm volatile("" ::: "memory");
        if (c + 1 < 64) SCAN_DMA(c + 1, (c + 1) & 1);
        {
#pragma unroll
        for (int mt = 0; mt < 4; ++mt)
#pragma unroll
            for (int e = 0; e < 4; ++e) { float t_; asm volatile("v_mov_b32 %0, %1" : "=v"(t_) : "v"(utn[mt][e])); ut[mt][e] = t_; }
        { float t_; asm volatile("v_mov_b32 %0, %1" : "=v"(t_) : "v"(egn)); egl = t_; }
        if (c + 1 < 64) SCAN_UT(c + 1);
        LAS unsigned char* sW = F.lds + (c & 1) * SBUF; LAS unsigned char* sQ = sW + 16384; LAS unsigned char* sK = sW + 32768; LAS unsigned char* sA = sW + 49152;
        bf16x8 sb[4];
#pragma unroll
        for (int ks = 0; ks < 4; ++ks) sb[ks] = *(const LAS bf16x8*)(St + a16 * 136 + 32 * ks + 8 * kg);
        f32x4 u[4], oq[4];
#pragma unroll
        for (int mt = 0; mt < 4; ++mt) { f32x4 acc = (f32x4){0.f, 0.f, 0.f, 0.f}, acq = (f32x4){0.f, 0.f, 0.f, 0.f};
#pragma unroll
            for (int ks = 0; ks < 4; ++ks) { acc = MFMA16(*(const LAS bf16x8*)(sW + sw16(16 * mt + a16, 4 * ks + kg)), sb[ks], acc);
                                             acq = MFMA16(*(const LAS bf16x8*)(sQ + sw16(16 * mt + a16, 4 * ks + kg)), sb[ks], acq); }
            u[mt] = ut[mt] - acc; oq[mt] = acq; }
        bf16x8 af[4][2];
#pragma unroll
        for (int mt = 0; mt < 4; ++mt)
#pragma unroll
            for (int k2 = 0; k2 < 2; ++k2) af[mt][k2] = *(const LAS bf16x8*)(sA + sw8(16 * mt + a16, 4 * k2 + kg));
#pragma unroll
        for (int mt = 0; mt < 4; ++mt) *(LAS u32x2*)(uT + a16 * 72 + 16 * mt + 4 * kg) = pack4(u[mt]);
        bf16x8 ub[2];
#pragma unroll
        for (int k2 = 0; k2 < 2; ++k2) ub[k2] = *(const LAS bf16x8*)(uT + a16 * 72 + 32 * k2 + 8 * kg);
#pragma unroll
        for (int mt = 0; mt < 4; ++mt) { f32x4 acc = oq[mt];
#pragma unroll
            for (int k2 = 0; k2 < 2; ++k2) acc = MFMA16(af[mt][k2], ub[k2], acc);
#pragma unroll
            for (int e = 0; e < 4; ++e) OG[(size_t)(b * SEQ + 64 * c + 16 * mt + 4 * kg + e) * DM + hh * 128 + 16 * sl + a16] = acc[e]; }
#pragma unroll
        for (int m = 0; m < 8; ++m) { f32x4 acc = S[m] * egl;
#pragma unroll
            for (int k2 = 0; k2 < 2; ++k2) acc = MFMA16(*(const LAS bf16x8*)(sK + sw8(16 * m + a16, 4 * k2 + kg)), ub[k2], acc);
            S[m] = acc; *(LAS u32x2*)(St + a16 * 136 + 16 * m + 4 * kg) = pack4(acc); }
        }
    }
#undef SCAN_DMA
#undef SCAN_UT
#undef SCAN_G2L
    asm volatile("s_waitcnt vmcnt(0) lgkmcnt(0)" ::: "memory"); __builtin_amdgcn_s_barrier(); asm volatile("" ::: "memory");
    float* gs = p.out + O_GSP + (size_t)((li * NB + b) * GH + hh) * 128 * 128;
    if (cwv)
#pragma unroll
    for (int m = 0; m < 8; ++m)
#pragma unroll
        for (int e = 0; e < 4; ++e) gs[(size_t)(16 * m + 4 * kg + e) * 128 + 16 * sl + a16] = S[m][e];
}
DI void gdn_sample(const P& p, const Frame& F, int li, int task) {
    const bf16* QH = (const bf16*)(p.ws + WS_QH); const bf16* KH = (const bf16*)(p.ws + WS_KH); const bf16* VH = (const bf16*)(p.ws + WS_VH);
    const float* BETA = (const float*)(p.ws + WS_BETA); const float* LOGA = (const float*)(p.ws + WS_LOGA); float* OG = (float*)(p.ws + WS_OG);
    LAS float* ks = (LAS float*)F.lds; LAS float* qs = ks + 1024; LAS float* vs = qs + 1024; LAS float* Gs = vs + 1024; LAS float* bs = Gs + 8; LAS float* KK = bs + 8; LAS float* QK = KK + 64; LAS float* red = QK + 64;
    const int b = task >> 3, hh = task & 7, rb = MP + b * 8;
#pragma unroll
    for (int e = 0; e < 6; ++e) { const int idx = F.tid + 512 * e, part = idx >> 10, i = (idx >> 7) & 7, d = idx & 127;
        const bf16* s = part == 0 ? KH : (part == 1 ? QH : VH);
        ks[idx] = bf2f(s[(size_t)(rb + i) * DM + hh * 128 + d]); }
    if (F.tid == 0) { float g = 0.f; for (int i = 0; i < 8; ++i) { g += LOGA[(size_t)(rb + i) * 8 + hh]; Gs[i] = g; bs[i] = BETA[(size_t)(rb + i) * 8 + hh]; } }
    __syncthreads();
    if (F.tid < 128) { const int which = F.tid >> 6, i = (F.tid >> 3) & 7, j = F.tid & 7; const LAS float* a = (which ? qs : ks) + i * 128; const LAS float* bb = ks + j * 128; float acc = 0.f;
        for (int d = 0; d < 128; ++d) acc += a[d] * bb[d];
        KK[which * 64 + i * 8 + j] = acc; }
    const int dv = F.tid & 127, qt = F.tid >> 7, dk0 = qt * 32;
    const float* st = (const float*)p.in[4] + ((size_t)((li * DB + b) * GH + hh) * 128 + dk0) * 128 + dv;
    float s0[32];
#pragma unroll
    for (int e = 0; e < 32; ++e) s0[e] = st[(size_t)e * 128];
    float pk[8], pq[8];
#pragma unroll
    for (int i = 0; i < 8; ++i) { pk[i] = 0.f; pq[i] = 0.f; }
#pragma unroll
    for (int e = 0; e < 32; ++e)
#pragma unroll
        for (int i = 0; i < 8; ++i) { pk[i] += ks[i * 128 + dk0 + e] * s0[e]; pq[i] += qs[i * 128 + dk0 + e] * s0[e]; }
#pragma unroll
    for (int i = 0; i < 8; ++i) { red[(qt * 16 + i) * 128 + dv] = pk[i]; red[(qt * 16 + 8 + i) * 128 + dv] = pq[i]; }
    __syncthreads();
    float u[8], eg[8];
#pragma unroll
    for (int i = 0; i < 8; ++i) { eg[i] = __expf(Gs[i]);
        const float kS = red[(0 * 16 + i) * 128 + dv] + red[(1 * 16 + i) * 128 + dv] + red[(2 * 16 + i) * 128 + dv] + red[(3 * 16 + i) * 128 + dv];
        float acc = bs[i] * (vs[i * 128 + dv] - eg[i] * kS);
#pragma unroll
        for (int j = 0; j < i; ++j) acc -= bs[i] * KK[i * 8 + j] * __expf(Gs[i] - Gs[j]) * u[j];
        u[i] = acc; }
    if (qt == 0) {
#pragma unroll
        for (int i = 0; i < 8; ++i) { const float qS = red[(0 * 16 + 8 + i) * 128 + dv] + red[(1 * 16 + 8 + i) * 128 + dv] + red[(2 * 16 + 8 + i) * 128 + dv] + red[(3 * 16 + 8 + i) * 128 + dv];
            float acc = eg[i] * qS;
#pragma unroll
            for (int j = 0; j <= i; ++j) acc += QK[i * 8 + j] * __expf(Gs[i] - Gs[j]) * u[j];
            OG[(size_t)(rb + i) * DM + hh * 128 + dv] = acc; } }
    float* so = p.out + O_GSS + ((size_t)((li * DB + b) * GH + hh) * 128 + dk0) * 128 + dv;
    float tl[8];
#pragma unroll
    for (int i = 0; i < 8; ++i) tl[i] = __expf(Gs[7] - Gs[i]) * u[i];
#pragma unroll
    for (int e = 0; e < 32; ++e) { float acc = eg[7] * s0[e];
#pragma unroll
        for (int i = 0; i < 8; ++i) acc += ks[i * 128 + dk0 + e] * tl[i];
        so[(size_t)e * 128] = acc; }
    __syncthreads();
}
DI void gdn_gate(const P& p, const Frame& F, int li) {
    const float* OG = (const float*)(p.ws + WS_OG); const bf16* H = (const bf16*)(p.ws + WS_H); bf16* AO = (bf16*)(p.ws + WS_AO);
    const f32x4 nw = *(const f32x4*)((const float*)p.in[14] + li * 128 + ((4 * F.lane) & 127));
    for (int row = F.gw; row < M; row += F.ngw) {
        f32x4 v[4]; u32x2 z[4];
#pragma unroll
        for (int k = 0; k < 4; ++k) { const int c = (k * 64 + F.lane) * 4; v[k] = *(const f32x4*)(OG + (size_t)row * DM + c); z[k] = *(const u32x2*)(H + (size_t)row * GINP + 3072 + c); }
#pragma unroll
        for (int k = 0; k < 4; ++k) { const int c = (k * 64 + F.lane) * 4;
            float s2 = (v[k][0] * v[k][0] + v[k][1] * v[k][1]) + (v[k][2] * v[k][2] + v[k][3] * v[k][3]);
            s2 = sum32(s2);
            const float rs = __builtin_amdgcn_rsqf(s2 * (1.f / 128.f) + 1e-6f);
            *(u32x2*)(AO + (size_t)row * DM + c) = (u32x2){pk2(v[k][0] * rs * nw[0] * siluf_(bflo(z[k].x)), v[k][1] * rs * nw[1] * siluf_(bfhi(z[k].x))), pk2(v[k][2] * rs * nw[2] * siluf_(bflo(z[k].y)), v[k][3] * rs * nw[3] * siluf_(bfhi(z[k].y)))}; }
    }
}

DI void nsa_transpose(const P& p, const Frame& F, int li) {
    const bf16* H = (const bf16*)(p.ws + WS_H);
    bf16* kslc = (bf16*)(p.ws + WS_KSLC_S + li * SZ_SLC_S); bf16* vslc = (bf16*)(p.ws + WS_VSLCT_S + li * SZ_SLC_S);
    bf16* kwin = (bf16*)(p.ws + WS_KWIN_S + li * SZ_WIN_S); bf16* vwin = (bf16*)(p.ws + WS_VWINT_S + li * SZ_WIN_S);
    for (int idx = F.gw * 64 + F.lane; idx < DB * DS * 512; idx += F.ngw * 64) {
        const int c = idx & 511, rs = idx >> 9, b = rs >> 3, t = rs & 7, kind = c >> 7, g = (c >> 6) & 1, d = c & 63;
        const bf16 v = H[(size_t)(MP + rs) * NINP + 1280 + c];
        if (kind == 0) kslc[((size_t)(b * 2 + g) * SLC_S_ROWS + PAST + t) * 64 + d] = v;
        else if (kind == 1) vslc[((size_t)(b * 2 + g) * SLC_S_ROWS + PAST + t) * 64 + d] = v;
        else if (kind == 2) kwin[((size_t)(b * 2 + g) * WIN_S_ROWS + 512 + t) * 64 + d] = v;
        else vwin[((size_t)(b * 2 + g) * WIN_S_ROWS + 512 + t) * 64 + d] = v;
    }
}
struct CmpOrder {
    int G, c, li; unsigned char* ws; int base, count;
    DI bool next(int i, pg8::Unit& u) const {
        const int L = base + i * G + c; if (i * G + c >= count) return false;
        if (L < 32) { u.z = L >> 3; u.pm = (L >> 1) & 3; u.pn = L & 1;
            u.A = (const char*)(ws + WS_CMPP) + ((size_t)u.pm * 256 * 4096 + (u.z >> 1) * 128 + (u.z & 1) * 64) * 2; u.C = (char*)(ws + WS_PC_P) + (size_t)u.z * 1024 * 512 * 2; }
        else { const int L2 = L - 32; u.z = L2 >> 7; u.pm = (L2 >> 1) & 63; u.pn = L2 & 1;
            u.A = (const char*)(ws + WS_CMPS + li * SZ_CMPS) + ((size_t)u.pm * 256 * 4096 + (u.z >> 1) * 128 + (u.z & 1) * 64) * 2; u.C = (char*)(ws + WS_PC_S) + (size_t)u.z * 16384 * 512 * 2; }
        u.B = (const char*)(ws + WS_WC1 + (li * 2 + (u.z >> 1)) * SZ_WC1) + (size_t)u.pn * 256 * 1024 * 2;
        return true;
    }
};
DI void nsa_cmp2(const P& p, const Frame& F, int li) {
    constexpr int WP = 264;
    LAS bf16* w2t = (LAS bf16*)F.lds;
    LAS bf16* hid = (LAS bf16*)(F.lds + 36864 + F.wave * 8704);
    const float* cb = (const float*)(p.ws + WS_CBIAS);
    constexpr int NH_P = NB * 2 * 16, NH_S = DB * 2 * 8, NH = NH_P + NH_S;
    const int a16 = F.lane & 15, kg = F.lane >> 4;
#pragma unroll 1
    for (int kv = 0; kv < 2; ++kv) {
        __syncthreads();
        { const float* w2g = (const float*)(kv ? p.in[22] : p.in[20]) + (size_t)li * 256 * 64;
          for (int i = F.tid; i < 256 * 64; i += 512) w2t[(i & 63) * WP + (i >> 6)] = (bf16)f2bf(w2g[i]); }
        __syncthreads();
        const f32x4 bv = *(const f32x4*)(cb + (li * 2 + kv) * 256 + 4 * F.lane);
        for (int id = F.gw; id < NH; id += F.ngw) {
            int b, n0, g, segs, npad, ncmp; const bf16* PC; bf16* DST;
            if (id < NH_P) { n0 = (id & 15) * 16; g = (id >> 4) & 1; b = id >> 5; segs = 256; npad = 256; ncmp = NCMP_P; PC = (const bf16*)(p.ws + WS_PC_P) + (size_t)(kv * 2 + g) * 1024 * 512; DST = (bf16*)(p.ws + (kv ? WS_VCT_P : WS_KC_P)); }
            else { const int i2 = id - NH_P; n0 = (i2 & 7) * 16; g = (i2 >> 3) & 1; b = i2 >> 4; segs = 128; npad = 128; ncmp = NCMP_S; PC = (const bf16*)(p.ws + WS_PC_S) + (size_t)(kv * 2 + g) * 16384 * 512; DST = (bf16*)(p.ws + (kv ? WS_VCT_S : WS_KC_S)); }
            const size_t ri = (size_t)b * segs + n0;
#pragma unroll
            for (int hb = 0; hb < 2; ++hb) { u32x2 a0[8], a1[8];
#pragma unroll
                for (int e = 0; e < 8; ++e) { const int n = 8 * hb + e; const bool ok = n0 + n < ncmp; a0[e] = ok ? *(const u32x2*)(PC + (ri + n) * 512 + 4 * F.lane) : (u32x2){0u, 0u}; a1[e] = ok ? *(const u32x2*)(PC + (ri + n + 1) * 512 + 256 + 4 * F.lane) : (u32x2){0u, 0u}; }
#pragma unroll
                for (int e = 0; e < 8; ++e) { const float h0 = siluf_(bflo(a0[e].x) + bflo(a1[e].x) + bv[0]), h1 = siluf_(bfhi(a0[e].x) + bfhi(a1[e].x) + bv[1]), h2 = siluf_(bflo(a0[e].y) + bflo(a1[e].y) + bv[2]), h3 = siluf_(bfhi(a0[e].y) + bfhi(a1[e].y) + bv[3]);
                    *(LAS u32x2*)(hid + (8 * hb + e) * WP + 4 * F.lane) = (u32x2){pk2(h0, h1), pk2(h2, h3)}; } }
            LDS_WAIT();
            f32x4 acc[4];
#pragma unroll
            for (int dt = 0; dt < 4; ++dt) acc[dt] = (f32x4){0.f, 0.f, 0.f, 0.f};
#pragma unroll
            for (int ks = 0; ks < 8; ++ks) { const bf16x8 af = *(const LAS bf16x8*)(hid + a16 * WP + 32 * ks + 8 * kg);
#pragma unroll
                for (int dt = 0; dt < 4; ++dt) acc[dt] = MFMA16(af, *(const LAS bf16x8*)(w2t + (16 * dt + a16) * WP + 32 * ks + 8 * kg), acc[dt]); }
#pragma unroll
            for (int dt = 0; dt < 4; ++dt)
#pragma unroll
                for (int e = 0; e < 4; ++e) { const int n = n0 + 4 * kg + e; if (n < ncmp) DST[((size_t)(b * 2 + g) * npad + n) * 64 + 16 * dt + a16] = (bf16)f2bf(acc[dt][e]); }
            LDS_WAIT();
        }
    }
}

struct AttnAcc { f32x16 o0, o1; float m, l; };
DI void attn_reset(AttnAcc& a) { for (int e = 0; e < 16; ++e) { a.o0[e] = 0.f; a.o1[e] = 0.f; } a.m = -__builtin_inff(); a.l = 0.f; }
constexpr float ATT_C = 1.0f;
constexpr float ATT_QS = 0.18033688011112042f;
DI f32x16 attn_scores(const LAS unsigned char* kt, int sb, const bf16x8 (&qf)[4], int r, int h) {
    f32x16 s; for (int e = 0; e < 16; ++e) s[e] = 0.f;
    const int row = 32 * sb + r, swz = (row >> 1) & 7; const LAS unsigned char* base = kt + row * 128;
#pragma unroll
    for (int st = 0; st < 4; ++st) s = MFMA32(*(const LAS bf16x8*)(base + (((2 * st + h) ^ swz) << 4)), qf[st], s);
    return s;
}
template <bool WIN> DI void attn_mask(f32x16& s, int hi) {
#pragma unroll
    for (int e = 0; e < 16; ++e) { const int ce = (e & 3) + 8 * (e >> 2); const bool v = WIN ? ((unsigned)(hi - ce) <= 512u) : (ce <= hi); s[e] = v ? s[e] : -__builtin_inff(); }
}
typedef short v4i16_t __attribute__((ext_vector_type(4)));
DI s16x4 vtr(const LAS unsigned char* p) { return __builtin_bit_cast(s16x4, __builtin_amdgcn_ds_read_tr16_b64_v4i16((LAS v4i16_t*)p)); }
DI void attn_pv(AttnAcc& a, const f32x16& p0, const f32x16& p1, const LAS unsigned char* vt, int r, int h) {
    const int q = (r >> 2) & 3, pp4 = r & 3, dg = r >> 4;
#pragma unroll
    for (int s4 = 0; s4 < 4; ++s4) {
        const f32x16& pp = s4 < 2 ? p0 : p1; const int o = 8 * (s4 & 1);
        u32x4 pw; pw.x = pg8::cvt_pk_bf16(pp[o], pp[o + 1]); pw.y = pg8::cvt_pk_bf16(pp[o + 2], pp[o + 3]); pw.z = pg8::cvt_pk_bf16(pp[o + 4], pp[o + 5]); pw.w = pg8::cvt_pk_bf16(pp[o + 6], pp[o + 7]);
        const bf16x8 pf = __builtin_bit_cast(bf16x8, pw);
        const int k1 = 16 * s4 + 4 * h + q, k2 = k1 + 8;
        const LAS unsigned char* r1 = vt + k1 * 128 + 8 * (pp4 & 1); const LAS unsigned char* r2 = vt + k2 * 128 + 8 * (pp4 & 1);
        const int z1 = (k1 >> 1) & 7, z2 = (k2 >> 1) & 7;
        { const int ch = 2 * dg + (pp4 >> 1);
          const s16x4 lo = vtr(r1 + ((ch ^ z1) << 4)), hi = vtr(r2 + ((ch ^ z2) << 4));
          a.o0 = MFMA32(__builtin_shufflevector(lo, hi, 0, 1, 2, 3, 4, 5, 6, 7), pf, a.o0); }
        { const int ch = 4 + 2 * dg + (pp4 >> 1);
          const s16x4 lo = vtr(r1 + ((ch ^ z1) << 4)), hi = vtr(r2 + ((ch ^ z2) << 4));
          a.o1 = MFMA32(__builtin_shufflevector(lo, hi, 0, 1, 2, 3, 4, 5, 6, 7), pf, a.o1); }
    }
}
template <bool WIN> DI void attn_chunk(AttnAcc& a, const LAS unsigned char* kt, const bf16x8 (&qf)[4], int hi0, int hi1, bool allv, bool lv, int r, int h) {
    f32x16 s0 = attn_scores(kt, 0, qf, r, h), s1 = attn_scores(kt, 1, qf, r, h);
    if (!allv) { attn_mask<WIN>(s0, hi0); attn_mask<WIN>(s1, hi1); }
    float mx = fmaxf(s0[0], s1[0]);
#pragma unroll
    for (int e = 1; e < 16; ++e) mx = fmaxf(mx, fmaxf(s0[e], s1[e]));
    mx = xor32_max(mx) * ATT_C; mx = lv ? mx : -__builtin_inff();
    const float mn = fmaxf(a.m, mx), mu = lv ? ((mn == -__builtin_inff()) ? 0.f : mn) : __builtin_inff();
    float ps = 0.f;
#pragma unroll
    for (int e = 0; e < 16; ++e) { s0[e] = __builtin_amdgcn_exp2f(__builtin_fmaf(s0[e], ATT_C, -mu)); s1[e] = __builtin_amdgcn_exp2f(__builtin_fmaf(s1[e], ATT_C, -mu)); ps += s0[e] + s1[e]; }
    ps = xor32_sum(ps);
    if (__ballot(mn != a.m) != 0ull) {
        const float sc = (a.m == -__builtin_inff()) ? 0.f : __builtin_amdgcn_exp2f(a.m - mn);
        a.l = a.l * sc + ps; a.o0 = a.o0 * sc; a.o1 = a.o1 * sc;
    } else a.l += ps;
    a.m = mn;
    attn_pv(a, s0, s1, kt + 8192, r, h);
}

namespace nb {
typedef __attribute__((address_space(3))) const char* lds_cptr;
constexpr int NSLOT = 3, SLOTB = 8192;
constexpr int LDS_K = 0, LDS_V = NSLOT * SLOTB, LDS_WS = 2 * NSLOT * SLOTB, LDS_OST = 65536, LDS_END = LDS_OST + 8 * 4096;
constexpr int LDS_TL = 98304 + 256;
#define NB_SBAR() __builtin_amdgcn_sched_barrier(0)
#define NB_WAIT_BAR(N) asm volatile("s_waitcnt vmcnt(" #N ") lgkmcnt(0)\n\ts_barrier" ::: "memory")
DI void glds16(const void* gsrc, unsigned lds_dst) { unsigned keep;
    asm volatile("s_mov_b32 %0, m0\n\ts_mov_b32 m0, %2\n\ts_nop 0\n\tglobal_load_lds_dwordx4 %1, off\n\ts_mov_b32 m0, %0" : "=&s"(keep) : "v"(gsrc), "s"(lds_dst) : "memory"); }
DI float max3f(float a, float b, float c) { float r; asm("v_max3_f32 %0, %1, %2, %3" : "=v"(r) : "v"(a), "v"(b), "v"(c)); return r; }
DI float max2f(float a, float b) { float r; asm("v_max_f32_e32 %0, %1, %2" : "=v"(r) : "v"(a), "v"(b)); return r; }
DI float fadd_s(float a, float b) { float r; asm("v_add_f32_e32 %0, %1, %2" : "=v"(r) : "v"(a), "v"(b)); return r; }
DI float fsub_s(float a, float b) { float r; asm("v_sub_f32_e32 %0, %1, %2" : "=v"(r) : "v"(a), "v"(b)); return r; }
typedef float f32x2_t __attribute__((ext_vector_type(2))); typedef __bf16 bf16x2_t __attribute__((ext_vector_type(2)));
DI unsigned cvtpk_s(float lo, float hi) { f32x2_t v = {lo, hi}; bf16x2_t b = __builtin_convertvector(v, bf16x2_t); return __builtin_bit_cast(unsigned, b); }
DI void qkt(f32x16& p0, f32x16& p1, lds_cptr Kslot, const bf16x8* qr, const f32x16& negm, int r32, int hi) {
    const lds_cptr kb = Kslot + hi * 1024 + r32 * 16;
#pragma unroll
    for (int d0 = 0; d0 < 4; ++d0) {
        const bf16x8 b0 = *(const LAS bf16x8*)(kb + d0 * 2048);
        const bf16x8 b1 = *(const LAS bf16x8*)(kb + d0 * 2048 + 512);
        if (d0 == 0) { p0 = __builtin_amdgcn_mfma_f32_32x32x16_bf16(b0, qr[0], negm, 0, 0, 0); p1 = __builtin_amdgcn_mfma_f32_32x32x16_bf16(b1, qr[0], negm, 0, 0, 0); }
        else { p0 = __builtin_amdgcn_mfma_f32_32x32x16_bf16(b0, qr[d0], p0, 0, 0, 0); p1 = __builtin_amdgcn_mfma_f32_32x32x16_bf16(b1, qr[d0], p1, 0, 0, 0); } }
}
DI void kload8(bf16x8* kf, lds_cptr kp) {
    kf[0] = *(const LAS bf16x8*)(kp);        kf[1] = *(const LAS bf16x8*)(kp + 512);
    kf[2] = *(const LAS bf16x8*)(kp + 2048); kf[3] = *(const LAS bf16x8*)(kp + 2560);
    kf[4] = *(const LAS bf16x8*)(kp + 4096); kf[5] = *(const LAS bf16x8*)(kp + 4608);
    kf[6] = *(const LAS bf16x8*)(kp + 6144); kf[7] = *(const LAS bf16x8*)(kp + 6656);
}
DI void kload2(bf16x8* kf, lds_cptr kp, int j) { kf[2 * j] = *(const LAS bf16x8*)(kp + j * 2048); kf[2 * j + 1] = *(const LAS bf16x8*)(kp + j * 2048 + 512); }
typedef short v4i16_t __attribute__((ext_vector_type(4)));
DI s16x4 vtr(lds_cptr p) { return __builtin_bit_cast(s16x4, __builtin_amdgcn_ds_read_tr16_b64_v4i16((LAS v4i16_t*)p)); }
DI float rowmax(const f32x16& p0, const f32x16& p1) {
    float a = max3f(p0[0], p0[1], p1[0]), b = max3f(p0[2], p0[3], p1[1]); a = max3f(a, p1[2], p1[3]);
#pragma unroll
    for (int r = 4; r < 16; r += 4) { a = max3f(a, p0[r], p0[r + 1]); b = max3f(b, p0[r + 2], p0[r + 3]); a = max3f(a, p1[r], p1[r + 1]); b = max3f(b, p1[r + 2], p1[r + 3]); }
    const float m = max2f(a, b);
    auto rr = __builtin_amdgcn_permlane32_swap(__float_as_uint(m), __float_as_uint(m), false, false);
    return max2f(__uint_as_float(rr[0]), __uint_as_float(rr[1]));
}
DI void pv(f32x16* o, int vb, bf16x8 pa0, bf16x8 pa1, bf16x8 pa2, bf16x8 pa3) {
#pragma unroll
    for (int d0 = 0; d0 < 2; ++d0) { s16x4 lo[4], hi[4];
#pragma unroll
        for (int ks = 0; ks < 4; ++ks) {
            asm volatile("ds_read_b64_tr_b16 %0,%1 offset:%c2" : "=&v"(lo[ks]) : "v"(vb), "i"(d0 * 4096 + ks * 1024) : "memory");
            asm volatile("ds_read_b64_tr_b16 %0,%1 offset:%c2" : "=&v"(hi[ks]) : "v"(vb), "i"(d0 * 4096 + ks * 1024 + 512) : "memory"); }
        asm volatile("s_waitcnt lgkmcnt(0)" ::: "memory"); NB_SBAR();
#define NB_PK(k) (bf16x8){lo[k][0], lo[k][1], lo[k][2], lo[k][3], hi[k][0], hi[k][1], hi[k][2], hi[k][3]}
        o[d0] = __builtin_amdgcn_mfma_f32_32x32x16_bf16(pa0, NB_PK(0), o[d0], 0, 0, 0);
        o[d0] = __builtin_amdgcn_mfma_f32_32x32x16_bf16(pa1, NB_PK(1), o[d0], 0, 0, 0);
        o[d0] = __builtin_amdgcn_mfma_f32_32x32x16_bf16(pa2, NB_PK(2), o[d0], 0, 0, 0);
        o[d0] = __builtin_amdgcn_mfma_f32_32x32x16_bf16(pa3, NB_PK(3), o[d0], 0, 0, 0);
#undef NB_PK
    }
}
DI void gmask(f32x16& p0, f32x16& p1, int hl, unsigned wd) {
    const float NEG = -__builtin_inff();
#pragma unroll
    for (int r = 0; r < 16; ++r) { const int ce = (r & 3) + 8 * (r >> 2); if ((unsigned)(hl - ce) > wd) p0[r] = NEG; if ((unsigned)(hl - 32 - ce) > wd) p1[r] = NEG; }
}
template <int THRL> DI void ring_unit(const int MODE, const bool LAST, const bf16* Qw, int ldq, const bf16* Kt, const bf16* Vt, int ld, const LAS int* tl, int NT, int posbase,
                                                          int pos0w  , unsigned long long m0, unsigned long long m1, unsigned long long m2, unsigned long long m3  ,
                                                          const bf16* gatep  , int br, bool store_ok, bf16* Ow, char* shm) {
    int tid_ = threadIdx.x; asm volatile("" : "+v"(tid_));
    const int tid = tid_, lane = tid & 63, r32 = lane & 31, hi = lane >> 5; const int wid = __builtin_amdgcn_readfirstlane(tid >> 6);
    const unsigned lds0 = (unsigned)(uintptr_t)shm;
    const bf16* ksrc = Kt + (long)lane * ld + wid * 8;
    const bf16* vsrc = Vt + (long)(16 * (wid & 3) + (lane >> 2)) * ld + (wid >> 2) * 32 + (lane & 3) * 8;
    const unsigned kdst = lds0 + LDS_K + wid * 1024, vdst = lds0 + LDS_V + wid * 1024;
#define NB_TL(t) __builtin_amdgcn_readfirstlane(tl[(t)])
    int dq0, dq1, dq2, dq3;
#define NB_DMA_KD(dd, slot) do { int d_ = (dd); d_ = d_ < 0 ? 0 : d_; nb::glds16(ksrc + (long)d_ * 64 * ld, (unsigned)__builtin_amdgcn_readfirstlane(kdst + (slot))); } while (0)
#define NB_DMA_VD(dd, slot) do { int d_ = (dd); d_ = d_ < 0 ? 0 : d_; nb::glds16(vsrc + (long)d_ * 64 * ld, (unsigned)__builtin_amdgcn_readfirstlane(vdst + (slot))); } while (0)
#define NB_DMA_K(t, slot) do { int d_ = NB_TL(t); d_ = d_ < 0 ? 0 : d_; nb::glds16(ksrc + (long)d_ * 64 * ld, (unsigned)__builtin_amdgcn_readfirstlane(kdst + (slot))); } while (0)
#define NB_DMA_V(t, slot) do { int d_ = NB_TL(t); d_ = d_ < 0 ? 0 : d_; nb::glds16(vsrc + (long)d_ * 64 * ld, (unsigned)__builtin_amdgcn_readfirstlane(vdst + (slot))); } while (0)
    const int vb0 = (int)(lds0 + LDS_V) + ((lane >> 4) & 1) * 32 + (lane & 3) * 8 + (4 * hi + ((lane & 15) >> 2)) * 64;
    bf16x8 kf[8];
    const lds_cptr shm3 = (lds_cptr)shm; const lds_cptr Kbase = shm3 + LDS_K;
    LAS float* wsf = (LAS float*)((LAS char*)shm3 + LDS_WS) + wid * 64; const lds_cptr kp0 = shm3 + LDS_K + hi * 1024 + r32 * 16; const lds_cptr vp0 = shm3 + LDS_V + ((lane >> 4) & 1) * 32 + (lane & 3) * 8 + (4 * hi + ((lane & 15) >> 2)) * 64;
    NB_DMA_K(0, 0); NB_DMA_V(0, 0); NB_DMA_K(1, SLOTB);
    bf16x8 qr[4];
    { const bf16* qp = Qw + (long)(r32 >> 3) * ldq + (r32 & 7) * 64 + hi * 8;
#pragma unroll
      for (int d0 = 0; d0 < 4; ++d0) qr[d0] = *reinterpret_cast<const bf16x8*>(qp + d0 * 16); }
    float mhat = 0.f, l_reg = 0.f; f32x16 o[2]; o[0] = f32x16{}; o[1] = f32x16{}; f32x16 negm = f32x16{}; asm volatile("" : "+v"(negm));
#define NB_CMASK(P0, P1, t) NB_CMASKD(P0, P1, NB_TL(t))
#define NB_CMASKD(P0, P1, dd) do { const int d_ = (dd); int hl_; unsigned wd_; bool full_; \
        const int trow_ = pos0w + (r32 >> 3); \
        if (MODE == 0) { const int pb_ = 64 * d_ + posbase; full_ = d_ >= 0 && pb_ + 63 <= pos0w && pb_ >= pos0w + 3 - 512; } \
        else { const int ds_ = d_ & 63; full_ = d_ >= 0 && ((m0 & m1 & m2 & m3) >> ds_ & 1ull) && 64 * d_ + 63 <= pos0w; } \
        if (full_) break; \
        if (MODE == 0) { hl_ = d_ < 0 ? -1 : trow_ - (64 * d_ + posbase) - 4 * hi; wd_ = 512u; } \
        else { const int ds_ = d_ & 63; const unsigned b4_ = (unsigned)((m0 >> ds_) & 1ull) | ((unsigned)((m1 >> ds_) & 1ull) << 1) | ((unsigned)((m2 >> ds_) & 1ull) << 2) | ((unsigned)((m3 >> ds_) & 1ull) << 3); \
               const bool mine_ = d_ >= 0 && ((b4_ >> (r32 >> 3)) & 1u); hl_ = mine_ ? trow_ - 64 * d_ - 4 * hi : -1; wd_ = 0x7fffffffu; } \
        nb::gmask(P0, P1, hl_, wd_); } while (0)
    bool resc = false;
#define NB_START(P0, P1) do { const float rm = nb::rowmax(P0, P1); resc = false; \
    { const float dl = (rm == -__builtin_inff()) ? 0.f : rm; mhat = nb::fadd_s(mhat, dl); \
      _Pragma("unroll") for (int r = 0; r < 16; ++r) { P0[r] = nb::fsub_s(P0[r], dl); P1[r] = nb::fsub_s(P1[r], dl); } \
      _Pragma("unroll") for (int r = 0; r < 16; ++r) negm[r] = -mhat; asm volatile("" : "+v"(negm)); } \
    _Pragma("unroll") for (int r = 0; r < 16; ++r) P0[r] = __builtin_amdgcn_exp2f(P0[r]); } while (0)
#define NB_RESC() do { if (resc) { asm volatile("s_waitcnt lgkmcnt(0)" ::: "memory"); \
      _Pragma("unroll") for (int d_ = 0; d_ < 2; ++d_) _Pragma("unroll") for (int r = 0; r < 16; ++r) o[d_][r] *= wsf[crow(r, hi)]; } } while (0)
    f32x16 pA0, pA1, pB0, pB1;
    int sl_prev = 0, sl_cur = 0, sl_next = SLOTB;
#define NB_ROT() do { sl_prev = sl_cur; sl_cur = sl_next; sl_next = (sl_next == (NSLOT - 1) * SLOTB) ? 0 : sl_next + SLOTB; } while (0)
#define NB_SHIFT(tn) do { dq0 = dq1; dq1 = dq2; dq2 = dq3; dq3 = NB_TL((tn) + 3 < 95 ? (tn) + 3 : 95); } while (0)
    NB_DMA_K(2, 2 * SLOTB);
    NB_WAIT_BAR(3);
    nb::qkt(pA0, pA1, Kbase, qr, negm, r32, hi); asm volatile("s_nop 15\n\ts_nop 7" : "+v"(pA0), "+v"(pA1)); NB_CMASK(pA0, pA1, 0);
    NB_START(pA0, pA1);
    _Pragma("unroll") for (int r = 0; r < 16; ++r) pA1[r] = __builtin_amdgcn_exp2f(pA1[r]);
    NB_WAIT_BAR(0);
    NB_DMA_K(3, 0); NB_DMA_V(1, SLOTB);
    NB_ROT();
    nb::kload8(kf, kp0 + sl_cur);
    NB_WAIT_BAR(2);
    dq0 = NB_TL(1); dq1 = NB_TL(2); dq2 = NB_TL(3); dq3 = NB_TL(4);
    s16x4 vlo[8], vhi[8]; u32x4 pw0, pw1, pw2, pw3;
#define NB_PKW(P, B) nb::cvtpk_s(P[B], P[B + 1])
#define NB_PAF(k) __builtin_bit_cast(bf16x8, pw##k)
#define NB_VFR(i) (bf16x8){vlo[i][0], vlo[i][1], vlo[i][2], vlo[i][3], vhi[i][0], vhi[i][1], vhi[i][2], vhi[i][3]}
#define NB_PIN(x) asm volatile("" : "+v"(x))
#define NB_MX3(a, b, c) __builtin_fmaxf(__builtin_fmaxf((a), (b)), (c))
#define NB_GAPA(MF, A0, A1, A2, A3, W0, W1, PW) do { MF; sacc += A0; sacc += A1; sacc += A2; sacc += A3; NB_PIN(sacc); W0; W1; NB_PIN(PW); NB_SBAR(); } while (0)
#define NB_EX(v) __builtin_amdgcn_exp2f(v)
#define NB_GAPB(MF, X, B) do { MF; X[B] = NB_EX(X[B]); X[B + 1] = NB_EX(X[B + 1]); X[B + 2] = NB_EX(X[B + 2]); X[B + 3] = NB_EX(X[B + 3]); NB_PIN(X); NB_SBAR(); } while (0)
#define NB_VRD(i) do { vlo[i] = nb::vtr(vp_ + (((i) >> 2) * 4096 + ((i) & 3) * 1024)); vhi[i] = nb::vtr(vp_ + (((i) >> 2) * 4096 + ((i) & 3) * 1024 + 512)); } while (0)
#define NB_KRD(G, j) do { if (G) { nb::kload2(kf, kp0 + sl_next, j); NB_SBAR(); } } while (0)
#define NB_MF(...) __builtin_amdgcn_mfma_f32_32x32x16_bf16(__VA_ARGS__, 0, 0, 0)
#define NB_STEP(C0, C1, P0, P1, t, GK, GV, GL) do { NB_SBAR(); \
    const lds_cptr vp_ = vp0 + sl_prev; \
    NB_VRD(0); NB_SBAR(); float sacc = (P0[0] + P0[1]); \
    NB_GAPA(C0 = NB_MF(kf[0], qr[0], negm), P0[2], P0[3], P0[4], P0[5],     pw0[0] = NB_PKW(P0, 0), pw0[1] = NB_PKW(P0, 2), pw0); \
    NB_VRD(4); NB_SBAR(); NB_GAPA(C1 = NB_MF(kf[1], qr[0], negm), P0[6], P0[7], P0[8], P0[9],     pw0[2] = NB_PKW(P0, 4), pw0[3] = NB_PKW(P0, 6), pw0); \
    NB_VRD(1); NB_SBAR(); NB_GAPA(C0 = NB_MF(kf[2], qr[1], C0),   P0[10], P0[11], P0[12], P0[13], pw1[0] = NB_PKW(P0, 8), pw1[1] = NB_PKW(P0, 10), pw1); \
    NB_VRD(5); NB_SBAR(); NB_GAPA(C1 = NB_MF(kf[3], qr[1], C1),   P0[14], P0[15], P1[0], P1[1],   pw1[2] = NB_PKW(P0, 12), pw1[3] = NB_PKW(P0, 14), pw1); \
    NB_VRD(2); NB_SBAR(); NB_GAPA(C0 = NB_MF(kf[4], qr[2], C0),   P1[2], P1[3], P1[4], P1[5],     pw2[0] = NB_PKW(P1, 0), pw2[1] = NB_PKW(P1, 2), pw2); \
    NB_VRD(6); NB_SBAR(); NB_GAPA(C1 = NB_MF(kf[5], qr[2], C1),   P1[6], P1[7], P1[8], P1[9],     pw2[2] = NB_PKW(P1, 4), pw2[3] = NB_PKW(P1, 6), pw2); \
    NB_VRD(3); NB_SBAR(); NB_GAPA(C0 = NB_MF(kf[6], qr[3], C0),   P1[10], P1[11], P1[12], P1[13], pw3[0] = NB_PKW(P1, 8), pw3[1] = NB_PKW(P1, 10), pw3); \
    NB_VRD(7); NB_SBAR(); NB_GAPA(C1 = NB_MF(kf[7], qr[3], C1),   P1[14], P1[15], 0.f, 0.f,       pw3[2] = NB_PKW(P1, 12), pw3[3] = NB_PKW(P1, 14), pw3); \
    l_reg += sacc; \
    if (GK) { NB_DMA_KD(dq3, sl_cur); } if (GV) { NB_DMA_VD(dq1, sl_next); } \
    NB_CMASKD(C0, C1, dq0); \
    { float a = NB_MX3(C0[0], C0[1], C1[0]), b = NB_MX3(C0[2], C0[3], C1[1]); a = NB_MX3(a, C1[2], C1[3]); \
      _Pragma("unroll") for (int r = 4; r < 16; r += 4) { a = NB_MX3(a, C0[r], C0[r + 1]); b = NB_MX3(b, C0[r + 2], C0[r + 3]); a = NB_MX3(a, C1[r], C1[r + 1]); b = NB_MX3(b, C1[r + 2], C1[r + 3]); } \
      float rm = __builtin_fmaxf(a, b); { auto rr = __builtin_amdgcn_permlane32_swap(__float_as_uint(rm), __float_as_uint(rm), false, false); rm = __builtin_fmaxf(__uint_as_float(rr[0]), __uint_as_float(rr[1])); } \
      resc = false; \
      if (__builtin_expect(__any(rm > (float)THRL), 0)) { const float dl = __builtin_fmaxf(rm, 0.f); mhat += dl; \
        _Pragma("unroll") for (int r = 0; r < 16; ++r) { C0[r] -= dl; C1[r] -= dl; } \
        _Pragma("unroll") for (int r = 0; r < 16; ++r) negm[r] = -mhat; asm volatile("" : "+v"(negm)); \
        const float f = __builtin_amdgcn_exp2f(-dl); l_reg *= f; if (hi == 0) wsf[r32] = f; resc = true; } } \
    NB_SBAR(); \
    NB_GAPB(o[0] = NB_MF(NB_PAF(0), NB_VFR(0), o[0]), C0, 0); \
    NB_GAPB(o[1] = NB_MF(NB_PAF(0), NB_VFR(4), o[1]), C0, 4); \
    NB_KRD(GL, 0); NB_GAPB(o[0] = NB_MF(NB_PAF(1), NB_VFR(1), o[0]), C0, 8); \
    NB_KRD(GL, 1); NB_GAPB(o[1] = NB_MF(NB_PAF(1), NB_VFR(5), o[1]), C0, 12); \
    NB_KRD(GL, 2); NB_GAPB(o[0] = NB_MF(NB_PAF(2), NB_VFR(2), o[0]), C1, 0); \
    NB_KRD(GL, 3); NB_GAPB(o[1] = NB_MF(NB_PAF(2), NB_VFR(6), o[1]), C1, 4); \
    NB_GAPB(o[0] = NB_MF(NB_PAF(3), NB_VFR(3), o[0]), C1, 8); \
    NB_GAPB(o[1] = NB_MF(NB_PAF(3), NB_VFR(7), o[1]), C1, 12); \
    } while (0)
    int t = 1;
    for (; t + 5 < NT; t += 2) {
        NB_STEP(pB0, pB1, pA0, pA1, t, true, true, true);     NB_WAIT_BAR(2); NB_SHIFT(t + 1); NB_RESC(); NB_ROT();
        NB_STEP(pA0, pA1, pB0, pB1, t + 1, true, true, true); NB_WAIT_BAR(2); NB_SHIFT(t + 2); NB_RESC(); NB_ROT();
    }
#define NB_ENDW(tt) do { if ((tt) + 3 < NT) { NB_WAIT_BAR(2); } else if ((tt) + 2 < NT) { NB_WAIT_BAR(1); } else { NB_WAIT_BAR(0); } } while (0)
    for (; t + 1 < NT; t += 2) {
        NB_STEP(pB0, pB1, pA0, pA1, t, (t + 3 < NT), (t + 1 < NT), (t + 1 < NT));         NB_ENDW(t);     NB_SHIFT(t + 1); NB_RESC(); NB_ROT();
        NB_STEP(pA0, pA1, pB0, pB1, t + 1, (t + 4 < NT), (t + 2 < NT), (t + 2 < NT));     NB_ENDW(t + 1); NB_SHIFT(t + 2); NB_RESC(); NB_ROT();
    }
    NB_STEP(pB0, pB1, pA0, pA1, NT - 1, false, false, false); NB_RESC();
    { float sacc = pB0[0] + pB0[1]; _Pragma("unroll") for (int r = 2; r < 16; ++r) sacc += pB0[r]; _Pragma("unroll") for (int r = 0; r < 16; ++r) sacc += pB1[r]; l_reg += sacc;
      pw0 = (u32x4){NB_PKW(pB0, 0), NB_PKW(pB0, 2), NB_PKW(pB0, 4), NB_PKW(pB0, 6)}; pw1 = (u32x4){NB_PKW(pB0, 8), NB_PKW(pB0, 10), NB_PKW(pB0, 12), NB_PKW(pB0, 14)};
      pw2 = (u32x4){NB_PKW(pB1, 0), NB_PKW(pB1, 2), NB_PKW(pB1, 4), NB_PKW(pB1, 6)}; pw3 = (u32x4){NB_PKW(pB1, 8), NB_PKW(pB1, 10), NB_PKW(pB1, 12), NB_PKW(pB1, 14)};
      NB_SBAR(); nb::pv(o, vb0 + sl_cur, NB_PAF(0), NB_PAF(1), NB_PAF(2), NB_PAF(3)); }
    { auto rr = __builtin_amdgcn_permlane32_swap(__float_as_uint(l_reg), __float_as_uint(l_reg), false, false); l_reg = __uint_as_float(rr[0]) + __uint_as_float(rr[1]); }
    if (hi == 0) { const float gate = sigmoidf_(bf2f(gatep[(long)(r32 >> 3) * ldq + (r32 & 7) * 3 + br])); wsf[32 + r32] = l_reg > 0.f ? gate / l_reg : 0.f; } asm volatile("s_waitcnt lgkmcnt(0)" ::: "memory");
    float rli[16];
#pragma unroll
    for (int r = 0; r < 16; ++r) rli[r] = wsf[32 + crow(r, hi)];
    { LAS bf16* stg = (LAS bf16*)((LAS char*)shm3 + LDS_OST) + wid * 2048;
#pragma unroll
      for (int r = 0; r < 16; ++r) { const int orow = crow(r, hi);
#pragma unroll
          for (int d0 = 0; d0 < 2; ++d0) { LAS bf16* sp = stg + orow * 64 + d0 * 32 + r32; *sp = (bf16)f2bf(bf2f(*sp) + o[d0][r] * rli[r]); } }
      asm volatile("s_waitcnt lgkmcnt(0)" ::: "memory");
      if (LAST && store_ok) {
#pragma unroll
          for (int i = 0; i < 4; ++i) { const int row = i * 8 + (lane >> 3), ch = lane & 7; const u32x4 v = *(const LAS u32x4*)(stg + row * 64 + ch * 8); *(u32x4*)(Ow + (long)(row >> 3) * DM + (row & 7) * 64 + ch * 8) = v; } } }
    asm volatile("s_waitcnt lgkmcnt(0)\n\ts_barrier" ::: "memory");
#undef NB_TL
#undef NB_DMA_K
#undef NB_DMA_KD
#undef NB_DMA_VD
#undef NB_CMASKD
#undef NB_SHIFT
#undef NB_DMA_V
#undef NB_CMASK
#undef NB_START
#undef NB_RESC
#undef NB_ROT
#undef NB_PKW
#undef NB_PAF
#undef NB_VFR
#undef NB_PIN
#undef NB_MX3
#undef NB_GAPA
#undef NB_EX
#undef NB_GAPB
#undef NB_VRD
#undef NB_KRD
#undef NB_MF
#undef NB_STEP
#undef NB_ENDW
}
}
struct WTask {
    const bf16* Q; int ldq;
    const bf16* gate;
    int pos0, ncw;
    const bf16 *Kc, *Vc; int ncmp;
    const bf16 *Ks, *Vs; int ldks, nsel;
    const bf16 *Kw, *Vw; int ldkw, winbase;
    bf16* O;
};
DI float head_sum8(float x) {
    x += __builtin_bit_cast(float, __builtin_amdgcn_update_dpp(0, __builtin_bit_cast(int, x), 0xB1, 0xF, 0xF, true));
    x += __builtin_bit_cast(float, __builtin_amdgcn_update_dpp(0, __builtin_bit_cast(int, x), 0x4E, 0xF, 0xF, true));
    x += __builtin_bit_cast(float, __builtin_amdgcn_update_dpp(0, __builtin_bit_cast(int, x), 0x141, 0xF, 0xF, true));
    return x;
}
DI void nsa_attend_wg(const WTask& T, const Frame& F) {
    LAS unsigned char* lds = F.lds;
    LAS float* PS = (LAS float*)(lds + 65536 + F.wave * 4096);
    volatile LAS unsigned* UM = (volatile LAS unsigned*)(lds + 98304);
    int lane_ = F.lane; asm volatile("" : "+v"(lane_));
    const int lane = lane_, r = lane & 31, h = lane >> 5, tok = r >> 3, head = r & 7;
    const bool cw = F.wave < T.ncw;
    const int wtok = cw ? 4 * F.wave : 0;
    const int pos0w = T.pos0 + wtok, t = pos0w + tok, tlast = T.pos0 + 4 * T.ncw - 1;
    const int tidl = F.wave * 64 + lane, srow = tidl >> 3, sch = (tidl & 7) ^ ((srow >> 1) & 7);
    const unsigned wbase = (unsigned)F.wave * 1024u;
#define AT_DMA(kp, ldk, vp, ldv, buf) do { \
        __builtin_amdgcn_global_load_lds((const unsigned*)((kp) + (size_t)srow * (ldk) + sch * 8), (LAS unsigned*)(lds + (buf) * 16384 + wbase), 16, 0, 0); \
        __builtin_amdgcn_global_load_lds((const unsigned*)((vp) + (size_t)srow * (ldv) + sch * 8), (LAS unsigned*)(lds + (buf) * 16384 + 8192 + wbase), 16, 0, 0); } while (0)
#define AT_WAITV(n) asm volatile("s_waitcnt vmcnt(" #n ")" ::: "memory")
#define AT_BAR() do { asm volatile("" ::: "memory"); __builtin_amdgcn_s_barrier(); asm volatile("" ::: "memory"); } while (0)
    bf16x8 qf[4];
    { const bf16* qp = T.Q + (size_t)(wtok + tok) * T.ldq + head * 64 + 8 * h;
#pragma unroll
      for (int st = 0; st < 4; ++st) qf[st] = *(const bf16x8*)(qp + 16 * st); }
    float gt[3];
#pragma unroll
    for (int br = 0; br < 3; ++br) gt[br] = sigmoidf_(bf2f(T.gate[(size_t)(wtok + tok) * T.ldq + head * 3 + br]));
    f32x16 out0, out1; for (int e = 0; e < 16; ++e) { out0[e] = 0.f; out1[e] = 0.f; }
    AttnAcc A; attn_reset(A);
    const int nc64 = tlast >= 31 ? ((((tlast - 31) >> 4) >> 6) + 1) : 0;
    for (int i = 0; i < nc64; ++i) AT_DMA(T.Kc + (size_t)i * 64 * 64, 64, T.Vc + (size_t)i * 64 * 64, 64, i);
    for (int n = lane; n < 1024; n += 64) PS[n] = 0.f;
    AT_WAITV(0); LDS_WAIT(); AT_BAR();
    if (cw) {
        float cm = -__builtin_inff(), cl = 0.f;
        const int nmaxl = t >= 31 ? (((t - 31) >> 4) < T.ncmp - 1 ? ((t - 31) >> 4) : T.ncmp - 1) : -1;
        for (int i = 0; i < nc64; ++i) {
            const LAS unsigned char* kt = lds + i * 16384;
            f32x16 s0 = attn_scores(kt, 0, qf, r, h), s1 = attn_scores(kt, 1, qf, r, h);
            attn_mask<false>(s0, nmaxl - 64 * i - 4 * h); attn_mask<false>(s1, nmaxl - 64 * i - 32 - 4 * h);
            float mx = fmaxf(s0[0], s1[0]);
#pragma unroll
            for (int e = 1; e < 16; ++e) mx = fmaxf(mx, fmaxf(s0[e], s1[e]));
            mx = xor32_max(mx) * ATT_C;
            const float mn = fmaxf(cm, mx), mu = (mn == -__builtin_inff()) ? 0.f : mn; float ps = 0.f;
#pragma unroll
            for (int e = 0; e < 16; ++e) ps += __builtin_amdgcn_exp2f(__builtin_fmaf(s0[e], ATT_C, -mu)) + __builtin_amdgcn_exp2f(__builtin_fmaf(s1[e], ATT_C, -mu));
            ps = xor32_sum(ps);
            cl = (cm == -__builtin_inff() ? 0.f : cl * __builtin_amdgcn_exp2f(cm - mn)) + ps; cm = mn;
        }
        const float linv = cl > 0.f ? 1.f / cl : 0.f, cmu = (cm == -__builtin_inff()) ? 0.f : cm;
        for (int i = 0; i < nc64; ++i) {
            const LAS unsigned char* kt = lds + i * 16384;
            f32x16 s0 = attn_scores(kt, 0, qf, r, h), s1 = attn_scores(kt, 1, qf, r, h);
            attn_mask<false>(s0, nmaxl - 64 * i - 4 * h); attn_mask<false>(s1, nmaxl - 64 * i - 32 - 4 * h);
#pragma unroll
            for (int e = 0; e < 16; ++e) { s0[e] = __builtin_amdgcn_exp2f(__builtin_fmaf(s0[e], ATT_C, -cmu)) * linv; s1[e] = __builtin_amdgcn_exp2f(__builtin_fmaf(s1[e], ATT_C, -cmu)) * linv; }
            attn_pv(A, s0, s1, kt + 8192, r, h);
#pragma unroll
            for (int e = 0; e < 16; ++e) { const float pe = head_sum8(s0[e]), pf2 = head_sum8(s1[e]);
                if (head == 0) { PS[tok * 256 + 64 * i + crow(e, h)] = pe; PS[tok * 256 + 64 * i + 32 + crow(e, h)] = pf2; } }
        }
        out0 = A.o0 * gt[0]; out1 = A.o1 * gt[0];
    }
    LDS_WAIT(); __builtin_amdgcn_wave_barrier();
    unsigned long long msk[4] = {0ull, 0ull, 0ull, 0ull};
    if (cw) {
#pragma unroll
        for (int tk = 0; tk < 4; ++tk) {
            const int tt = pos0w + tk, cur = tt >> 6, j = lane;
            float imp = 0.f;
#pragma unroll
            for (int dn = -1; dn <= 3; ++dn) { const int n = 4 * j + dn; if (n >= 0 && n < T.ncmp) imp += PS[tk * 256 + n]; }
            const bool valid = (j <= cur) && (j < T.nsel), forced = (j == 0) || (j == cur) || (j == cur - 1);
            const unsigned key = !valid ? 0u : (forced ? 0xffffffffu : __builtin_bit_cast(unsigned, imp) + 1u);
            unsigned thr = 0u;
#pragma unroll 1
            for (int bit = 31; bit >= 0; --bit) { const unsigned cand = thr | (1u << bit); if (__builtin_popcountll(__ballot(key >= cand)) >= 16) thr = cand; }
            const int need = 16 - __builtin_popcountll(__ballot(key > thr));
            const unsigned long long ties = __ballot(key == thr);
            const bool tie_ok = key == thr && __builtin_popcountll(ties & ((1ull << j) - 1ull)) < need;
            msk[tk] = __ballot(valid && (key > thr || tie_ok));
        }
    }
    { const unsigned long long wu = msk[0] | msk[1] | msk[2] | msk[3];
      if (lane == 0) { UM[2 * F.wave] = (unsigned)wu; UM[2 * F.wave + 1] = (unsigned)(wu >> 32); } }
    LDS_WAIT(); AT_BAR();
    unsigned long long un = 0ull;
#pragma unroll
    for (int w = 0; w < 8; ++w) un |= (unsigned long long)UM[2 * w] | ((unsigned long long)UM[2 * w + 1] << 32);
    un = ((unsigned long long)__builtin_amdgcn_readfirstlane((unsigned)(un >> 32)) << 32) | (unsigned long long)__builtin_amdgcn_readfirstlane((unsigned)un);
    {   int lo = T.pos0 - 512 - T.winbase; lo = lo < 0 ? 0 : lo;
        const int c0 = lo >> 6, nW = ((tlast - T.winbase) >> 6) - c0 + 1;
        int ntw = (nW + 1) & ~1; ntw = ntw < 4 ? 4 : ntw;
        LAS int* tlw = (LAS int*)(lds + nb::LDS_TL);
        { LAS bf16* stg = (LAS bf16*)(lds + nb::LDS_OST + F.wave * 4096) + r * 64 + 4 * h;
#pragma unroll
          for (int q4 = 0; q4 < 4; ++q4) {
              *(LAS u32x2*)(stg + 8 * q4) = (u32x2){pg8::cvt_pk_bf16(out0[4 * q4], out0[4 * q4 + 1]), pg8::cvt_pk_bf16(out0[4 * q4 + 2], out0[4 * q4 + 3])};
              *(LAS u32x2*)(stg + 32 + 8 * q4) = (u32x2){pg8::cvt_pk_bf16(out1[4 * q4], out1[4 * q4 + 1]), pg8::cvt_pk_bf16(out1[4 * q4 + 2], out1[4 * q4 + 3])}; } }
        if (F.wave == 0) for (int i = lane; i < 96; i += 64) tlw[i] = i < nW ? c0 + i : -1;
        asm volatile("s_waitcnt vmcnt(0) lgkmcnt(0)\n\ts_barrier" ::: "memory");
        const int p0w = cw ? pos0w : -(1 << 24);
        nb::ring_unit<8>(0, false, T.Q + (size_t)wtok * T.ldq, T.ldq, T.Kw, T.Vw, T.ldkw, tlw, ntw, T.winbase, p0w, 0ull, 0ull, 0ull, 0ull, T.gate + (size_t)wtok * T.ldq, 2, cw, T.O + (size_t)wtok * DM, (char*)lds);
    }
    { const bf16* qp = T.Q + (size_t)(wtok + tok) * T.ldq + head * 64 + 8 * h; asm volatile("" : "+v"(qp));
#pragma unroll
      for (int st = 0; st < 4; ++st) qf[st] = *(const bf16x8*)(qp + 16 * st); }
    const int nCh = __builtin_popcountll(un);
    unsigned long long rem_i = un, rem_c = un;
#define AT_ISSUE(q) do { const int j_ = __builtin_ctzll(rem_i); rem_i &= rem_i - 1ull; AT_DMA(T.Ks + (size_t)j_ * 64 * T.ldks, T.ldks, T.Vs + (size_t)j_ * 64 * T.ldks, T.ldks, (q) & 3); } while (0)
    for (int q = 0; q < 3 && q < nCh; ++q) AT_ISSUE(q);
    attn_reset(A);
    const unsigned long long mym = tok == 0 ? msk[0] : (tok == 1 ? msk[1] : (tok == 2 ? msk[2] : msk[3]));
    const unsigned long long wany = msk[0] | msk[1] | msk[2] | msk[3];
    for (int i = 0; i < nCh; ++i) {
        const int left = nCh - 1 - i;
        if (left >= 2) AT_WAITV(4); else if (left == 1) AT_WAITV(2); else AT_WAITV(0);
        AT_BAR();
        if (i + 3 < nCh) AT_ISSUE(i + 3);
        const LAS unsigned char* kt = lds + (i & 3) * 16384;
        const int j = __builtin_ctzll(rem_c); rem_c &= rem_c - 1ull;
        if (cw && ((wany >> j) & 1ull) && 64 * j <= pos0w + 3) {
            const bool mine = (mym >> j) & 1ull;
            const bool allv = 64 * j + 63 <= pos0w;
            const int hi = mine ? t - 64 * j - 4 * h : -1;
            attn_chunk<false>(A, kt, qf, hi, mine ? hi - 32 : -1, allv, mine, r, h);
        }
    }
#undef AT_DMA
#undef AT_ISSUE
#undef AT_WAITV
#undef AT_BAR
    if (cw) {
        const float inv = A.l > 0.f ? gt[1] / A.l : 0.f;
        const LAS bf16* stg = (const LAS bf16*)(lds + nb::LDS_OST + F.wave * 4096) + r * 64 + 4 * h;
        bf16* op = T.O + (size_t)(wtok + tok) * DM + head * 64;
#pragma unroll
        for (int q4 = 0; q4 < 4; ++q4) {
            const u32x2 w0 = *(const LAS u32x2*)(stg + 8 * q4), w1 = *(const LAS u32x2*)(stg + 32 + 8 * q4);
            *(u32x2*)(op + 8 * q4 + 4 * h) = (u32x2){pk2(bflo(w0.x) + A.o0[4 * q4] * inv, bfhi(w0.x) + A.o0[4 * q4 + 1] * inv), pk2(bflo(w0.y) + A.o0[4 * q4 + 2] * inv, bfhi(w0.y) + A.o0[4 * q4 + 3] * inv)};
            *(u32x2*)(op + 32 + 8 * q4 + 4 * h) = (u32x2){pk2(bflo(w1.x) + A.o1[4 * q4] * inv, bfhi(w1.x) + A.o1[4 * q4 + 1] * inv), pk2(bflo(w1.y) + A.o1[4 * q4 + 2] * inv, bfhi(w1.y) + A.o1[4 * q4 + 3] * inv)}; }
    }
}
DI void nsa_attention(const P& p, const Frame& F, int li) {
    const bf16* H = (const bf16*)(p.ws + WS_H); bf16* AO = (bf16*)(p.ws + WS_AO);
    constexpr int NT_P = NB * 2 * (SEQ / 32), NT_S = DB * 2;
    for (int id = F.bid; id < NT_P + NT_S; id += F.G) {
        WTask T;
        if (id < NT_P) {
            int g, b, tq; if (F.G == 256) { const int k = id >> 8, w = (id & 255) >> 3; g = id & 1; b = (id & 7) >> 1; tq = k == 0 ? w : (k == 1 ? 63 - w : (k == 2 ? 64 + w : 127 - w)); }
            else { const int q = id >> 1; g = id & 1; b = q >> 7; tq = (b & 1) ? 127 - (q & 127) : (q & 127); }
            const size_t row = (size_t)b * SEQ + 32 * tq;
            T.Q = H + row * NINP + g * 512; T.ldq = NINP; T.gate = H + row * NINP + 1792 + g * 24; T.pos0 = 32 * tq; T.ncw = 8;
            T.Kc = (const bf16*)(p.ws + WS_KC_P) + (size_t)(b * 2 + g) * 256 * 64; T.Vc = (const bf16*)(p.ws + WS_VCT_P) + (size_t)(b * 2 + g) * 256 * 64; T.ncmp = NCMP_P;
            T.Ks = H + (size_t)b * SEQ * NINP + 1280 + g * 64; T.ldks = NINP; T.Vs = H + (size_t)b * SEQ * NINP + 1408 + g * 64; T.nsel = NSEL_P;
            T.Kw = H + (size_t)b * SEQ * NINP + 1536 + g * 64; T.ldkw = NINP; T.Vw = H + (size_t)b * SEQ * NINP + 1664 + g * 64; T.winbase = 0;
            T.O = AO + row * DM + g * 512; }
        else { const int i2 = id - NT_P, g = i2 & 1, b = i2 >> 1; const size_t row = (size_t)MP + b * DS;
            T.Q = H + row * NINP + g * 512; T.ldq = NINP; T.gate = H + row * NINP + 1792 + g * 24; T.pos0 = PAST; T.ncw = 2;
            T.Kc = (const bf16*)(p.ws + WS_KC_S) + (size_t)(b * 2 + g) * 128 * 64; T.Vc = (const bf16*)(p.ws + WS_VCT_S) + (size_t)(b * 2 + g) * 128 * 64; T.ncmp = NCMP_S;
            T.Ks = (const bf16*)(p.ws + WS_KSLC_S + li * SZ_SLC_S) + (size_t)(b * 2 + g) * SLC_S_ROWS * 64; T.ldks = 64; T.Vs = (const bf16*)(p.ws + WS_VSLCT_S + li * SZ_SLC_S) + (size_t)(b * 2 + g) * SLC_S_ROWS * 64; T.nsel = NSEL_S;
            T.Kw = (const bf16*)(p.ws + WS_KWIN_S + li * SZ_WIN_S) + (size_t)(b * 2 + g) * WIN_S_ROWS * 64; T.ldkw = 64; T.Vw = (const bf16*)(p.ws + WS_VWINT_S + li * SZ_WIN_S) + (size_t)(b * 2 + g) * WIN_S_ROWS * 64; T.winbase = PAST - 512;
            T.O = AO + row * DM + g * 512; }
        nsa_attend_wg(T, F);
        __syncthreads();
    }
}

DI void small_gemm_resid(const Frame& F, const bf16* A, const bf16* Bt, int K, float* X) {
    LAS unsigned char* lds = F.lds; LAS float* red = (LAS float*)(F.lds + 98304);
    const int r = F.lane & 31, h = F.lane >> 5, mi = F.wave & 1, ni = (F.wave >> 1) & 1, kh = F.wave >> 2, nst = K >> 7;
    const int p0 = F.tid, p1 = F.tid + 512;
    const int r0 = p0 >> 4, c0 = (p0 & 15) ^ (r0 & 15), r1 = p1 >> 4, c1 = (p1 & 15) ^ (r1 & 15);
    const unsigned wb = (unsigned)F.wave * 1024u;
    for (int tile = F.bid; tile < 256; tile += F.G) {
        const int row0 = MP + (tile >> 4) * 64, col0 = (tile & 15) * 64;
        const bf16* a0 = A + (size_t)(row0 + r0) * K + c0 * 8; const bf16* a1 = A + (size_t)(row0 + r1) * K + c1 * 8;
        const bf16* b0 = Bt + (size_t)(col0 + r0) * K + c0 * 8; const bf16* b1 = Bt + (size_t)(col0 + r1) * K + c1 * 8;
#define SG_DMA(s_) do { const int k_ = (s_) * 128; LAS unsigned char* d_ = lds + ((s_) % 3) * 32768 + wb; \
        __builtin_amdgcn_global_load_lds((const unsigned*)(a0 + k_), (LAS unsigned*)d_, 16, 0, 0); __builtin_amdgcn_global_load_lds((const unsigned*)(a1 + k_), (LAS unsigned*)(d_ + 8192), 16, 0, 0); \
        __builtin_amdgcn_global_load_lds((const unsigned*)(b0 + k_), (LAS unsigned*)(d_ + 16384), 16, 0, 0); __builtin_amdgcn_global_load_lds((const unsigned*)(b1 + k_), (LAS unsigned*)(d_ + 24576), 16, 0, 0); } while (0)
        f32x16 acc; for (int e = 0; e < 16; ++e) acc[e] = 0.f;
        SG_DMA(0); if (nst > 1) SG_DMA(1);
        for (int s = 0; s < nst; ++s) {
            if (s + 1 < nst) asm volatile("s_waitcnt vmcnt(4)" ::: "memory"); else asm volatile("s_waitcnt vmcnt(0)" ::: "memory");
            asm volatile("" ::: "memory"); __builtin_amdgcn_s_barrier(); asm volatile("" ::: "memory");
            if (s + 2 < nst) SG_DMA(s + 2);
            const LAS unsigned char* ia = lds + (s % 3) * 32768; const LAS unsigned char* ib = ia + 16384;
            const int ra = 32 * mi + r, rb = 32 * ni + r;
#pragma unroll
            for (int u = 0; u < 4; ++u) { const int ch = 8 * kh + 2 * u + h;
                acc = MFMA32(*(const LAS bf16x8*)(ia + ra * 256 + ((ch ^ (ra & 15)) << 4)), *(const LAS bf16x8*)(ib + rb * 256 + ((ch ^ (rb & 15)) << 4)), acc); }
        }
#undef SG_DMA
        if (kh == 1) {
#pragma unroll
            for (int e = 0; e < 16; ++e) red[((F.wave & 3) * 16 + e) * 64 + F.lane] = acc[e]; }
        __syncthreads();
        if (kh == 0) {
#pragma unroll
            for (int e = 0; e < 16; ++e) { float* xp = X + (size_t)(row0 + 32 * mi + crow(e, h)) * DM + col0 + 32 * ni + r; *xp = *xp + acc[e] + red[((F.wave & 3) * 16 + e) * 64 + F.lane]; } }
        __syncthreads();
    }
}

DI P load_ptrs(LAS unsigned char* lds) {
    unsigned off = PTAB_OFF; asm volatile("" : "+s"(off));
    const LAS unsigned* t = (const LAS unsigned*)(lds + off);
    P q;
#pragma unroll
    for (int k = 0; k < 28; ++k) { const unsigned lo = __builtin_amdgcn_readfirstlane(t[2 * k]), hi = __builtin_amdgcn_readfirstlane(t[2 * k + 1]);
        void* v = (void*)(GAS char*)(((unsigned long long)hi << 32) | lo);
        if (k < 26) q.in[k] = v; else if (k == 26) q.out = (float*)v; else q.ws = (unsigned char*)v; }
    return q;
}
__global__ void __launch_bounds__(512, 2) hybrid_fwd(P parg) {
    extern __shared__ __attribute__((aligned(16))) unsigned char lds_raw[];
    Frame F;
    F.lds = (LAS unsigned char*)lds_raw; F.tid = threadIdx.x; F.lane = F.tid & 63; F.wave = __builtin_amdgcn_readfirstlane(F.tid >> 6);
    F.bid = blockIdx.x; F.G = gridDim.x; F.gw = F.bid * 8 + F.wave; F.ngw = F.G * 8;
    volatile LAS unsigned* MISC = (volatile LAS unsigned*)(F.lds + MISC_OFF);
    for (int u = F.tid; u < (LDS_BYTES - RING_BYTES) / 4; u += 512) ((LAS unsigned*)(F.lds + RING_BYTES))[u] = 0u;
    __syncthreads();
    if (F.tid < 28) { const void* v = F.tid < 26 ? parg.in[F.tid] : (F.tid == 26 ? (const void*)parg.out : (const void*)parg.ws);
        const unsigned long long w = (unsigned long long)v; LAS unsigned* t = (LAS unsigned*)(F.lds + PTAB_OFF); t[2 * F.tid] = (unsigned)w; t[2 * F.tid + 1] = (unsigned)(w >> 32); }
    __syncthreads();
    XcdBarrier bar = xcd_barrier_post((unsigned*)(parg.ws + WS_CTL) + CW_BAR, MISC + 8);
#define REFRESH() do { int t_ = threadIdx.x, b_ = __builtin_amdgcn_readfirstlane(F.bid), g_ = __builtin_amdgcn_readfirstlane(F.G); asm volatile("" : "+v"(t_), "+s"(b_), "+s"(g_)); F.tid = t_; F.lane = t_ & 63; F.wave = __builtin_amdgcn_readfirstlane(t_ >> 6); F.bid = b_; F.G = g_; F.gw = b_ * 8 + F.wave; F.ngw = g_ * 8; } while (0)
#define GRID_BAR() do { xcd_barrier(bar); REFRESH(); } while (0)
#define PH(...) do { const P p = load_ptrs(F.lds); unsigned char* ws = p.ws; (void)ws; __VA_ARGS__ } while (0)
    PH( p0_cbias(p, F); );
    PH( p0_weights(p, F, 0); );
    PH( rms_phase<0>(p, F, (const float*)p.in[7]); );
    GRID_BAR();
#define LAYER_BODY(layer) { const int li = (layer) >> 1;  \
        if ((layer & 1) == 0) { \
            PH( pg8::Gemm g{DM, DM, 128}; pg8::StaticOrder S; S.init(M, GINP, F.G, F.bid, ws + WS_XN, ws + WS_WG_IN + li * SZ_WG_IN, ws + WS_H, DM, DM); \
                pg8::EpiBf16 E{GINP}; pg8::gemm_phase(F.lds, g, S, E); ); \
            GRID_BAR(); \
            PH( gdn_prep(p, F, li); ); \
            GRID_BAR(); \
            PH( gdn_chunk(p, F, li); ); \
            GRID_BAR(); \
            PH( if (F.G > 64) { if (F.bid < 64) gdn_scan(p, F, li, (((F.bid & 7) + 8 * (F.bid >> 4)) << 1) | ((F.bid >> 3) & 1)); else {     for (int task = F.bid - 64; task < DB * GH; task += F.G - 64) gdn_sample(p, F, li, task); Frame F2 = F; F2.bid = F.bid - 64; F2.G = F.G - 64; F2.gw = F2.bid * 8 + F.wave; F2.ngw = F2.G * 8; p0_cache_win(p, F2, li); if (li == 0) p0_weights(p, F2, 1); } } \
                else { for (int sid = F.bid; sid < 64; sid += F.G) { gdn_scan(p, F, li, sid); __syncthreads(); } for (int task = F.bid; task < DB * GH; task += F.G) gdn_sample(p, F, li, task); p0_cache_win(p, F, li); if (li == 0) p0_weights(p, F, 1); } ); \
            GRID_BAR(); \
            PH( gdn_gate(p, F, li); if (layer == 0) p0_cbias2(p, F); ); \
            GRID_BAR(); \
        } else { \
            PH( pg8::Gemm g{DM, DM, 128}; pg8::StaticOrder S; S.init(M, NINP, F.G, F.bid, ws + WS_XN, ws + WS_WN_IN + li * SZ_WN_IN, ws + WS_H, DM, DM); \
                pg8::EpiNsaIn E{(bf16*)(ws + WS_H), p.out, (bf16*)(ws + WS_CMPP), li}; pg8::gemm_phase(F.lds, g, S, E); \
                if (F.G > 32 && F.bid >= 32) { pg8::Gemm g2{1024, 4096, 512}; CmpOrder S2{F.G - 32, F.bid - 32, li, ws, 320, 224}; pg8::EpiBf16 E2{512}; pg8::gemm_phase(F.lds, g2, S2, E2); } ); \
            GRID_BAR(); \
            PH( nsa_transpose(p, F, li); ); \
            __syncthreads(); REFRESH(); \
            PH( pg8::Gemm g{1024, 4096, 512}; CmpOrder S{F.G, F.bid, li, ws, 0, F.G > 32 ? 320 : 544}; pg8::EpiBf16 E{512}; pg8::gemm_phase(F.lds, g, S, E); ); \
            GRID_BAR(); \
            PH( nsa_cmp2(p, F, li); ); \
            GRID_BAR(); \
            PH( nsa_attention(p, F, li); ); \
            GRID_BAR(); \
        } \
        PH( const bf16* Wout = (const bf16*)(ws + ((layer & 1) ? WS_WN_OUT : WS_WG_OUT) + li * SZ_W1K); \
            pg8::Gemm g{DM, DM, 128}; pg8::StaticOrder S; S.init(MP, DM, F.G, F.bid, ws + WS_AO, Wout, nullptr, DM, DM); \
            pg8::EpiResid E{(float*)(ws + WS_X)}; pg8::gemm_phase(F.lds, g, S, E); small_gemm_resid(F, (const bf16*)(ws + WS_AO), Wout, DM, (float*)(ws + WS_X)); ); \
        GRID_BAR(); \
        PH( rms_phase<1>(p, F, (const float*)p.in[8] + layer * DM); ); \
        GRID_BAR(); \
        PH( pg8::Gemm g{DM, DM, 128}; pg8::StaticOrder S; S.init(M, FF2, F.G, F.bid, ws + WS_XN, ws + WS_WF_IN + layer * SZ_WF_IN, nullptr, DM, DM); \
            pg8::EpiSwiglu E{(bf16*)(ws + WS_FFH), FF}; pg8::gemm_phase(F.lds, g, S, E); ); \
        GRID_BAR(); \
        PH( pg8::Gemm g{FF, FF, 128}; pg8::StaticOrder S; S.init(MP, DM, F.G, F.bid, ws + WS_FFH, ws + WS_WF_OUT + layer * SZ_WF_OUT, nullptr, FF, FF); \
            pg8::EpiResid E{(float*)(ws + WS_X)}; pg8::gemm_phase(F.lds, g, S, E); small_gemm_resid(F, (const bf16*)(ws + WS_FFH), (const bf16*)(ws + WS_WF_OUT + layer * SZ_WF_OUT), FF, (float*)(ws + WS_X)); ); \
        GRID_BAR(); \
        if (layer < 3) { PH( rms_phase<1>(p, F, (const float*)p.in[7] + (layer + 1) * DM); ); GRID_BAR(); } \
     }
    LAYER_BODY(0)
    LAYER_BODY(1)
    LAYER_BODY(2)
    LAYER_BODY(3)
    PH( rms_phase<2>(p, F, (const float*)p.in[9]); );
}

extern "C" void kernel_launch(void* const* d_in, const int* in_sizes, int n_in, void* d_out, int out_size, void* d_ws, size_t ws_size, hipStream_t stream) {
    static int grid = 0;
    if (grid == 0) {
        if (n_in != 26 || ws_size < WS_END) { fprintf(stderr, "kernel_launch: unexpected n_in %d or ws_size %zu (< %zu)\n", n_in, ws_size, (size_t)WS_END); grid = -1; return; }
        int dev = 0, cus = 0, per_cu = 0;
        if (hipGetDevice(&dev) != hipSuccess || hipDeviceGetAttribute(&cus, hipDeviceAttributeMultiprocessorCount, dev) != hipSuccess) { grid = -1; return; }
        if (hipFuncSetAttribute((const void*)hybrid_fwd, hipFuncAttributeMaxDynamicSharedMemorySize, LDS_BYTES) != hipSuccess) { fprintf(stderr, "kernel_launch: hipFuncSetAttribute failed\n"); grid = -1; return; }
        if (hipOccupancyMaxActiveBlocksPerMultiprocessor(&per_cu, (const void*)hybrid_fwd, 512, LDS_BYTES) != hipSuccess || per_cu < 1) fprintf(stderr, "kernel_launch: occupancy query says %d\n", per_cu);
        (void)hipGetLastError();
        grid = cus;
    }
    if (grid < 0) return;
    (void)in_sizes; (void)out_size;
    (void)hipMemsetAsync((char*)d_ws + WS_CTL, 0, CTL_BYTES, stream);
    P p{};
    for (int i = 0; i < 26; ++i) p.in[i] = d_in[i];
    p.out = (float*)d_out; p.ws = (unsigned char*)d_ws;
    hipLaunchKernelGGL(hybrid_fwd, dim3(grid), dim3(512), LDS_BYTES, stream, p);
}
```

```cpp
#include <hip/hip_runtime.h>
#include <cstdio>

#define DI __device__ __forceinline__
#define LAS __attribute__((address_space(3)))
#define GAS __attribute__((address_space(1)))
typedef unsigned short bf16;
typedef short bf16x8 __attribute__((ext_vector_type(8)));
typedef short s16x4 __attribute__((ext_vector_type(4)));
typedef float f32x4 __attribute__((ext_vector_type(4)));
typedef float f32x2 __attribute__((ext_vector_type(2)));
typedef float f32x16 __attribute__((ext_vector_type(16)));
typedef unsigned u32x4 __attribute__((ext_vector_type(4)));
typedef unsigned u32x2 __attribute__((ext_vector_type(2)));

constexpr int DM = 1024, NB = 4, SEQ = 4096, DB = 128, DS = 8, PAST = 2048, PAGE = 128, NPAGE = 16, NPHYS = 2560;
constexpr int MP = NB * SEQ, MS = DB * DS, M = MP + MS;
constexpr int GH = 8, GDK = 128, GQKV = 3072, GIN = 4112, GINP = 4352;
constexpr int NIN = 1840, NINP = 2048;
constexpr int FF = 2816, FF2 = 5632;
constexpr int NCMP_P = 255, NCMP_S = 127, NSEL_P = 64, NSEL_S = 33;
constexpr int SLC_S_ROWS = 2112, WIN_S_ROWS = 576;
constexpr int NCHUNK = NB * GH * 64;

constexpr size_t O_Y = 0, O_KVP = 17825792, O_KVS = 34603008, O_WINP = 35651584, O_WINS = 36700160, O_GSP = 70254592, O_GSS = 71303168, O_GCP = 104857600, O_GCS = 104931328;

constexpr size_t al256(size_t x) { return (x + 255) & ~(size_t)255; }
constexpr size_t WS_CTL = 0, CTL_BYTES = 1u << 20;
constexpr size_t SZ_WG_IN = (size_t)GINP * DM * 2, SZ_W1K = (size_t)DM * DM * 2, SZ_WN_IN = (size_t)NINP * DM * 2, SZ_WF_IN = (size_t)FF2 * DM * 2, SZ_WF_OUT = (size_t)DM * FF * 2, SZ_WC1 = (size_t)512 * 1024 * 2;
constexpr size_t WS_WG_IN = WS_CTL + CTL_BYTES;
constexpr size_t WS_WG_OUT = WS_WG_IN + 2 * SZ_WG_IN;
constexpr size_t WS_WN_IN = WS_WG_OUT + 2 * SZ_W1K;
constexpr size_t WS_WN_OUT = WS_WN_IN + 2 * SZ_WN_IN;
constexpr size_t WS_WF_IN = WS_WN_OUT + 2 * SZ_W1K;
constexpr size_t WS_WF_OUT = WS_WF_IN + 4 * SZ_WF_IN;
constexpr size_t WS_WC1 = WS_WF_OUT + 4 * SZ_WF_OUT;
constexpr size_t WS_CBIAS = WS_WC1 + 4 * SZ_WC1;
constexpr size_t WS_X = WS_CBIAS + 4096;
constexpr size_t WS_XN = WS_X + (size_t)M * DM * 4;
constexpr size_t WS_H = WS_XN + (size_t)M * DM * 2;
constexpr size_t WS_FFH = WS_H + (size_t)M * GINP * 2;
constexpr size_t WS_AO = WS_FFH + (size_t)M * FF * 2;
constexpr size_t WS_QH = WS_AO + (size_t)M * DM * 2;
constexpr size_t WS_KH = WS_QH + (size_t)M * DM * 2;
constexpr size_t WS_VH = WS_KH + (size_t)M * DM * 2;
constexpr size_t WS_BETA = WS_VH + (size_t)M * DM * 2;
constexpr size_t WS_LOGA = WS_BETA + (size_t)M * 8 * 4;
constexpr size_t WS_OG = WS_LOGA + (size_t)M * 8 * 4;
constexpr size_t WS_CW = WS_OG + (size_t)M * DM * 4;
constexpr size_t WS_CUT = WS_CW + (size_t)NCHUNK * 64 * 128 * 2;
constexpr size_t WS_CAQK = WS_CUT + (size_t)NCHUNK * 128 * 64 * 4;
constexpr size_t WS_CQT = WS_CAQK + (size_t)NCHUNK * 64 * 64 * 2;
constexpr size_t WS_CKTT = WS_CQT + (size_t)NCHUNK * 64 * 128 * 2;
constexpr size_t WS_CEGL = WS_CKTT + (size_t)NCHUNK * 128 * 64 * 2;
constexpr size_t WS_CMPP = WS_CEGL + (size_t)NCHUNK * 4;
constexpr size_t SZ_CMPS = (size_t)DB * PAST * 256 * 2;
constexpr size_t WS_CMPS = WS_CMPP + (size_t)MP * 256 * 2;
constexpr size_t SZ_SLC_S = (size_t)DB * 2 * SLC_S_ROWS * 64 * 2;
constexpr size_t WS_KSLC_S = WS_CMPS + 2 * SZ_CMPS;
constexpr size_t WS_VSLCT_S = WS_KSLC_S + 2 * SZ_SLC_S;
constexpr size_t SZ_WIN_S = (size_t)DB * 2 * WIN_S_ROWS * 64 * 2;
constexpr size_t WS_KWIN_S = WS_VSLCT_S + 2 * SZ_SLC_S;
constexpr size_t WS_VWINT_S = WS_KWIN_S + 2 * SZ_WIN_S;
constexpr size_t WS_VSLCT_P = WS_VWINT_S + 2 * SZ_WIN_S;
constexpr size_t WS_VWINT_P = WS_VSLCT_P + (size_t)NB * 2 * 64 * SEQ * 2;
constexpr size_t WS_PC_P = WS_VWINT_P + (size_t)NB * 2 * 64 * SEQ * 2;
constexpr size_t WS_PC_S = WS_PC_P + (size_t)4 * 1024 * 512 * 2;
constexpr size_t WS_KC_P = WS_PC_S + (size_t)4 * 16384 * 512 * 2;
constexpr size_t WS_VCT_P = WS_KC_P + (size_t)NB * 2 * 256 * 64 * 2;
constexpr size_t WS_KC_S = WS_VCT_P + (size_t)NB * 2 * 256 * 64 * 2;
constexpr size_t WS_VCT_S = WS_KC_S + (size_t)DB * 2 * 128 * 64 * 2;
constexpr size_t WS_END = WS_VCT_S + (size_t)DB * 2 * 128 * 64 * 2;

constexpr int CW_BAR = 4096;

constexpr int RING_BYTES = 131072, MISC_OFF = RING_BYTES + 320, LDS_BYTES = 147456;
constexpr int PTAB_OFF = RING_BYTES + 1024;

typedef __bf16 hwbf16x2 __attribute__((ext_vector_type(2)));
DI unsigned pk2(float lo, float hi) { const f32x2 v = {lo, hi}; return __builtin_bit_cast(unsigned, __builtin_convertvector(v, hwbf16x2)); }
DI unsigned f2bf(float f) { return pk2(f, f) & 0xffffu; }
DI float bf2f(unsigned b) { return __builtin_bit_cast(float, b << 16); }
DI float bflo(unsigned w) { return __builtin_bit_cast(float, w << 16); }
DI float bfhi(unsigned w) { return __builtin_bit_cast(float, w & 0xffff0000u); }
template <int CTRL> DI float dppf(float x) { return __builtin_bit_cast(float, __builtin_amdgcn_update_dpp(0, __builtin_bit_cast(int, x), CTRL, 0xF, 0xF, true)); }
DI float sum16(float x) { x += dppf<0xB1>(x); x += dppf<0x4E>(x); x += dppf<0x141>(x); x += dppf<0x140>(x); return x; }
DI float xor16_sum(float x) { auto s = __builtin_amdgcn_permlane16_swap(__float_as_uint(x), __float_as_uint(x), false, false); const unsigned s0 = s[0], s1 = s[1];
    return __uint_as_float(s0) + __uint_as_float(s1); }
DI float xor32_sum(float x) { auto s = __builtin_amdgcn_permlane32_swap(__float_as_uint(x), __float_as_uint(x), false, false); const unsigned s0 = s[0], s1 = s[1];
    return __uint_as_float(s0) + __uint_as_float(s1); }
DI float xor32_max(float x) { auto s = __builtin_amdgcn_permlane32_swap(__float_as_uint(x), __float_as_uint(x), false, false); const unsigned s0 = s[0], s1 = s[1];
    return fmaxf(__uint_as_float(s0), __uint_as_float(s1)); }
DI float sum32(float x) { return xor16_sum(sum16(x)); }
DI float wave_sum(float v) { return xor32_sum(sum32(v)); }
DI float sigmoidf_(float x) { return __builtin_amdgcn_rcpf(1.f + __expf(-x)); }
DI float siluf_(float x) { return x * __builtin_amdgcn_rcpf(1.f + __expf(-x)); }
#define LDS_WAIT() asm volatile("s_waitcnt lgkmcnt(0)" ::: "memory")
#define VM_WAIT() asm volatile("s_waitcnt vmcnt(0)" ::: "memory")

namespace pg8 {
constexpr int BM = 256, BK = 64, HALF = 128, HTB = HALF * BK * 2, STAGE_BYTES = 8 * HTB, NXCD = 8, WGM = 8;
DI int lds_byte(int r, int c) { const int st = (r >> 4) * 2 + (c >> 5), rr = r & 15, cc = c & 31, ob = rr * 64 + cc * 2; return st * 1024 + (ob ^ (((ob >> 9) & 1) << 5)); }
DI void stage_rc(int b, int& R, int& C) { const int st = b / 1024, sb = b % 1024, swz = sb ^ (((sb >> 9) & 1) << 5); R = (st >> 1) * 16 + swz / 64; C = (st & 1) * 32 + (swz % 64) / 2; }
DI int perm32(int rho) { const int n = rho >> 4, i = rho & 15; return 8 * (i >> 2) + 4 * n + (i & 3); }

struct Unit { int pm, pn, z; const char* A; const char* B; char* C; };
struct Gemm { int K; int lda; int kstepA; };

struct StaticOrder {
    int nM, nN, nwg, G, c, K, lda; const char* A; const char* B; char* C;
    DI void init(int M_, int N_, int G_, int c_, const void* A_, const void* B_, void* C_, int K_, int lda_) { nM = M_ / BM; nN = N_ / BM; nwg = nM * nN; G = G_; c = c_; A = (const char*)A_; B = (const char*)B_; C = (char*)C_; K = K_; lda = lda_; }
    DI bool next(int i, Unit& u) const {
        const long L = (long)i * G + c; if (L >= nwg) return false;
        int wgid = (int)L; { const int q = nwg / NXCD, r = nwg % NXCD, xcd = wgid % NXCD, off = wgid / NXCD; wgid = (xcd < r ? xcd * (q + 1) : r * (q + 1) + (xcd - r) * q) + off; }
        const int nig = WGM * nN, gid = wgid / nig, fm = gid * WGM, gsz = (nM - fm) < WGM ? (nM - fm) : WGM;
        u.pm = fm + ((wgid % nig) % gsz); u.pn = (wgid % nig) / gsz; u.z = 0;
        u.A = A + (size_t)u.pm * BM * lda * 2; u.B = B + (size_t)u.pn * BM * K * 2; u.C = C; return true;
    }
};

DI unsigned cvt_pk_bf16(float lo, float hi) { unsigned r; asm volatile("v_cvt_pk_bf16_f32 %0, %1, %2" : "=v"(r) : "v"(lo), "v"(hi)); return r; }

struct EpiBf16 {
    static constexpr bool PERM = true; static constexpr bool INIT = false;
    int ldc;
    DI void operator()(const f32x4 (&acc)[2][2][4][2], const Unit& u, int wr, int wc, int fr, int fq) const {
        const int row0 = u.pm * BM + wr * 64 + fr, col0 = u.pn * BM + wc * 32 + 8 * fq;
#pragma unroll
        for (int ai = 0; ai < 2; ++ai)
#pragma unroll
            for (int m = 0; m < 4; ++m) { bf16* rowp = (bf16*)u.C + (size_t)(row0 + ai * HALF + m * 16) * ldc + col0;
#pragma unroll
                for (int bj = 0; bj < 2; ++bj) { const f32x4 v0 = acc[ai][bj][m][0], v1 = acc[ai][bj][m][1];
                    u32x4 w; w.x = cvt_pk_bf16(v0[0], v0[1]); w.y = cvt_pk_bf16(v0[2], v0[3]); w.z = cvt_pk_bf16(v1[0], v1[1]); w.w = cvt_pk_bf16(v1[2], v1[3]);
                    *(u32x4*)(rowp + bj * HALF) = w; } }
    }
};
struct EpiSwiglu {
    static constexpr bool PERM = true; static constexpr bool INIT = false;
    bf16* O; int ldc;
    DI void operator()(const f32x4 (&acc)[2][2][4][2], const Unit& u, int wr, int wc, int fr, int fq) const {
        const int row0 = u.pm * BM + wr * 64 + fr, col0 = u.pn * HALF + wc * 32 + 8 * fq;
#pragma unroll
        for (int ai = 0; ai < 2; ++ai)
#pragma unroll
            for (int m = 0; m < 4; ++m) { bf16* rowp = O + (size_t)(row0 + ai * HALF + m * 16) * ldc + col0;
                float o[8];
#pragma unroll
                for (int n = 0; n < 2; ++n)
#pragma unroll
                    for (int e = 0; e < 4; ++e) { const float g = acc[ai][0][m][n][e], uu = acc[ai][1][m][n][e]; o[n * 4 + e] = g * __builtin_amdgcn_rcpf(1.f + __expf(-g)) * uu; }
                u32x4 w; w.x = cvt_pk_bf16(o[0], o[1]); w.y = cvt_pk_bf16(o[2], o[3]); w.z = cvt_pk_bf16(o[4], o[5]); w.w = cvt_pk_bf16(o[6], o[7]);
                *(u32x4*)rowp = w; }
    }
};
struct EpiResid {
    static constexpr bool PERM = false;
    static constexpr bool INIT = true;
    float* X;
    DI void init(f32x4 (&acc)[2][2][4][2], const Unit& u, int wr, int wc, int fr, int fq) const {
        const int row0 = u.pm * BM + wr * 64 + fr, col0 = u.pn * BM + wc * 32 + 4 * fq;
#pragma unroll
        for (int ai = 0; ai < 2; ++ai)
#pragma unroll
            for (int m = 0; m < 4; ++m) { const float* rowp = X + (size_t)(row0 + ai * HALF + m * 16) * DM + col0;
#pragma unroll
                for (int bj = 0; bj < 2; ++bj)
#pragma unroll
                    for (int n = 0; n < 2; ++n) acc[ai][bj][m][n] = *(const f32x4*)(rowp + bj * HALF + n * 16); }
    }
    DI void operator()(const f32x4 (&acc)[2][2][4][2], const Unit& u, int wr, int wc, int fr, int fq) const {
        const int row0 = u.pm * BM + wr * 64 + fr, col0 = u.pn * BM + wc * 32 + 4 * fq;
#pragma unroll
        for (int ai = 0; ai < 2; ++ai)
#pragma unroll
            for (int m = 0; m < 4; ++m) { float* rowp = X + (size_t)(row0 + ai * HALF + m * 16) * DM + col0;
#pragma unroll
                for (int bj = 0; bj < 2; ++bj)
#pragma unroll
                    for (int n = 0; n < 2; ++n) *(f32x4*)(rowp + bj * HALF + n * 16) = acc[ai][bj][m][n]; }
    }
};
struct EpiNsaIn {
    static constexpr bool PERM = true; static constexpr bool INIT = false;
    bf16* H; float* out; bf16* cmpp; int li;
    DI void operator()(const f32x4 (&acc)[2][2][4][2], const Unit& u, int wr, int wc, int fr, int fq) const {
        const int row0 = u.pm * BM + wr * 64 + fr, col0 = u.pn * BM + wc * 32 + 8 * fq;
        const bool smp = u.pm >= MP / BM;
#pragma unroll
        for (int ai = 0; ai < 2; ++ai)
#pragma unroll
            for (int m = 0; m < 4; ++m) { const int row = row0 + ai * HALF + m * 16; bf16* rowp = H + (size_t)row * NINP + col0;
                float* o = nullptr;
                if (u.pn == 4 || u.pn == 5) o = (smp ? out + O_KVS + (size_t)li * MS * 512 + (size_t)(row - MP) * 512 : out + O_KVP + (size_t)li * MP * 512 + (size_t)row * 512) + (col0 - 1024);
                else if (u.pn == 6) {
                    if (smp) { const int rs = row - MP; o = out + O_WINS + ((size_t)(li * DB + (rs >> 3)) * 512 + 504 + (rs & 7)) * 256 + (col0 - 1536); }
                    else { const int t = row & 4095; if (t >= SEQ - 512) o = out + O_WINP + ((size_t)(li * NB + (row >> 12)) * 512 + (t - (SEQ - 512))) * 256 + (col0 - 1536); } }
#pragma unroll
                for (int bj = 0; bj < 2; ++bj) { const float qs = u.pn < 4 ? 0.18033688011112042f : 1.f;
                    const f32x4 v0 = acc[ai][bj][m][0] * qs, v1 = acc[ai][bj][m][1] * qs;
                    u32x4 w; w.x = cvt_pk_bf16(v0[0], v0[1]); w.y = cvt_pk_bf16(v0[2], v0[3]); w.z = cvt_pk_bf16(v1[0], v1[1]); w.w = cvt_pk_bf16(v1[2], v1[3]);
                    *(u32x4*)(rowp + bj * HALF) = w;
                    if (o) { *(f32x4*)(o + bj * HALF) = v0; *(f32x4*)(o + bj * HALF + 4) = v1; }
                    if (u.pn == 4 && !smp) *(u32x4*)(cmpp + (size_t)row * 256 + (col0 - 1024) + bj * HALF) = w; } }
    }
};

template <class Epi, class Sched>
DI void gemm_phase(LAS unsigned char* lds, const Gemm g, const Sched& S, const Epi& E) {
    int tid_ = threadIdx.x; asm volatile("" : "+v"(tid_)); const int tid = tid_, wid = __builtin_amdgcn_readfirstlane(tid >> 6), lane = tid & 63, wr = wid >> 2, wc = wid & 3, fr = lane & 15, fq = lane >> 4;
    const int K = g.K, nt = K / BK;
    unsigned voffA[2], voffB[2];
#pragma unroll
    for (int i = 0; i < 2; ++i) { int R, C; stage_rc(tid * 16 + i * 8192, R, C); const int Rb = Epi::PERM ? ((R & ~31) + perm32(R & 31)) : R;
        voffA[i] = (unsigned)(R * g.lda + C) * 2u; voffB[i] = (unsigned)(Rb * K + C) * 2u; }
    const size_t kstepA = (size_t)g.kstepA, kstepB = (size_t)(BK * 2);
    const size_t hstepA = (size_t)HALF * g.lda * 2, hstepB = (size_t)HALF * K * 2;
    const unsigned ldsw = (unsigned)wid * 1024u;
    const int aoff = lds_byte(wr * 64 + fr, fq * 8), boff = lds_byte(wc * 32 + fr, fq * 8);
#define PG8_SA(b, h) (((b) * 2 + (h)) * HTB)
#define PG8_SB(b, h) ((4 + (b) * 2 + (h)) * HTB)
#define PG8_STAGE(bufoff, gbase, voff) do { _Pragma("unroll") for (int _i = 0; _i < 2; ++_i) \
        __builtin_amdgcn_global_load_lds((const unsigned*)((const char*)(gbase) + (voff)[_i]), (LAS unsigned*)(lds + (bufoff) + ldsw + _i * 8192), 16, 0, 0); } while (0)
#define PG8_LDA(dst, b, h) do { _Pragma("unroll") for (int m = 0; m < 4; ++m) _Pragma("unroll") for (int k = 0; k < 2; ++k) dst[m][k] = *(const LAS bf16x8*)(lds + PG8_SA(b, h) + aoff + m * 2048 + k * 1024); } while (0)
#define PG8_LDB(dst, b, h) do { _Pragma("unroll") for (int n = 0; n < 2; ++n) _Pragma("unroll") for (int k = 0; k < 2; ++k) dst[n][k] = *(const LAS bf16x8*)(lds + PG8_SB(b, h) + boff + n * 2048 + k * 1024); } while (0)
#define PG8_MMA(ai, bj, At, Bt) do { __builtin_amdgcn_s_setprio(1); _Pragma("unroll") for (int m = 0; m < 4; ++m) _Pragma("unroll") for (int n = 0; n < 2; ++n) _Pragma("unroll") for (int k = 0; k < 2; ++k) \
        acc[ai][bj][m][n] = __builtin_amdgcn_mfma_f32_16x16x32_bf16(Bt[n][k], At[m][k], acc[ai][bj][m][n], 0, 0, 0); __builtin_amdgcn_s_setprio(0); } while (0)
#define PG8_WAIT_V(n) asm volatile("s_waitcnt vmcnt(" #n ")" ::: "memory")
#define PG8_WAIT_L(n) asm volatile("s_waitcnt lgkmcnt(" #n ")" ::: "memory")
#define PG8_BAR __builtin_amdgcn_s_barrier()
#define PG8_SCHED __builtin_amdgcn_sched_barrier(0)
    Unit cur, nxt; int ui = 0;
    if (!S.next(0, cur)) return;
    f32x4 acc[2][2][4][2];
    if constexpr (Epi::INIT) E.init(acc, cur, wr, wc, fr, fq);
    else {
#pragma unroll
    for (int a = 0; a < 2; ++a)
#pragma unroll
        for (int b = 0; b < 2; ++b)
#pragma unroll
            for (int m = 0; m < 4; ++m)
#pragma unroll
                for (int n = 0; n < 2; ++n) acc[a][b][m][n] = (f32x4){0.f, 0.f, 0.f, 0.f};
    }
    bf16x8 At[4][2], B0[2][2], B1[2][2];
    const char* cA = cur.A; const char* cB = cur.B;
    PG8_STAGE(PG8_SB(0, 0), cB, voffB); PG8_STAGE(PG8_SA(0, 0), cA, voffA); PG8_STAGE(PG8_SB(0, 1), cB + hstepB, voffB); PG8_STAGE(PG8_SA(0, 1), cA + hstepA, voffA);
    if (wr == 1) PG8_BAR;
    PG8_WAIT_V(4); PG8_BAR;
    PG8_STAGE(PG8_SB(1, 0), cB + kstepB, voffB); PG8_STAGE(PG8_SA(1, 0), cA + kstepA, voffA); PG8_STAGE(PG8_SB(1, 1), cB + hstepB + kstepB, voffB);
    if constexpr (Epi::INIT) __builtin_amdgcn_s_waitcnt(0x0F76);
    else PG8_WAIT_V(6);
    PG8_BAR;
    for (;;) {
        const bool has_next = S.next(ui + 1, nxt);
        const char* nA = has_next ? nxt.A : cA; const char* nB = has_next ? nxt.B : cB;
        for (int t = 0; t < nt; t += 2) {
            const bool last = (t == nt - 2);
            const char* a1 = cA + (size_t)(t + 1) * kstepA;
            const char* a2 = last ? nA : cA + (size_t)(t + 2) * kstepA; const char* b2 = last ? nB : cB + (size_t)(t + 2) * kstepB;
            const char* a3 = a2 + kstepA; const char* b3 = b2 + kstepB;
            PG8_LDB(B0, 0, 0); PG8_SCHED; PG8_LDA(At, 0, 0); PG8_STAGE(PG8_SA(1, 1), a1 + hstepA, voffA);
            PG8_WAIT_L(8); PG8_BAR; PG8_WAIT_L(0); PG8_MMA(0, 0, At, B0); PG8_BAR; PG8_SCHED;
            PG8_LDB(B1, 0, 1); PG8_STAGE(PG8_SB(0, 0), b2, voffB);
            PG8_BAR; PG8_WAIT_L(0); PG8_MMA(0, 1, At, B1); PG8_BAR;
            PG8_LDA(At, 0, 1); PG8_STAGE(PG8_SA(0, 0), a2, voffA);
            PG8_BAR; PG8_WAIT_L(0); PG8_MMA(1, 0, At, B0); PG8_BAR; PG8_SCHED;
            PG8_STAGE(PG8_SB(0, 1), b2 + hstepB, voffB);
            PG8_WAIT_V(6); PG8_BAR; PG8_MMA(1, 1, At, B1); PG8_BAR;
            PG8_LDB(B0, 1, 0); PG8_SCHED; PG8_LDA(At, 1, 0); PG8_STAGE(PG8_SA(0, 1), a2 + hstepA, voffA);
            PG8_WAIT_L(8); PG8_BAR; PG8_WAIT_L(0); PG8_MMA(0, 0, At, B0); PG8_BAR; PG8_SCHED;
            PG8_LDB(B1, 1, 1); PG8_STAGE(PG8_SB(1, 0), b3, voffB);
            PG8_BAR; PG8_WAIT_L(0); PG8_MMA(0, 1, At, B1); PG8_BAR;
            PG8_LDA(At, 1, 1); PG8_STAGE(PG8_SA(1, 0), a3, voffA);
            PG8_BAR; PG8_WAIT_L(0); PG8_MMA(1, 0, At, B0); PG8_BAR; PG8_SCHED;
            PG8_STAGE(PG8_SB(1, 1), b3 + hstepB, voffB);
            PG8_WAIT_V(6); PG8_BAR; PG8_MMA(1, 1, At, B1); PG8_BAR;
        }
        E(acc, cur, wr, wc, fr, fq);
        if (!has_next) break;
        if constexpr (Epi::INIT) { E.init(acc, nxt, wr, wc, fr, fq); __builtin_amdgcn_s_waitcnt(0x0070); }
        else {
#pragma unroll
        for (int a = 0; a < 2; ++a)
#pragma unroll
            for (int b = 0; b < 2; ++b)
#pragma unroll
                for (int m = 0; m < 4; ++m)
#pragma unroll
                    for (int n = 0; n < 2; ++n) acc[a][b][m][n] = (f32x4){0.f, 0.f, 0.f, 0.f};
        }
        cur = nxt; cA = nA; cB = nB; ++ui;
    }
    PG8_WAIT_V(0);
    if (wr == 0) PG8_BAR;
    PG8_BAR;
#undef PG8_SA
#undef PG8_SB
#undef PG8_STAGE
#undef PG8_LDA
#undef PG8_LDB
#undef PG8_MMA
#undef PG8_WAIT_V
#undef PG8_WAIT_L
#undef PG8_BAR
#undef PG8_SCHED
}
}

#define XB_TMO      128
#define XB_XCNT(j)  (256  + 64 * (j))
#define XB_XSUB(j)  (1280 + 64 * (j))
#define XB_XGEN(j)  (2304 + 64 * (j))
#define XB_TOP      3328
#define XB_TOPGEN   3392
#define XCD_BAR_WORDS 3456
#define XB_SPIN_CAP (1u << 18)
DI unsigned xb_ld(unsigned* p)              { return __hip_atomic_load(p, __ATOMIC_RELAXED, __HIP_MEMORY_SCOPE_AGENT); }
DI unsigned xb_add(unsigned* p, unsigned v) { return __hip_atomic_fetch_add(p, v, __ATOMIC_RELAXED, __HIP_MEMORY_SCOPE_AGENT); }
DI unsigned xb_xcc_id() { return (unsigned)__builtin_amdgcn_s_getreg((3 << 11) | 20) & 0xFu; }
#define XB_SPIN(cond, bar) do { unsigned _sp = 0; while (cond) { __builtin_amdgcn_s_sleep(1); \
    if ((++_sp & 255u) == 0u) { if (xb_ld(&(bar)[XB_TMO])) break; if (_sp > XB_SPIN_CAP) { atomicAdd(&(bar)[XB_TMO], 1u); break; } } } } while (0)
struct XcdBarrier { unsigned* bar; unsigned x; volatile LAS unsigned* st; };
DI XcdBarrier xcd_barrier_post(unsigned* bar, volatile LAS unsigned* st) {
    XcdBarrier b; b.bar = bar; b.x = xb_xcc_id(); b.st = st;
    if (threadIdx.x == 0) (void)xb_add(&bar[XB_XCNT(b.x)], 1u);
    return b;
}
DI void xcd_barrier_complete(unsigned* bar, unsigned x, unsigned& nloc, unsigned& nx) {
    const unsigned G = gridDim.x * gridDim.y * gridDim.z;
    unsigned sum, cnt, mine, sp = 0u;
    for (;;) {
        sum = 0u; cnt = 0u; mine = 0u;
#pragma unroll
        for (unsigned j = 0; j < 16; ++j) { const unsigned c = xb_ld(&bar[XB_XCNT(j)]); sum += c; cnt += (c > 0u) ? 1u : 0u; mine = (j == x) ? c : mine; }
        if (sum == G) break;
        __builtin_amdgcn_s_sleep(1);
        if ((++sp & 255u) == 0u) { if (xb_ld(&bar[XB_TMO])) break; if (sp > XB_SPIN_CAP) { atomicAdd(&bar[XB_TMO], 1u); break; } }
    }
    nloc = mine > 0u ? mine : 1u; nx = cnt > 0u ? cnt : 1u;
}
DI void xcd_barrier(const XcdBarrier& b) {
    asm volatile("s_waitcnt vmcnt(0)" ::: "memory");
    __syncthreads();
    if (threadIdx.x == 0) {
        unsigned* bar = b.bar;
        __builtin_amdgcn_s_waitcnt(0);
        unsigned nloc = b.st[0], nx = b.st[1];
        if (nloc == 0u) { xcd_barrier_complete(bar, b.x, nloc, nx); b.st[0] = nloc; b.st[1] = nx; }
        const unsigned old = xb_add(&bar[XB_XSUB(b.x)], 1u);
        const unsigned gen = old / nloc;
        if (old + 1u == (gen + 1u) * nloc) {
            __builtin_amdgcn_fence(__ATOMIC_RELEASE, "agent");
            asm volatile("s_waitcnt vmcnt(0)" ::: "memory");
            const unsigned og = xb_add(&bar[XB_TOP], 1u);
            const unsigned tg = og / nx;
            if (og + 1u == (tg + 1u) * nx) xb_add(&bar[XB_TOPGEN], 1u);
            else XB_SPIN(xb_ld(&bar[XB_TOPGEN]) == tg, bar);
            __builtin_amdgcn_fence(__ATOMIC_ACQUIRE, "agent");
            xb_add(&bar[XB_XGEN(b.x)], 1u);
            asm volatile("s_waitcnt vmcnt(0)" ::: "memory");
        } else {
            XB_SPIN(xb_ld(&bar[XB_XGEN(b.x)]) == gen, bar);
            __builtin_amdgcn_fence(__ATOMIC_ACQUIRE, "agent");
            asm volatile("s_waitcnt vmcnt(0)" ::: "memory");
        }
    }
    __syncthreads();
}

struct P { const void* in[26]; float* out; unsigned char* ws; };
struct Frame { LAS unsigned char* lds; int tid, lane, wave, bid, G, gw, ngw; };
#define MFMA32(a, b, c) __builtin_amdgcn_mfma_f32_32x32x16_bf16((a), (b), (c), 0, 0, 0)
#define MFMA16(a, b, c) __builtin_amdgcn_mfma_f32_16x16x32_bf16((a), (b), (c), 0, 0, 0)
DI int crow(int reg, int h) { return (reg & 3) + 8 * (reg >> 2) + 4 * h; }
DI u32x2 pack4(f32x4 v) { u32x2 w; w.x = pk2(v[0], v[1]); w.y = pk2(v[2], v[3]); return w; }

DI void tr_item(const float* W, int K, int N, int ldw, bf16* WT, int dst_row0, LAS float* scr, int k0, int n0, int lane) {
    const int nn = n0 + (lane & 31); const bool ok = nn < N;
    float tv[32];
#pragma unroll
    for (int i = 0; i < 32; ++i) tv[i] = ok ? W[(size_t)(k0 + 2 * i + (lane >> 5)) * ldw + nn] : 0.f;
#pragma unroll
    for (int i = 0; i < 32; ++i) scr[(2 * i + (lane >> 5)) * 33 + (lane & 31)] = tv[i];
    LDS_WAIT();
    const int c = lane & 7;
#pragma unroll
    for (int j = 0; j < 4; ++j) { const int n = (lane >> 3) + 8 * j; const LAS float* s = scr + (8 * c) * 33 + n;
        u32x4 o; o.x = pk2(s[0 * 33], s[1 * 33]); o.y = pk2(s[2 * 33], s[3 * 33]); o.z = pk2(s[4 * 33], s[5 * 33]); o.w = pk2(s[6 * 33], s[7 * 33]);
        *(u32x4*)(WT + (size_t)(dst_row0 + n) * K + k0 + 8 * c) = o; }
    LDS_WAIT();
}
DI void p0_weights(const P& p, const Frame& F, int which) {
    LAS float* scr = (LAS float*)(F.lds + F.wave * 16384);
    constexpr int C_GIN = 16 * (GINP / 32), C_SQ = 16 * 32, C_NIN = 16 * (NINP / 32), C_FIN = 16 * (FF2 / 32), C_FOUT = (FF / 64) * 32, C_C1 = 16 * 8;
    constexpr int TOT = 2 * C_GIN + 2 * C_SQ + 2 * C_NIN + 2 * C_SQ + 4 * C_FIN + 4 * C_FOUT + 8 * C_C1;
    for (int it = F.gw; it < TOT; it += F.ngw) {
        int r = it; const float* W; int K = DM, N, Npad, ldw; bf16* WT; int mode = 0, rowoff = 0;
        bool l0 = false;
        if (r < 2 * C_GIN) { const int li = r / C_GIN; r -= li * C_GIN; l0 = li == 0; W = (const float*)p.in[10] + (size_t)li * DM * GIN; N = GIN; Npad = GINP; ldw = GIN; WT = (bf16*)(p.ws + WS_WG_IN + li * SZ_WG_IN); }
        else if ((r -= 2 * C_GIN) < 2 * C_SQ) { const int li = r / C_SQ; r -= li * C_SQ; l0 = li == 0; W = (const float*)p.in[15] + (size_t)li * DM * DM; N = DM; Npad = DM; ldw = DM; WT = (bf16*)(p.ws + WS_WG_OUT + li * SZ_W1K); }
        else if ((r -= 2 * C_SQ) < 2 * C_NIN) { const int li = r / C_NIN; r -= li * C_NIN; W = (const float*)p.in[16] + (size_t)li * DM * NIN; N = NIN; Npad = NINP; ldw = NIN; WT = (bf16*)(p.ws + WS_WN_IN + li * SZ_WN_IN); }
        else if ((r -= 2 * C_NIN) < 2 * C_SQ) { const int li = r / C_SQ; r -= li * C_SQ; W = (const float*)p.in[23] + (size_t)li * DM * DM; N = DM; Npad = DM; ldw = DM; WT = (bf16*)(p.ws + WS_WN_OUT + li * SZ_W1K); }
        else if ((r -= 2 * C_SQ) < 4 * C_FIN) { const int i = r / C_FIN; r -= i * C_FIN; l0 = i == 0; W = (const float*)p.in[24] + (size_t)i * DM * FF2; N = FF2; Npad = FF2; ldw = FF2; WT = (bf16*)(p.ws + WS_WF_IN + i * SZ_WF_IN); mode = 1; }
        else if ((r -= 4 * C_FIN) < 4 * C_FOUT) { const int i = r / C_FOUT; r -= i * C_FOUT; l0 = i == 0; W = (const float*)p.in[25] + (size_t)i * FF * DM; K = FF; N = DM; Npad = DM; ldw = DM; WT = (bf16*)(p.ws + WS_WF_OUT + i * SZ_WF_OUT); }
        else { r -= 4 * C_FOUT; const int id = r / C_C1; r -= id * C_C1; const int li = id >> 2, kv = (id >> 1) & 1, half = id & 1;
            W = (const float*)(kv ? p.in[21] : p.in[19]) + (size_t)li * 2048 * 256 + (size_t)half * 1024 * 256; N = 256; Npad = 256; ldw = 256; WT = (bf16*)(p.ws + WS_WC1 + (li * 2 + kv) * SZ_WC1); rowoff = half * 256; }
        if (l0 != (which == 0)) continue;
        const int nblk = Npad / 32, kb = r / nblk, nb = r % nblk, n0 = nb * 32;
        int drow = n0 + rowoff;
        if (mode == 1) { const int j = n0 < FF ? n0 : n0 - FF; drow = 256 * (j >> 7) + (j & 127) + (n0 < FF ? 0 : 128); }
        tr_item(W, K, N, ldw, WT, drow, scr, kb * 64, n0, F.lane);
    }
}
DI void p0_cbias(const P& p, const Frame& F) {
    LAS float* red = (LAS float*)F.lds;
    float* part = (float*)(p.ws + WS_PC_P);
    for (int t = F.bid; t < 256; t += F.G) {
        const int id = t >> 6, sl = t & 63, li = id >> 1, kv = id & 1, c = F.tid & 255, half = F.tid >> 8;
        const float* w1 = (const float*)(kv ? p.in[21] : p.in[19]) + (size_t)li * 2048 * 256; const float* pe = (const float*)(kv ? p.in[18] : p.in[17]) + (size_t)li * 2048;
        const int k0 = sl * 32 + half * 16; float acc = 0.f;
#pragma unroll
        for (int kk = 0; kk < 16; ++kk) acc += pe[k0 + kk] * w1[(size_t)(k0 + kk) * 256 + c];
        red[F.tid] = acc; __syncthreads();
        if (F.tid < 256) part[(size_t)t * 256 + c] = red[F.tid] + red[F.tid + 256];
        __syncthreads();
    }
}
DI void p0_cbias2(const P& p, const Frame& F) {
    const float* part = (const float*)(p.ws + WS_PC_P);
    for (int id = F.bid; id < 4; id += F.G) if (F.tid < 256) { float acc = 0.f;
#pragma unroll 16
        for (int sl = 0; sl < 64; ++sl) acc += part[(size_t)(id * 64 + sl) * 256 + F.tid];
        ((float*)(p.ws + WS_CBIAS))[id * 256 + F.tid] = acc; }
}
DI void cache_kv_item(const P& p, int li, int id, int lane, int phys_in = -1) {
    const int* pt = (const int*)p.in[6];
    bf16* cmps = (bf16*)(p.ws + WS_CMPS + li * SZ_CMPS); bf16* kslc = (bf16*)(p.ws + WS_KSLC_S + li * SZ_SLC_S); bf16* vslc = (bf16*)(p.ws + WS_VSLCT_S + li * SZ_SLC_S);
    const int b = id >> 8, pg = (id >> 4) & 15, s8 = id & 15;
    const int phys = phys_in >= 0 ? phys_in : pt[b * NPAGE + pg];
    const float* src = (const float*)p.in[2] + (((size_t)li * NPHYS + phys) * PAGE + s8 * 8) * 512;
    f32x4 a[8], c[8];
#pragma unroll
    for (int rr = 0; rr < 8; ++rr) { a[rr] = *(const f32x4*)(src + (size_t)rr * 512 + lane * 4); c[rr] = *(const f32x4*)(src + (size_t)rr * 512 + 256 + lane * 4); }
    const int kind = lane >> 5, g = (lane >> 4) & 1, d = (lane & 15) * 4;
    bf16* dst2 = (kind ? vslc : kslc) + (size_t)(b * 2 + g) * SLC_S_ROWS * 64 + d;
#pragma unroll
    for (int rr = 0; rr < 8; ++rr) { const int pos = pg * PAGE + s8 * 8 + rr;
        *(u32x2*)(cmps + ((size_t)b * PAST + pos) * 256 + lane * 4) = pack4(a[rr]);
        *(u32x2*)(dst2 + (size_t)pos * 64) = pack4(c[rr]); }
}
DI void p0_cache_win(const P& p, const Frame& F, int li) {
    bf16* kwin = (bf16*)(p.ws + WS_KWIN_S + li * SZ_WIN_S); bf16* vwin = (bf16*)(p.ws + WS_VWINT_S + li * SZ_WIN_S);
    for (int id = F.gw; id < DB * 64; id += F.ngw) {
        const int b = id >> 6, r8 = id & 63;
        const float* src = (const float*)p.in[3] + (((size_t)li * DB + b) * 512 + r8 * 8) * 256;
        float* outw = p.out + O_WINS + (size_t)(li * DB + b) * 512 * 256;
        f32x4 a[8];
#pragma unroll
        for (int rr = 0; rr < 8; ++rr) a[rr] = *(const f32x4*)(src + (size_t)rr * 256 + F.lane * 4);
        const int kind = F.lane >> 5, g = (F.lane >> 4) & 1, d = (F.lane & 15) * 4;
        bf16* dst2 = (kind ? vwin : kwin) + (size_t)(b * 2 + g) * WIN_S_ROWS * 64 + d;
#pragma unroll
        for (int rr = 0; rr < 8; ++rr) { const int idx = r8 * 8 + rr;
            if (idx >= 8) *(f32x4*)(outw + (size_t)(idx - 8) * 256 + F.lane * 4) = a[rr];
            *(u32x2*)(dst2 + (size_t)idx * 64) = pack4(a[rr]); }
    }
}
template <int MODE> DI void rms_phase(const P& p, const Frame& F, const float* w) {
    float* X = (float*)(p.ws + WS_X); bf16* XN = (bf16*)(p.ws + WS_XN);
    f32x4 wv[4];
#pragma unroll
    for (int j = 0; j < 4; ++j) wv[j] = ((const f32x4*)w)[F.lane + 64 * j];
    for (int row = F.gw; row < M; row += F.ngw) {
        const float* src = MODE == 0 ? (row < MP ? (const float*)p.in[0] + (size_t)row * DM : (const float*)p.in[1] + (size_t)(row - MP) * DM) : X + (size_t)row * DM;
        f32x4 v[4]; float ss = 0.f;
#pragma unroll
        for (int j = 0; j < 4; ++j) { v[j] = ((const f32x4*)src)[F.lane + 64 * j]; ss += (v[j][0] * v[j][0] + v[j][1] * v[j][1]) + (v[j][2] * v[j][2] + v[j][3] * v[j][3]); }
        const float rstd = __builtin_amdgcn_rsqf(wave_sum(ss) * (1.f / DM) + 1e-6f);
#pragma unroll
        for (int j = 0; j < 4; ++j) { const f32x4 o = v[j] * rstd * wv[j];
            if (MODE == 2) ((f32x4*)(p.out + O_Y + (size_t)row * DM))[F.lane + 64 * j] = o;
            else ((u32x2*)(XN + (size_t)row * DM))[F.lane + 64 * j] = pack4(o);
            if (MODE == 0) ((f32x4*)(X + (size_t)row * DM))[F.lane + 64 * j] = v[j]; }
    }
}

DI void gdn_prep(const P& p, const Frame& F, int li) {
    const bf16* H = (const bf16*)(p.ws + WS_H);
    bf16* QH = (bf16*)(p.ws + WS_QH); bf16* KH = (bf16*)(p.ws + WS_KH); bf16* VH = (bf16*)(p.ws + WS_VH);
    float* BETA = (float*)(p.ws + WS_BETA); float* LOGA = (float*)(p.ws + WS_LOGA);
    const float* cw = (const float*)p.in[11] + (size_t)li * 4 * GQKV;
    const float* cbuf = (const float*)p.in[5] + (size_t)li * DB * 3 * GQKV;
    const float* Alog = (const float*)p.in[12] + li * 8; const float* dtb = (const float*)p.in[13] + li * 8;
    LAS float* wl = (LAS float*)F.lds;
    for (int i = F.tid; i < 4 * GQKV / 4; i += 512) ((LAS f32x4*)wl)[i] = ((const f32x4*)cw)[i];
    __syncthreads();
    for (int row = F.gw; row < M; row += F.ngw) {
        int b, t; const bool smp = row >= MP;
        if (!smp) { b = row >> 12; t = row & 4095; } else { b = (row - MP) >> 3; t = (row - MP) & 7; }
        u32x4 xr[4][6];
#pragma unroll
        for (int k = 0; k < 4; ++k) { const int tt = t - 3 + k;
#pragma unroll
            for (int cc = 0; cc < 6; ++cc) { const int c = (cc >> 1) * 1024 + ((cc & 1) * 64 + F.lane) * 8;
                if (tt >= 0) xr[k][cc] = *(const u32x4*)(H + (size_t)(row - 3 + k) * GINP + c);
                else if (smp) { const float* s = cbuf + ((size_t)b * 3 + (3 + tt)) * GQKV + c; const f32x4 v0 = *(const f32x4*)s, v1 = *(const f32x4*)(s + 4);
                    xr[k][cc] = (u32x4){pk2(v0[0], v0[1]), pk2(v0[2], v0[3]), pk2(v1[0], v1[1]), pk2(v1[2], v1[3])}; }
                else xr[k][cc] = (u32x4){0u, 0u, 0u, 0u}; } }
#pragma unroll
        for (int part = 0; part < 3; ++part) {
            asm volatile("" ::: "memory");
            float y[2][8]; float ss[2];
#pragma unroll
            for (int k2 = 0; k2 < 2; ++k2) { const int cc = part * 2 + k2, c = part * 1024 + (k2 * 64 + F.lane) * 8;
#pragma unroll
                for (int e = 0; e < 8; ++e) y[k2][e] = 0.f;
#pragma unroll
                for (int k = 0; k < 4; ++k) { const f32x4 w0 = *(const LAS f32x4*)(wl + k * GQKV + c), w1 = *(const LAS f32x4*)(wl + k * GQKV + c + 4); const u32x4 x = xr[k][cc];
                    y[k2][0] += w0[0] * bflo(x.x); y[k2][1] += w0[1] * bfhi(x.x); y[k2][2] += w0[2] * bflo(x.y); y[k2][3] += w0[3] * bfhi(x.y);
                    y[k2][4] += w1[0] * bflo(x.z); y[k2][5] += w1[1] * bfhi(x.z); y[k2][6] += w1[2] * bflo(x.w); y[k2][7] += w1[3] * bfhi(x.w); }
                float s2 = 0.f;
#pragma unroll
                for (int e = 0; e < 8; ++e) { y[k2][e] = siluf_(y[k2][e]); s2 += y[k2][e] * y[k2][e]; }
                s2 = sum16(s2);
                ss[k2] = s2;
                const int jo = smp ? t - (DS - 3) : t - (SEQ - 3);
                if (jo >= 0) { float* o = p.out + (smp ? O_GCS + ((size_t)(li * DB + b) * 3 + jo) * GQKV : O_GCP + ((size_t)(li * NB + b) * 3 + jo) * GQKV) + c; const u32x4 x = xr[3][cc];
                    *(f32x4*)o = (f32x4){bflo(x.x), bfhi(x.x), bflo(x.y), bfhi(x.y)}; *(f32x4*)(o + 4) = (f32x4){bflo(x.z), bfhi(x.z), bflo(x.w), bfhi(x.w)}; }
            }
            bf16* dst = part == 0 ? QH : (part == 1 ? KH : VH);
#pragma unroll
            for (int k2 = 0; k2 < 2; ++k2) { const float sc = part == 0 ? __builtin_amdgcn_rsqf(ss[k2] + 1e-6f) * 0.08838834764831845f : (part == 1 ? __builtin_amdgcn_rsqf(ss[k2] + 1e-6f) : 1.f);
                *(u32x4*)(dst + (size_t)row * DM + (k2 * 64 + F.lane) * 8) = (u32x4){pk2(y[k2][0] * sc, y[k2][1] * sc), pk2(y[k2][2] * sc, y[k2][3] * sc), pk2(y[k2][4] * sc, y[k2][5] * sc), pk2(y[k2][6] * sc, y[k2][7] * sc)}; }
        }
        if (F.lane < 8) { const int hh = F.lane;
            const float bb = bf2f(H[(size_t)row * GINP + 4096 + hh]), aa = bf2f(H[(size_t)row * GINP + 4104 + hh]) + dtb[hh];
            const float sp = aa > 20.f ? aa : log1pf(__expf(aa));
            BETA[(size_t)row * 8 + hh] = sigmoidf_(bb); LOGA[(size_t)row * 8 + hh] = -__expf(Alog[hh]) * sp; }
    }
}
DI void gdn_chunk(const P& p, const Frame& F, int li) {
    const bf16* QH = (const bf16*)(p.ws + WS_QH); const bf16* KH = (const bf16*)(p.ws + WS_KH); const bf16* VH = (const bf16*)(p.ws + WS_VH);
    const float* BETA = (const float*)(p.ws + WS_BETA); const float* LOGA = (const float*)(p.ws + WS_LOGA);
    bf16* CW = (bf16*)(p.ws + WS_CW); float* CUT = (float*)(p.ws + WS_CUT); bf16* CAQK = (bf16*)(p.ws + WS_CAQK); bf16* CQT = (bf16*)(p.ws + WS_CQT); bf16* CKTT = (bf16*)(p.ws + WS_CKTT); float* CEGL = (float*)(p.ws + WS_CEGL);
    LAS float* Gs = (LAS float*)F.lds; LAS float* bs = Gs + 64; LAS float* Lm = Gs + 128;
    for (int task = F.bid; task < NCHUNK; task += F.G) {
        const int b = task >> 9, hh = (task >> 6) & 7, c = task & 63, r0 = b * SEQ + c * 64;
        if (F.wave == 0) { float la = LOGA[(size_t)(r0 + F.lane) * 8 + hh];
#pragma unroll
            for (int o = 1; o < 64; o <<= 1) { const float tq = __shfl_up(la, o); if (F.lane >= o) la += tq; }
            const float bt = BETA[(size_t)(r0 + F.lane) * 8 + hh]; Gs[F.lane] = la; bs[F.lane] = bt; Gs[64 * 66 + F.lane] = bt * __expf(la); }
        __syncthreads();
        { const int which = F.wave >> 2, ti = (F.wave >> 1) & 1, tj = F.wave & 1, r = F.lane & 31, h = F.lane >> 5;
          const bf16* Ar = (which ? QH : KH) + (size_t)(r0 + 32 * ti + r) * DM + hh * 128 + 8 * h;
          const bf16* Br = KH + (size_t)(r0 + 32 * tj + r) * DM + hh * 128 + 8 * h;
          f32x16 cc; for (int e = 0; e < 16; ++e) cc[e] = 0.f;
#pragma unroll
          for (int ks = 0; ks < 8; ++ks) cc = MFMA32(*(const bf16x8*)(Ar + 16 * ks), *(const bf16x8*)(Br + 16 * ks), cc);
          const int j = 32 * tj + r; const float Gj = Gs[j];
#pragma unroll
          for (int reg = 0; reg < 16; ++reg) { const int i = 32 * ti + crow(reg, h); const float dec = (j <= i) ? __expf(Gs[i] - Gj) : 0.f;
              if (which == 0) Lm[i * 64 + j] = (j < i) ? bs[i] * cc[reg] * dec : 0.f;
              else CAQK[(size_t)task * 4096 + i * 64 + j] = (bf16)f2bf(cc[reg] * dec); } }
        __syncthreads();
        if (F.tid < 256) {
            const int col = F.tid; const bool isk = col < 128;
            const bf16* src = (isk ? KH : VH) + (size_t)r0 * DM + hh * 128 + (col & 127);
            const LAS float* sc2 = isk ? (Gs + 64 * 66) : bs;
            float x[64];
#pragma unroll
            for (int i = 0; i < 64; ++i) x[i] = bf2f(src[(size_t)i * DM]);
            asm volatile("" ::: "memory");
#pragma unroll
            for (int i = 0; i < 64; ++i) { float acc = x[i] * sc2[i];
#pragma unroll
                for (int j4 = 0; j4 < (i + 3) / 4; ++j4) { const f32x4 L4 = *(const LAS f32x4*)(Lm + i * 64 + 4 * j4);
                    acc -= L4[0] * x[4 * j4] + L4[1] * x[4 * j4 + 1] + L4[2] * x[4 * j4 + 2] + L4[3] * x[4 * j4 + 3]; }
                x[i] = acc; if ((i & 3) == 3) asm volatile("" ::: "memory"); }
            if (isk) {
#pragma unroll
                for (int i = 0; i < 64; ++i) CW[(size_t)task * 8192 + i * 128 + col] = (bf16)f2bf(x[i]); }
            else { float* d = CUT + ((size_t)task * 128 + (col - 128)) * 64;
#pragma unroll
                for (int i4 = 0; i4 < 16; ++i4) *(f32x4*)(d + 4 * i4) = (f32x4){x[4 * i4], x[4 * i4 + 1], x[4 * i4 + 2], x[4 * i4 + 3]}; }
        } else {
            const int t2 = F.tid - 256, dk = t2 & 127, half = t2 >> 7;
            { const bf16* sp = (half == 0 ? QH : KH) + (size_t)r0 * DM + hh * 128 + dk; const float Gl = Gs[63];
#pragma unroll
              for (int hb = 0; hb < 2; ++hb) { bf16 raw[32];
#pragma unroll
                for (int i = 0; i < 32; ++i) raw[i] = sp[(size_t)(32 * hb + i) * DM];
                if (half == 0) {
#pragma unroll
                    for (int i = 0; i < 32; ++i) CQT[(size_t)task * 8192 + (32 * hb + i) * 128 + dk] = (bf16)f2bf(__expf(Gs[32 * hb + i]) * bf2f(raw[i]));
                } else {
#pragma unroll
                    for (int i8 = 0; i8 < 4; ++i8) { float v[8];
#pragma unroll
                        for (int e = 0; e < 8; ++e) v[e] = bf2f(raw[8 * i8 + e]) * __expf(Gl - Gs[32 * hb + 8 * i8 + e]);
                        *(u32x4*)(CKTT + ((size_t)task * 128 + dk) * 64 + 32 * hb + 8 * i8) = (u32x4){pk2(v[0], v[1]), pk2(v[2], v[3]), pk2(v[4], v[5]), pk2(v[6], v[7])}; } }
                asm volatile("" ::: "memory"); } }
            if (t2 == 0) CEGL[task] = __expf(Gs[63]);
{ const int id0 = (task * 4 + (F.wave - 4)) * 4; const int ph = ((const int*)p.in[6])[(id0 >> 8) * NPAGE + ((id0 >> 4) & 15)];
#pragma unroll 1
            for (int k = 0; k < 4; ++k) cache_kv_item(p, li, id0 + k, F.lane, ph); }
        }
        __syncthreads();
    }
}
DI int sw16(int row, int ch) { return row * 256 + ((ch ^ (row & 15)) << 4); }
DI int sw8(int row, int ch) { return row * 128 + ((ch ^ ((row >> 1) & 7)) << 4); }
DI void gdn_scan(const P& p, const Frame& F, int li, int sid) {
    const bf16* CW = (const bf16*)(p.ws + WS_CW); const float* CUT = (const float*)(p.ws + WS_CUT); const bf16* CAQK = (const bf16*)(p.ws + WS_CAQK); const bf16* CQT = (const bf16*)(p.ws + WS_CQT); const bf16* CKTT = (const bf16*)(p.ws + WS_CKTT); const float* CEGL = (const float*)(p.ws + WS_CEGL);
    float* OG = (float*)(p.ws + WS_OG);
    constexpr int SBUF = 57344;
    LAS bf16* St = (LAS bf16*)(F.lds + ((F.wave & 3) < 2 ? 2 * SBUF + (F.wave & 3) * 6656 : PTAB_OFF + 256 + ((F.wave & 3) - 2) * 6656)); LAS bf16* uT = St + 16 * 136;
    const int a16 = F.lane & 15, kg = F.lane >> 4, sl = (sid & 1) * 4 + (F.wave & 3), b = sid >> 4, hh = (sid >> 1) & 7; const bool cwv = F.wave < 4;
    sid >>= 1;
    int so[4];
    { const int q0 = F.tid, q1 = F.tid + 512;
      so[0] = (q0 >> 4) * 128 + (((q0 & 15) ^ ((q0 >> 4) & 15)) << 3); so[1] = (q1 >> 4) * 128 + (((q1 & 15) ^ ((q1 >> 4) & 15)) << 3);
      so[2] = (q0 >> 3) * 64 + (((q0 & 7) ^ ((q0 >> 4) & 7)) << 3); so[3] = (q1 >> 3) * 64 + (((q1 & 7) ^ ((q1 >> 4) & 7)) << 3); }
    const unsigned wbase = (unsigned)F.wave * 1024u;
    f32x4 utn[4]; float egn;
#define SCAN_G2L(srcp, off) __builtin_amdgcn_global_load_lds((const unsigned*)(srcp), (LAS unsigned*)(F.lds + (off) + wbase), 16, 0, 0)
#define SCAN_DMA(c_, buf_) do { const size_t task_ = (size_t)sid * 64 + (c_); const int bo_ = (buf_) * SBUF; \
        SCAN_G2L(CW + task_ * 8192 + so[0], bo_); SCAN_G2L(CW + task_ * 8192 + so[1], bo_ + 8192); \
        SCAN_G2L(CQT + task_ * 8192 + so[0], bo_ + 16384); SCAN_G2L(CQT + task_ * 8192 + so[1], bo_ + 16384 + 8192); \
        SCAN_G2L(CKTT + task_ * 8192 + so[2], bo_ + 32768); SCAN_G2L(CKTT + task_ * 8192 + so[3], bo_ + 32768 + 8192); \
        SCAN_G2L(CAQK + task_ * 4096 + so[2], bo_ + 49152); } while (0)
#define SCAN_UT(c_) do { const size_t task_ = (size_t)sid * 64 + (c_); \
        _Pragma("unroll") for (int mt = 0; mt < 4; ++mt) utn[mt] = *(const f32x4*)(CUT + task_ * 8192 + (16 * sl + a16) * 64 + 16 * mt + 4 * kg); \
        egn = CEGL[task_]; } while (0)
    f32x4 S[8];
#pragma unroll
    for (int m = 0; m < 8; ++m) { S[m] = (f32x4){0.f, 0.f, 0.f, 0.f}; if (cwv) *(LAS u32x2*)(St + a16 * 136 + 16 * m + 4 * kg) = (u32x2){0u, 0u}; }
    SCAN_DMA(0, 0);
    if (cwv) SCAN_UT(0);
    __builtin_amdgcn_s_waitcnt(0x0070);
    f32x4 ut[4]; float egl;
    if (!cwv) {
        for (int c = 0; c < 64; ++c) {
            asm volatile("" ::: "memory"); __builtin_amdgcn_s_waitcnt(0x0070); __builtin_amdgcn_s_barrier(); asm volatile("" ::: "memory");
            if (c + 1 < 64) SCAN_DMA(c + 1, (c + 1) & 1);
        }
    } else
    for (int c = 0; c < 64; ++c) {
        asm volatile("" ::: "memory"); __builtin_amdgcn_s_waitcnt(0x4070); __builtin_amdgcn_s_barrier(); asm volatile("" ::: "memory");
        if (c + 1 < 64) SCAN_DMA(c + 1, (c + 1) & 1);
        {
#pragma unroll
        for (int mt = 0; mt < 4; ++mt)
#pragma unroll
            for (int e = 0; e < 4; ++e) { float t_; asm volatile("v_mov_b32 %0, %1" : "=v"(t_) : "v"(utn[mt][e])); ut[mt][e] = t_; }
        { float t_; asm volatile("v_mov_b32 %0, %1" : "=v"(t_) : "v"(egn)); egl = t_; }
        if (c + 1 < 64) SCAN_UT(c + 1);
        LAS unsigned char* sW = F.lds + (c & 1) * SBUF; LAS unsigned char* sQ = sW + 16384; LAS unsigned char* sK = sW + 32768; LAS unsigned char* sA = sW + 49152;
        bf16x8 sb[4];
#pragma unroll
        for (int ks = 0; ks < 4; ++ks) sb[ks] = *(const LAS bf16x8*)(St + a16 * 136 + 32 * ks + 8 * kg);
        f32x4 u[4];
#pragma unroll
        for (int mt = 0; mt < 4; ++mt) { f32x4 acc = (f32x4){0.f, 0.f, 0.f, 0.f};
#pragma unroll
            for (int ks = 0; ks < 4; ++ks) acc = MFMA16(*(const LAS bf16x8*)(sW + sw16(16 * mt + a16, 4 * ks + kg)), sb[ks], acc);
            u[mt] = ut[mt] - acc; }
#pragma unroll
        for (int mt = 0; mt < 4; ++mt) *(LAS u32x2*)(uT + a16 * 72 + 16 * mt + 4 * kg) = pack4(u[mt]);
        bf16x8 ub[2];
#pragma unroll
        for (int k2 = 0; k2 < 2; ++k2) ub[k2] = *(const LAS bf16x8*)(uT + a16 * 72 + 32 * k2 + 8 * kg);
#pragma unroll
        for (int mt = 0; mt < 4; ++mt) { f32x4 acc = (f32x4){0.f, 0.f, 0.f, 0.f};
#pragma unroll
            for (int ks = 0; ks < 4; ++ks) acc = MFMA16(*(const LAS bf16x8*)(sQ + sw16(16 * mt + a16, 4 * ks + kg)), sb[ks], acc);
#pragma unroll
            for (int k2 = 0; k2 < 2; ++k2) acc = MFMA16(*(const LAS bf16x8*)(sA + sw8(16 * mt + a16, 4 * k2 + kg)), ub[k2], acc);
#pragma unroll
            for (int e = 0; e < 4; ++e) OG[(size_t)(b * SEQ + 64 * c + 16 * mt + 4 * kg + e) * DM + hh * 128 + 16 * sl + a16] = acc[e]; }
#pragma unroll
        for (int m = 0; m < 8; ++m) { f32x4 acc = S[m] * egl;
#pragma unroll
            for (int k2 = 0; k2 < 2; ++k2) acc = MFMA16(*(const LAS bf16x8*)(sK + sw8(16 * m + a16, 4 * k2 + kg)), ub[k2], acc);
            S[m] = acc; *(LAS u32x2*)(St + a16 * 136 + 16 * m + 4 * kg) = pack4(acc); }
        }
    }
#undef SCAN_DMA
#undef SCAN_UT
#undef SCAN_G2L
    asm volatile("s_waitcnt vmcnt(0) lgkmcnt(0)" ::: "memory"); __builtin_amdgcn_s_barrier(); asm volatile("" ::: "memory");
    float* gs = p.out + O_GSP + (size_t)((li * NB + b) * GH + hh) * 128 * 128;
    if (cwv)
#pragma unroll
    for (int m = 0; m < 8; ++m)
#pragma unroll
        for (int e = 0; e < 4; ++e) gs[(size_t)(16 * m + 4 * kg + e) * 128 + 16 * sl + a16] = S[m][e];
}
DI void gdn_sample(const P& p, const Frame& F, int li, int task) {
    const bf16* QH = (const bf16*)(p.ws + WS_QH); const bf16* KH = (const bf16*)(p.ws + WS_KH); const bf16* VH = (const bf16*)(p.ws + WS_VH);
    const float* BETA = (const float*)(p.ws + WS_BETA); const float* LOGA = (const float*)(p.ws + WS_LOGA); float* OG = (float*)(p.ws + WS_OG);
    LAS float* ks = (LAS float*)F.lds; LAS float* qs = ks + 1024; LAS float* vs = qs + 1024; LAS float* Gs = vs + 1024; LAS float* bs = Gs + 8; LAS float* KK = bs + 8; LAS float* QK = KK + 64; LAS float* red = QK + 64;
    const int b = task >> 3, hh = task & 7, rb = MP + b * 8;
#pragma unroll
    for (int e = 0; e < 6; ++e) { const int idx = F.tid + 512 * e, part = idx >> 10, i = (idx >> 7) & 7, d = idx & 127;
        const bf16* s = part == 0 ? KH : (part == 1 ? QH : VH);
        ks[idx] = bf2f(s[(size_t)(rb + i) * DM + hh * 128 + d]); }
    if (F.tid == 0) { float g = 0.f; for (int i = 0; i < 8; ++i) { g += LOGA[(size_t)(rb + i) * 8 + hh]; Gs[i] = g; bs[i] = BETA[(size_t)(rb + i) * 8 + hh]; } }
    __syncthreads();
    if (F.tid < 128) { const int which = F.tid >> 6, i = (F.tid >> 3) & 7, j = F.tid & 7; const LAS float* a = (which ? qs : ks) + i * 128; const LAS float* bb = ks + j * 128; float acc = 0.f;
        for (int d = 0; d < 128; ++d) acc += a[d] * bb[d];
        KK[which * 64 + i * 8 + j] = acc; }
    const int dv = F.tid & 127, qt = F.tid >> 7, dk0 = qt * 32;
    const float* st = (const float*)p.in[4] + ((size_t)((li * DB + b) * GH + hh) * 128 + dk0) * 128 + dv;
    float s0[32];
#pragma unroll
    for (int e = 0; e < 32; ++e) s0[e] = st[(size_t)e * 128];
    float pk[8], pq[8];
#pragma unroll
    for (int i = 0; i < 8; ++i) { pk[i] = 0.f; pq[i] = 0.f; }
#pragma unroll
    for (int e = 0; e < 32; ++e)
#pragma unroll
        for (int i = 0; i < 8; ++i) { pk[i] += ks[i * 128 + dk0 + e] * s0[e]; pq[i] += qs[i * 128 + dk0 + e] * s0[e]; }
#pragma unroll
    for (int i = 0; i < 8; ++i) { red[(qt * 16 + i) * 128 + dv] = pk[i]; red[(qt * 16 + 8 + i) * 128 + dv] = pq[i]; }
    __syncthreads();
    float u[8], eg[8];
#pragma unroll
    for (int i = 0; i < 8; ++i) { eg[i] = __expf(Gs[i]);
        const float kS = red[(0 * 16 + i) * 128 + dv] + red[(1 * 16 + i) * 128 + dv] + red[(2 * 16 + i) * 128 + dv] + red[(3 * 16 + i) * 128 + dv];
        float acc = bs[i] * (vs[i * 128 + dv] - eg[i] * kS);
#pragma unroll
        for (int j = 0; j < i; ++j) acc -= bs[i] * KK[i * 8 + j] * __expf(Gs[i] - Gs[j]) * u[j];
        u[i] = acc; }
    if (qt == 0) {
#pragma unroll
        for (int i = 0; i < 8; ++i) { const float qS = red[(0 * 16 + 8 + i) * 128 + dv] + red[(1 * 16 + 8 + i) * 128 + dv] + red[(2 * 16 + 8 + i) * 128 + dv] + red[(3 * 16 + 8 + i) * 128 + dv];
            float acc = eg[i] * qS;
#pragma unroll
            for (int j = 0; j <= i; ++j) acc += QK[i * 8 + j] * __expf(Gs[i] - Gs[j]) * u[j];
            OG[(size_t)(rb + i) * DM + hh * 128 + dv] = acc; } }
    float* so = p.out + O_GSS + ((size_t)((li * DB + b) * GH + hh) * 128 + dk0) * 128 + dv;
    float tl[8];
#pragma unroll
    for (int i = 0; i < 8; ++i) tl[i] = __expf(Gs[7] - Gs[i]) * u[i];
#pragma unroll
    for (int e = 0; e < 32; ++e) { float acc = eg[7] * s0[e];
#pragma unroll
        for (int i = 0; i < 8; ++i) acc += ks[i * 128 + dk0 + e] * tl[i];
        so[(size_t)e * 128] = acc; }
    __syncthreads();
}
DI void gdn_gate(const P& p, const Frame& F, int li) {
    const float* OG = (const float*)(p.ws + WS_OG); const bf16* H = (const bf16*)(p.ws + WS_H); bf16* AO = (bf16*)(p.ws + WS_AO);
    const f32x4 nw = *(const f32x4*)((const float*)p.in[14] + li * 128 + ((4 * F.lane) & 127));
    for (int row = F.gw; row < M; row += F.ngw) {
        f32x4 v[4]; u32x2 z[4];
#pragma unroll
        for (int k = 0; k < 4; ++k) { const int c = (k * 64 + F.lane) * 4; v[k] = *(const f32x4*)(OG + (size_t)row * DM + c); z[k] = *(const u32x2*)(H + (size_t)row * GINP + 3072 + c); }
#pragma unroll
        for (int k = 0; k < 4; ++k) { const int c = (k * 64 + F.lane) * 4;
            float s2 = (v[k][0] * v[k][0] + v[k][1] * v[k][1]) + (v[k][2] * v[k][2] + v[k][3] * v[k][3]);
            s2 = sum32(s2);
            const float rs = __builtin_amdgcn_rsqf(s2 * (1.f / 128.f) + 1e-6f);
            *(u32x2*)(AO + (size_t)row * DM + c) = (u32x2){pk2(v[k][0] * rs * nw[0] * siluf_(bflo(z[k].x)), v[k][1] * rs * nw[1] * siluf_(bfhi(z[k].x))), pk2(v[k][2] * rs * nw[2] * siluf_(bflo(z[k].y)), v[k][3] * rs * nw[3] * siluf_(bfhi(z[k].y)))}; }
    }
}

DI void nsa_transpose(const P& p, const Frame& F, int li) {
    const bf16* H = (const bf16*)(p.ws + WS_H);
    bf16* kslc = (bf16*)(p.ws + WS_KSLC_S + li * SZ_SLC_S); bf16* vslc = (bf16*)(p.ws + WS_VSLCT_S + li * SZ_SLC_S);
    bf16* kwin = (bf16*)(p.ws + WS_KWIN_S + li * SZ_WIN_S); bf16* vwin = (bf16*)(p.ws + WS_VWINT_S + li * SZ_WIN_S);
    for (int idx = F.gw * 64 + F.lane; idx < DB * DS * 512; idx += F.ngw * 64) {
        const int c = idx & 511, rs = idx >> 9, b = rs >> 3, t = rs & 7, kind = c >> 7, g = (c >> 6) & 1, d = c & 63;
        const bf16 v = H[(size_t)(MP + rs) * NINP + 1280 + c];
        if (kind == 0) kslc[((size_t)(b * 2 + g) * SLC_S_ROWS + PAST + t) * 64 + d] = v;
        else if (kind == 1) vslc[((size_t)(b * 2 + g) * SLC_S_ROWS + PAST + t) * 64 + d] = v;
        else if (kind == 2) kwin[((size_t)(b * 2 + g) * WIN_S_ROWS + 512 + t) * 64 + d] = v;
        else vwin[((size_t)(b * 2 + g) * WIN_S_ROWS + 512 + t) * 64 + d] = v;
    }
}
struct CmpOrder {
    int G, c, li; unsigned char* ws; int base, count;
    DI bool next(int i, pg8::Unit& u) const {
        const int L = base + i * G + c; if (i * G + c >= count) return false;
        if (L < 32) { u.z = L >> 3; u.pm = (L >> 1) & 3; u.pn = L & 1;
            u.A = (const char*)(ws + WS_CMPP) + ((size_t)u.pm * 256 * 4096 + (u.z >> 1) * 128 + (u.z & 1) * 64) * 2; u.C = (char*)(ws + WS_PC_P) + (size_t)u.z * 1024 * 512 * 2; }
        else { const int L2 = L - 32; u.z = L2 >> 7; u.pm = (L2 >> 1) & 63; u.pn = L2 & 1;
            u.A = (const char*)(ws + WS_CMPS + li * SZ_CMPS) + ((size_t)u.pm * 256 * 4096 + (u.z >> 1) * 128 + (u.z & 1) * 64) * 2; u.C = (char*)(ws + WS_PC_S) + (size_t)u.z * 16384 * 512 * 2; }
        u.B = (const char*)(ws + WS_WC1 + (li * 2 + (u.z >> 1)) * SZ_WC1) + (size_t)u.pn * 256 * 1024 * 2;
        return true;
    }
};
DI void nsa_cmp2(const P& p, const Frame& F, int li) {
    constexpr int WP = 264;
    LAS bf16* w2t = (LAS bf16*)F.lds;
    LAS bf16* hid = (LAS bf16*)(F.lds + 36864 + F.wave * 8704);
    const float* cb = (const float*)(p.ws + WS_CBIAS);
    constexpr int NH_P = NB * 2 * 16, NH_S = DB * 2 * 8, NH = NH_P + NH_S;
    const int a16 = F.lane & 15, kg = F.lane >> 4;
#pragma unroll 1
    for (int kv = 0; kv < 2; ++kv) {
        __syncthreads();
        { const float* w2g = (const float*)(kv ? p.in[22] : p.in[20]) + (size_t)li * 256 * 64;
          for (int i = F.tid; i < 256 * 64; i += 512) w2t[(i & 63) * WP + (i >> 6)] = (bf16)f2bf(w2g[i]); }
        __syncthreads();
        const f32x4 bv = *(const f32x4*)(cb + (li * 2 + kv) * 256 + 4 * F.lane);
        for (int id = F.gw; id < NH; id += F.ngw) {
            int b, n0, g, segs, npad, ncmp; const bf16* PC; bf16* DST;
            if (id < NH_P) { n0 = (id & 15) * 16; g = (id >> 4) & 1; b = id >> 5; segs = 256; npad = 256; ncmp = NCMP_P; PC = (const bf16*)(p.ws + WS_PC_P) + (size_t)(kv * 2 + g) * 1024 * 512; DST = (bf16*)(p.ws + (kv ? WS_VCT_P : WS_KC_P)); }
            else { const int i2 = id - NH_P; n0 = (i2 & 7) * 16; g = (i2 >> 3) & 1; b = i2 >> 4; segs = 128; npad = 128; ncmp = NCMP_S; PC = (const bf16*)(p.ws + WS_PC_S) + (size_t)(kv * 2 + g) * 16384 * 512; DST = (bf16*)(p.ws + (kv ? WS_VCT_S : WS_KC_S)); }
            const size_t ri = (size_t)b * segs + n0;
#pragma unroll
            for (int hb = 0; hb < 2; ++hb) { u32x2 a0[8], a1[8];
#pragma unroll
                for (int e = 0; e < 8; ++e) { const int n = 8 * hb + e; const bool ok = n0 + n < ncmp; a0[e] = ok ? *(const u32x2*)(PC + (ri + n) * 512 + 4 * F.lane) : (u32x2){0u, 0u}; a1[e] = ok ? *(const u32x2*)(PC + (ri + n + 1) * 512 + 256 + 4 * F.lane) : (u32x2){0u, 0u}; }
#pragma unroll
                for (int e = 0; e < 8; ++e) { const float h0 = siluf_(bflo(a0[e].x) + bflo(a1[e].x) + bv[0]), h1 = siluf_(bfhi(a0[e].x) + bfhi(a1[e].x) + bv[1]), h2 = siluf_(bflo(a0[e].y) + bflo(a1[e].y) + bv[2]), h3 = siluf_(bfhi(a0[e].y) + bfhi(a1[e].y) + bv[3]);
                    *(LAS u32x2*)(hid + (8 * hb + e) * WP + 4 * F.lane) = (u32x2){pk2(h0, h1), pk2(h2, h3)}; } }
            LDS_WAIT();
            f32x4 acc[4];
#pragma unroll
            for (int dt = 0; dt < 4; ++dt) acc[dt] = (f32x4){0.f, 0.f, 0.f, 0.f};
#pragma unroll
            for (int ks = 0; ks < 8; ++ks) { const bf16x8 af = *(const LAS bf16x8*)(hid + a16 * WP + 32 * ks + 8 * kg);
#pragma unroll
                for (int dt = 0; dt < 4; ++dt) acc[dt] = MFMA16(af, *(const LAS bf16x8*)(w2t + (16 * dt + a16) * WP + 32 * ks + 8 * kg), acc[dt]); }
#pragma unroll
            for (int dt = 0; dt < 4; ++dt)
#pragma unroll
                for (int e = 0; e < 4; ++e) { const int n = n0 + 4 * kg + e; if (n < ncmp) DST[((size_t)(b * 2 + g) * npad + n) * 64 + 16 * dt + a16] = (bf16)f2bf(acc[dt][e]); }
            LDS_WAIT();
        }
    }
}

struct AttnAcc { f32x16 o0, o1; float m, l; };
DI void attn_reset(AttnAcc& a) { for (int e = 0; e < 16; ++e) { a.o0[e] = 0.f; a.o1[e] = 0.f; } a.m = -__builtin_inff(); a.l = 0.f; }
constexpr float ATT_C = 1.0f;
constexpr float ATT_QS = 0.18033688011112042f;
DI f32x16 attn_scores(const LAS unsigned char* kt, int sb, const bf16x8 (&qf)[4], int r, int h) {
    f32x16 s; for (int e = 0; e < 16; ++e) s[e] = 0.f;
    const int row = 32 * sb + r, swz = (row >> 1) & 7; const LAS unsigned char* base = kt + row * 128;
#pragma unroll
    for (int st = 0; st < 4; ++st) s = MFMA32(*(const LAS bf16x8*)(base + (((2 * st + h) ^ swz) << 4)), qf[st], s);
    return s;
}
template <bool WIN> DI void attn_mask(f32x16& s, int hi) {
#pragma unroll
    for (int e = 0; e < 16; ++e) { const int ce = (e & 3) + 8 * (e >> 2); const bool v = WIN ? ((unsigned)(hi - ce) <= 512u) : (ce <= hi); s[e] = v ? s[e] : -__builtin_inff(); }
}
typedef short v4i16_t __attribute__((ext_vector_type(4)));
DI s16x4 vtr(const LAS unsigned char* p) { return __builtin_bit_cast(s16x4, __builtin_amdgcn_ds_read_tr16_b64_v4i16((LAS v4i16_t*)p)); }
DI void attn_pv(AttnAcc& a, const f32x16& p0, const f32x16& p1, const LAS unsigned char* vt, int r, int h) {
    const int q = (r >> 2) & 3, pp4 = r & 3, dg = r >> 4;
#pragma unroll
    for (int s4 = 0; s4 < 4; ++s4) {
        const f32x16& pp = s4 < 2 ? p0 : p1; const int o = 8 * (s4 & 1);
        u32x4 pw; pw.x = pg8::cvt_pk_bf16(pp[o], pp[o + 1]); pw.y = pg8::cvt_pk_bf16(pp[o + 2], pp[o + 3]); pw.z = pg8::cvt_pk_bf16(pp[o + 4], pp[o + 5]); pw.w = pg8::cvt_pk_bf16(pp[o + 6], pp[o + 7]);
        const bf16x8 pf = __builtin_bit_cast(bf16x8, pw);
        const int k1 = 16 * s4 + 4 * h + q, k2 = k1 + 8;
        const LAS unsigned char* r1 = vt + k1 * 128 + 8 * (pp4 & 1); const LAS unsigned char* r2 = vt + k2 * 128 + 8 * (pp4 & 1);
        const int z1 = (k1 >> 1) & 7, z2 = (k2 >> 1) & 7;
        { const int ch = 2 * dg + (pp4 >> 1);
          const s16x4 lo = vtr(r1 + ((ch ^ z1) << 4)), hi = vtr(r2 + ((ch ^ z2) << 4));
          a.o0 = MFMA32(__builtin_shufflevector(lo, hi, 0, 1, 2, 3, 4, 5, 6, 7), pf, a.o0); }
        { const int ch = 4 + 2 * dg + (pp4 >> 1);
          const s16x4 lo = vtr(r1 + ((ch ^ z1) << 4)), hi = vtr(r2 + ((ch ^ z2) << 4));
          a.o1 = MFMA32(__builtin_shufflevector(lo, hi, 0, 1, 2, 3, 4, 5, 6, 7), pf, a.o1); }
    }
}
template <bool WIN> DI void attn_chunk(AttnAcc& a, const LAS unsigned char* kt, const bf16x8 (&qf)[4], int hi0, int hi1, bool allv, bool lv, int r, int h) {
    f32x16 s0 = attn_scores(kt, 0, qf, r, h), s1 = attn_scores(kt, 1, qf, r, h);
    if (!allv) { attn_mask<WIN>(s0, hi0); attn_mask<WIN>(s1, hi1); }
    float mx = fmaxf(s0[0], s1[0]);
#pragma unroll
    for (int e = 1; e < 16; ++e) mx = fmaxf(mx, fmaxf(s0[e], s1[e]));
    mx = xor32_max(mx) * ATT_C; mx = lv ? mx : -__builtin_inff();
    const float mn = fmaxf(a.m, mx), mu = lv ? ((mn == -__builtin_inff()) ? 0.f : mn) : __builtin_inff();
    float ps = 0.f;
#pragma unroll
    for (int e = 0; e < 16; ++e) { s0[e] = __builtin_amdgcn_exp2f(__builtin_fmaf(s0[e], ATT_C, -mu)); s1[e] = __builtin_amdgcn_exp2f(__builtin_fmaf(s1[e], ATT_C, -mu)); ps += s0[e] + s1[e]; }
    ps = xor32_sum(ps);
    if (__ballot(mn != a.m) != 0ull) {
        const float sc = (a.m == -__builtin_inff()) ? 0.f : __builtin_amdgcn_exp2f(a.m - mn);
        a.l = a.l * sc + ps; a.o0 = a.o0 * sc; a.o1 = a.o1 * sc;
    } else a.l += ps;
    a.m = mn;
    attn_pv(a, s0, s1, kt + 8192, r, h);
}

namespace nb {
typedef __attribute__((address_space(3))) const char* lds_cptr;
constexpr int NSLOT = 3, SLOTB = 8192;
constexpr int LDS_K = 0, LDS_V = NSLOT * SLOTB, LDS_WS = 2 * NSLOT * SLOTB, LDS_OST = 65536, LDS_END = LDS_OST + 8 * 4096;
constexpr int LDS_TL = 98304 + 256;
#define NB_SBAR() __builtin_amdgcn_sched_barrier(0)
#define NB_WAIT_BAR(N) asm volatile("s_waitcnt vmcnt(" #N ") lgkmcnt(0)\n\ts_barrier" ::: "memory")
DI void glds16(const void* gsrc, unsigned lds_dst) { unsigned keep;
    asm volatile("s_mov_b32 %0, m0\n\ts_mov_b32 m0, %2\n\ts_nop 0\n\tglobal_load_lds_dwordx4 %1, off\n\ts_mov_b32 m0, %0" : "=&s"(keep) : "v"(gsrc), "s"(lds_dst) : "memory"); }
DI float max3f(float a, float b, float c) { float r; asm("v_max3_f32 %0, %1, %2, %3" : "=v"(r) : "v"(a), "v"(b), "v"(c)); return r; }
DI float max2f(float a, float b) { float r; asm("v_max_f32_e32 %0, %1, %2" : "=v"(r) : "v"(a), "v"(b)); return r; }
DI float fadd_s(float a, float b) { float r; asm("v_add_f32_e32 %0, %1, %2" : "=v"(r) : "v"(a), "v"(b)); return r; }
DI float fsub_s(float a, float b) { float r; asm("v_sub_f32_e32 %0, %1, %2" : "=v"(r) : "v"(a), "v"(b)); return r; }
typedef float f32x2_t __attribute__((ext_vector_type(2))); typedef __bf16 bf16x2_t __attribute__((ext_vector_type(2)));
DI unsigned cvtpk_s(float lo, float hi) { f32x2_t v = {lo, hi}; bf16x2_t b = __builtin_convertvector(v, bf16x2_t); return __builtin_bit_cast(unsigned, b); }
DI void qkt(f32x16& p0, f32x16& p1, lds_cptr Kslot, const bf16x8* qr, const f32x16& negm, int r32, int hi) {
    const lds_cptr kb = Kslot + hi * 1024 + r32 * 16;
#pragma unroll
    for (int d0 = 0; d0 < 4; ++d0) {
        const bf16x8 b0 = *(const LAS bf16x8*)(kb + d0 * 2048);
        const bf16x8 b1 = *(const LAS bf16x8*)(kb + d0 * 2048 + 512);
        if (d0 == 0) { p0 = __builtin_amdgcn_mfma_f32_32x32x16_bf16(b0, qr[0], negm, 0, 0, 0); p1 = __builtin_amdgcn_mfma_f32_32x32x16_bf16(b1, qr[0], negm, 0, 0, 0); }
        else { p0 = __builtin_amdgcn_mfma_f32_32x32x16_bf16(b0, qr[d0], p0, 0, 0, 0); p1 = __builtin_amdgcn_mfma_f32_32x32x16_bf16(b1, qr[d0], p1, 0, 0, 0); } }
}
DI void kload8(bf16x8* kf, lds_cptr kp) {
    kf[0] = *(const LAS bf16x8*)(kp);        kf[1] = *(const LAS bf16x8*)(kp + 512);
    kf[2] = *(const LAS bf16x8*)(kp + 2048); kf[3] = *(const LAS bf16x8*)(kp + 2560);
    kf[4] = *(const LAS bf16x8*)(kp + 4096); kf[5] = *(const LAS bf16x8*)(kp + 4608);
    kf[6] = *(const LAS bf16x8*)(kp + 6144); kf[7] = *(const LAS bf16x8*)(kp + 6656);
}
DI void kload2(bf16x8* kf, lds_cptr kp, int j) { kf[2 * j] = *(const LAS bf16x8*)(kp + j * 2048); kf[2 * j + 1] = *(const LAS bf16x8*)(kp + j * 2048 + 512); }
typedef short v4i16_t __attribute__((ext_vector_type(4)));
DI s16x4 vtr(lds_cptr p) { return __builtin_bit_cast(s16x4, __builtin_amdgcn_ds_read_tr16_b64_v4i16((LAS v4i16_t*)p)); }
DI float rowmax(const f32x16& p0, const f32x16& p1) {
    float a = max3f(p0[0], p0[1], p1[0]), b = max3f(p0[2], p0[3], p1[1]); a = max3f(a, p1[2], p1[3]);
#pragma unroll
    for (int r = 4; r < 16; r += 4) { a = max3f(a, p0[r], p0[r + 1]); b = max3f(b, p0[r + 2], p0[r + 3]); a = max3f(a, p1[r], p1[r + 1]); b = max3f(b, p1[r + 2], p1[r + 3]); }
    const float m = max2f(a, b);
    auto rr = __builtin_amdgcn_permlane32_swap(__float_as_uint(m), __float_as_uint(m), false, false);
    return max2f(__uint_as_float(rr[0]), __uint_as_float(rr[1]));
}
DI void pv(f32x16* o, int vb, bf16x8 pa0, bf16x8 pa1, bf16x8 pa2, bf16x8 pa3) {
#pragma unroll
    for (int d0 = 0; d0 < 2; ++d0) { s16x4 lo[4], hi[4];
#pragma unroll
        for (int ks = 0; ks < 4; ++ks) {
            asm volatile("ds_read_b64_tr_b16 %0,%1 offset:%c2" : "=&v"(lo[ks]) : "v"(vb), "i"(d0 * 4096 + ks * 1024) : "memory");
            asm volatile("ds_read_b64_tr_b16 %0,%1 offset:%c2" : "=&v"(hi[ks]) : "v"(vb), "i"(d0 * 4096 + ks * 1024 + 512) : "memory"); }
        asm volatile("s_waitcnt lgkmcnt(0)" ::: "memory"); NB_SBAR();
#define NB_PK(k) (bf16x8){lo[k][0], lo[k][1], lo[k][2], lo[k][3], hi[k][0], hi[k][1], hi[k][2], hi[k][3]}
        o[d0] = __builtin_amdgcn_mfma_f32_32x32x16_bf16(pa0, NB_PK(0), o[d0], 0, 0, 0);
        o[d0] = __builtin_amdgcn_mfma_f32_32x32x16_bf16(pa1, NB_PK(1), o[d0], 0, 0, 0);
        o[d0] = __builtin_amdgcn_mfma_f32_32x32x16_bf16(pa2, NB_PK(2), o[d0], 0, 0, 0);
        o[d0] = __builtin_amdgcn_mfma_f32_32x32x16_bf16(pa3, NB_PK(3), o[d0], 0, 0, 0);
#undef NB_PK
    }
}
DI void gmask(f32x16& p0, f32x16& p1, int hl, unsigned wd) {
    const float NEG = -__builtin_inff();
#pragma unroll
    for (int r = 0; r < 16; ++r) { const int ce = (r & 3) + 8 * (r >> 2); if ((unsigned)(hl - ce) > wd) p0[r] = NEG; if ((unsigned)(hl - 32 - ce) > wd) p1[r] = NEG; }
}
template <int THRL> DI void ring_unit(const int MODE, const bool LAST, const bf16* Qw, int ldq, const bf16* Kt, const bf16* Vt, int ld, const LAS int* tl, int NT, int posbase,
                                                          int pos0w  , unsigned long long m0, unsigned long long m1, unsigned long long m2, unsigned long long m3  ,
                                                          const bf16* gatep  , int br, bool store_ok, bf16* Ow, char* shm) {
    int tid_ = threadIdx.x; asm volatile("" : "+v"(tid_));
    const int tid = tid_, lane = tid & 63, r32 = lane & 31, hi = lane >> 5; const int wid = __builtin_amdgcn_readfirstlane(tid >> 6);
    const unsigned lds0 = (unsigned)(uintptr_t)shm;
    const bf16* ksrc = Kt + (long)lane * ld + wid * 8;
    const bf16* vsrc = Vt + (long)(16 * (wid & 3) + (lane >> 2)) * ld + (wid >> 2) * 32 + (lane & 3) * 8;
    const unsigned kdst = lds0 + LDS_K + wid * 1024, vdst = lds0 + LDS_V + wid * 1024;
#define NB_TL(t) __builtin_amdgcn_readfirstlane(tl[(t)])
    int dq0, dq1, dq2, dq3;
#define NB_DMA_KD(dd, slot) do { int d_ = (dd); d_ = d_ < 0 ? 0 : d_; nb::glds16(ksrc + (long)d_ * 64 * ld, (unsigned)__builtin_amdgcn_readfirstlane(kdst + (slot))); } while (0)
#define NB_DMA_VD(dd, slot) do { int d_ = (dd); d_ = d_ < 0 ? 0 : d_; nb::glds16(vsrc + (long)d_ * 64 * ld, (unsigned)__builtin_amdgcn_readfirstlane(vdst + (slot))); } while (0)
#define NB_DMA_K(t, slot) do { int d_ = NB_TL(t); d_ = d_ < 0 ? 0 : d_; nb::glds16(ksrc + (long)d_ * 64 * ld, (unsigned)__builtin_amdgcn_readfirstlane(kdst + (slot))); } while (0)
#define NB_DMA_V(t, slot) do { int d_ = NB_TL(t); d_ = d_ < 0 ? 0 : d_; nb::glds16(vsrc + (long)d_ * 64 * ld, (unsigned)__builtin_amdgcn_readfirstlane(vdst + (slot))); } while (0)
    const int vb0 = (int)(lds0 + LDS_V) + ((lane >> 4) & 1) * 32 + (lane & 3) * 8 + (4 * hi + ((lane & 15) >> 2)) * 64;
    bf16x8 kf[8];
    const lds_cptr shm3 = (lds_cptr)shm; const lds_cptr Kbase = shm3 + LDS_K;
    LAS float* wsf = (LAS float*)((LAS char*)shm3 + LDS_WS) + wid * 64; const lds_cptr kp0 = shm3 + LDS_K + hi * 1024 + r32 * 16; const lds_cptr vp0 = shm3 + LDS_V + ((lane >> 4) & 1) * 32 + (lane & 3) * 8 + (4 * hi + ((lane & 15) >> 2)) * 64;
    NB_DMA_K(0, 0); NB_DMA_V(0, 0); NB_DMA_K(1, SLOTB);
    bf16x8 qr[4];
    { const bf16* qp = Qw + (long)(r32 >> 3) * ldq + (r32 & 7) * 64 + hi * 8;
#pragma unroll
      for (int d0 = 0; d0 < 4; ++d0) qr[d0] = *reinterpret_cast<const bf16x8*>(qp + d0 * 16); }
    float mhat = 0.f, l_reg = 0.f; f32x16 o[2]; o[0] = f32x16{}; o[1] = f32x16{}; f32x16 negm = f32x16{}; asm volatile("" : "+v"(negm));
#define NB_CMASK(P0, P1, t) NB_CMASKD(P0, P1, NB_TL(t))
#define NB_CMASKD(P0, P1, dd) do { const int d_ = (dd); int hl_; unsigned wd_; bool full_; \
        const int trow_ = pos0w + (r32 >> 3); \
        if (MODE == 0) { const int pb_ = 64 * d_ + posbase; full_ = d_ >= 0 && pb_ + 63 <= pos0w && pb_ >= pos0w + 3 - 512; } \
        else { const int ds_ = d_ & 63; full_ = d_ >= 0 && ((m0 & m1 & m2 & m3) >> ds_ & 1ull) && 64 * d_ + 63 <= pos0w; } \
        if (full_) break; \
        if (MODE == 0) { hl_ = d_ < 0 ? -1 : trow_ - (64 * d_ + posbase) - 4 * hi; wd_ = 512u; } \
        else { const int ds_ = d_ & 63; const unsigned b4_ = (unsigned)((m0 >> ds_) & 1ull) | ((unsigned)((m1 >> ds_) & 1ull) << 1) | ((unsigned)((m2 >> ds_) & 1ull) << 2) | ((unsigned)((m3 >> ds_) & 1ull) << 3); \
               const bool mine_ = d_ >= 0 && ((b4_ >> (r32 >> 3)) & 1u); hl_ = mine_ ? trow_ - 64 * d_ - 4 * hi : -1; wd_ = 0x7fffffffu; } \
        nb::gmask(P0, P1, hl_, wd_); } while (0)
    bool resc = false;
#define NB_START(P0, P1) do { const float rm = nb::rowmax(P0, P1); resc = false; \
    { const float dl = (rm == -__builtin_inff()) ? 0.f : rm; mhat = nb::fadd_s(mhat, dl); \
      _Pragma("unroll") for (int r = 0; r < 16; ++r) { P0[r] = nb::fsub_s(P0[r], dl); P1[r] = nb::fsub_s(P1[r], dl); } \
      _Pragma("unroll") for (int r = 0; r < 16; ++r) negm[r] = -mhat; asm volatile("" : "+v"(negm)); } \
    _Pragma("unroll") for (int r = 0; r < 16; ++r) P0[r] = __builtin_amdgcn_exp2f(P0[r]); } while (0)
#define NB_RESC() do { if (resc) { asm volatile("s_waitcnt lgkmcnt(0)" ::: "memory"); \
      _Pragma("unroll") for (int d_ = 0; d_ < 2; ++d_) _Pragma("unroll") for (int r = 0; r < 16; ++r) o[d_][r] *= wsf[crow(r, hi)]; } } while (0)
    f32x16 pA0, pA1, pB0, pB1;
    int sl_prev = 0, sl_cur = 0, sl_next = SLOTB;
#define NB_ROT() do { sl_prev = sl_cur; sl_cur = sl_next; sl_next = (sl_next == (NSLOT - 1) * SLOTB) ? 0 : sl_next + SLOTB; } while (0)
#define NB_SHIFT(tn) do { dq0 = dq1; dq1 = dq2; dq2 = dq3; dq3 = NB_TL((tn) + 3 < 95 ? (tn) + 3 : 95); } while (0)
    NB_DMA_K(2, 2 * SLOTB);
    NB_WAIT_BAR(3);
    nb::qkt(pA0, pA1, Kbase, qr, negm, r32, hi); asm volatile("s_nop 15\n\ts_nop 7" : "+v"(pA0), "+v"(pA1)); NB_CMASK(pA0, pA1, 0);
    NB_START(pA0, pA1);
    _Pragma("unroll") for (int r = 0; r < 16; ++r) pA1[r] = __builtin_amdgcn_exp2f(pA1[r]);
    NB_WAIT_BAR(0);
    NB_DMA_K(3, 0); NB_DMA_V(1, SLOTB);
    NB_ROT();
    nb::kload8(kf, kp0 + sl_cur);
    NB_WAIT_BAR(2);
    dq0 = NB_TL(1); dq1 = NB_TL(2); dq2 = NB_TL(3); dq3 = NB_TL(4);
    s16x4 vlo[8], vhi[8]; u32x4 pw0, pw1, pw2, pw3;
#define NB_PKW(P, B) nb::cvtpk_s(P[B], P[B + 1])
#define NB_PAF(k) __builtin_bit_cast(bf16x8, pw##k)
#define NB_VFR(i) (bf16x8){vlo[i][0], vlo[i][1], vlo[i][2], vlo[i][3], vhi[i][0], vhi[i][1], vhi[i][2], vhi[i][3]}
#define NB_PIN(x) asm volatile("" : "+v"(x))
#define NB_MX3(a, b, c) __builtin_fmaxf(__builtin_fmaxf((a), (b)), (c))
#define NB_GAPA(MF, A0, A1, A2, A3, W0, W1, PW) do { MF; sacc += A0; sacc += A1; sacc += A2; sacc += A3; NB_PIN(sacc); W0; W1; NB_PIN(PW); NB_SBAR(); } while (0)
#define NB_EX(v) __builtin_amdgcn_exp2f(v)
#define NB_GAPB(MF, X, B) do { MF; X[B] = NB_EX(X[B]); X[B + 1] = NB_EX(X[B + 1]); X[B + 2] = NB_EX(X[B + 2]); X[B + 3] = NB_EX(X[B + 3]); NB_PIN(X); NB_SBAR(); } while (0)
#define NB_VRD(i) do { vlo[i] = nb::vtr(vp_ + (((i) >> 2) * 4096 + ((i) & 3) * 1024)); vhi[i] = nb::vtr(vp_ + (((i) >> 2) * 4096 + ((i) & 3) * 1024 + 512)); } while (0)
#define NB_KRD(G, j) do { if (G) { nb::kload2(kf, kp0 + sl_next, j); NB_SBAR(); } } while (0)
#define NB_MF(...) __builtin_amdgcn_mfma_f32_32x32x16_bf16(__VA_ARGS__, 0, 0, 0)
#define NB_STEP(C0, C1, P0, P1, t, GK, GV, GL) do { NB_SBAR(); \
    const lds_cptr vp_ = vp0 + sl_prev; \
    NB_VRD(0); NB_SBAR(); float sacc = (P0[0] + P0[1]); \
    NB_GAPA(C0 = NB_MF(kf[0], qr[0], negm), P0[2], P0[3], P0[4], P0[5],     pw0[0] = NB_PKW(P0, 0), pw0[1] = NB_PKW(P0, 2), pw0); \
    NB_VRD(4); NB_SBAR(); NB_GAPA(C1 = NB_MF(kf[1], qr[0], negm), P0[6], P0[7], P0[8], P0[9],     pw0[2] = NB_PKW(P0, 4), pw0[3] = NB_PKW(P0, 6), pw0); \
    NB_VRD(1); NB_SBAR(); NB_GAPA(C0 = NB_MF(kf[2], qr[1], C0),   P0[10], P0[11], P0[12], P0[13], pw1[0] = NB_PKW(P0, 8), pw1[1] = NB_PKW(P0, 10), pw1); \
    NB_VRD(5); NB_SBAR(); NB_GAPA(C1 = NB_MF(kf[3], qr[1], C1),   P0[14], P0[15], P1[0], P1[1],   pw1[2] = NB_PKW(P0, 12), pw1[3] = NB_PKW(P0, 14), pw1); \
    NB_VRD(2); NB_SBAR(); NB_GAPA(C0 = NB_MF(kf[4], qr[2], C0),   P1[2], P1[3], P1[4], P1[5],     pw2[0] = NB_PKW(P1, 0), pw2[1] = NB_PKW(P1, 2), pw2); \
    NB_VRD(6); NB_SBAR(); NB_GAPA(C1 = NB_MF(kf[5], qr[2], C1),   P1[6], P1[7], P1[8], P1[9],     pw2[2] = NB_PKW(P1, 4), pw2[3] = NB_PKW(P1, 6), pw2); \
    NB_VRD(3); NB_SBAR(); NB_GAPA(C0 = NB_MF(kf[6], qr[3], C0),   P1[10], P1[11], P1[12], P1[13], pw3[0] = NB_PKW(P1, 8), pw3[1] = NB_PKW(P1, 10), pw3); \
    NB_VRD(7); NB_SBAR(); NB_GAPA(C1 = NB_MF(kf[7], qr[3], C1),   P1[14], P1[15], 0.f, 0.f,       pw3[2] = NB_PKW(P1, 12), pw3[3] = NB_PKW(P1, 14), pw3); \
    l_reg += sacc; \
    if (GK) { NB_DMA_KD(dq3, sl_cur); } if (GV) { NB_DMA_VD(dq1, sl_next); } \
    NB_CMASKD(C0, C1, dq0); \
    { float a = NB_MX3(C0[0], C0[1], C1[0]), b = NB_MX3(C0[2], C0[3], C1[1]); a = NB_MX3(a, C1[2], C1[3]); \
      _Pragma("unroll") for (int r = 4; r < 16; r += 4) { a = NB_MX3(a, C0[r], C0[r + 1]); b = NB_MX3(b, C0[r + 2], C0[r + 3]); a = NB_MX3(a, C1[r], C1[r + 1]); b = NB_MX3(b, C1[r + 2], C1[r + 3]); } \
      float rm = __builtin_fmaxf(a, b); { auto rr = __builtin_amdgcn_permlane32_swap(__float_as_uint(rm), __float_as_uint(rm), false, false); rm = __builtin_fmaxf(__uint_as_float(rr[0]), __uint_as_float(rr[1])); } \
      resc = false; \
      if (__builtin_expect(__any(rm > (float)THRL), 0)) { const float dl = __builtin_fmaxf(rm, 0.f); mhat += dl; \
        _Pragma("unroll") for (int r = 0; r < 16; ++r) { C0[r] -= dl; C1[r] -= dl; } \
        _Pragma("unroll") for (int r = 0; r < 16; ++r) negm[r] = -mhat; asm volatile("" : "+v"(negm)); \
        const float f = __builtin_amdgcn_exp2f(-dl); l_reg *= f; if (hi == 0) wsf[r32] = f; resc = true; } } \
    NB_SBAR(); \
    NB_GAPB(o[0] = NB_MF(NB_PAF(0), NB_VFR(0), o[0]), C0, 0); \
    NB_GAPB(o[1] = NB_MF(NB_PAF(0), NB_VFR(4), o[1]), C0, 4); \
    NB_KRD(GL, 0); NB_GAPB(o[0] = NB_MF(NB_PAF(1), NB_VFR(1), o[0]), C0, 8); \
    NB_KRD(GL, 1); NB_GAPB(o[1] = NB_MF(NB_PAF(1), NB_VFR(5), o[1]), C0, 12); \
    NB_KRD(GL, 2); NB_GAPB(o[0] = NB_MF(NB_PAF(2), NB_VFR(2), o[0]), C1, 0); \
    NB_KRD(GL, 3); NB_GAPB(o[1] = NB_MF(NB_PAF(2), NB_VFR(6), o[1]), C1, 4); \
    NB_GAPB(o[0] = NB_MF(NB_PAF(3), NB_VFR(3), o[0]), C1, 8); \
    NB_GAPB(o[1] = NB_MF(NB_PAF(3), NB_VFR(7), o[1]), C1, 12); \
    } while (0)
    int t = 1;
    for (; t + 5 < NT; t += 2) {
        NB_STEP(pB0, pB1, pA0, pA1, t, true, true, true);     NB_WAIT_BAR(2); NB_SHIFT(t + 1); NB_RESC(); NB_ROT();
        NB_STEP(pA0, pA1, pB0, pB1, t + 1, true, true, true); NB_WAIT_BAR(2); NB_SHIFT(t + 2); NB_RESC(); NB_ROT();
    }
#define NB_ENDW(tt) do { if ((tt) + 3 < NT) { NB_WAIT_BAR(2); } else if ((tt) + 2 < NT) { NB_WAIT_BAR(1); } else { NB_WAIT_BAR(0); } } while (0)
    for (; t + 1 < NT; t += 2) {
        NB_STEP(pB0, pB1, pA0, pA1, t, (t + 3 < NT), (t + 1 < NT), (t + 1 < NT));         NB_ENDW(t);     NB_SHIFT(t + 1); NB_RESC(); NB_ROT();
        NB_STEP(pA0, pA1, pB0, pB1, t + 1, (t + 4 < NT), (t + 2 < NT), (t + 2 < NT));     NB_ENDW(t + 1); NB_SHIFT(t + 2); NB_RESC(); NB_ROT();
    }
    NB_STEP(pB0, pB1, pA0, pA1, NT - 1, false, false, false); NB_RESC();
    { float sacc = pB0[0] + pB0[1]; _Pragma("unroll") for (int r = 2; r < 16; ++r) sacc += pB0[r]; _Pragma("unroll") for (int r = 0; r < 16; ++r) sacc += pB1[r]; l_reg += sacc;
      pw0 = (u32x4){NB_PKW(pB0, 0), NB_PKW(pB0, 2), NB_PKW(pB0, 4), NB_PKW(pB0, 6)}; pw1 = (u32x4){NB_PKW(pB0, 8), NB_PKW(pB0, 10), NB_PKW(pB0, 12), NB_PKW(pB0, 14)};
      pw2 = (u32x4){NB_PKW(pB1, 0), NB_PKW(pB1, 2), NB_PKW(pB1, 4), NB_PKW(pB1, 6)}; pw3 = (u32x4){NB_PKW(pB1, 8), NB_PKW(pB1, 10), NB_PKW(pB1, 12), NB_PKW(pB1, 14)};
      NB_SBAR(); nb::pv(o, vb0 + sl_cur, NB_PAF(0), NB_PAF(1), NB_PAF(2), NB_PAF(3)); }
    { auto rr = __builtin_amdgcn_permlane32_swap(__float_as_uint(l_reg), __float_as_uint(l_reg), false, false); l_reg = __uint_as_float(rr[0]) + __uint_as_float(rr[1]); }
    if (hi == 0) { const float gate = sigmoidf_(bf2f(gatep[(long)(r32 >> 3) * ldq + (r32 & 7) * 3 + br])); wsf[32 + r32] = l_reg > 0.f ? gate / l_reg : 0.f; } asm volatile("s_waitcnt lgkmcnt(0)" ::: "memory");
    float rli[16];
#pragma unroll
    for (int r = 0; r < 16; ++r) rli[r] = wsf[32 + crow(r, hi)];
    { LAS bf16* stg = (LAS bf16*)((LAS char*)shm3 + LDS_OST) + wid * 2048;
#pragma unroll
      for (int r = 0; r < 16; ++r) { const int orow = crow(r, hi);
#pragma unroll
          for (int d0 = 0; d0 < 2; ++d0) { LAS bf16* sp = stg + orow * 64 + d0 * 32 + r32; *sp = (bf16)f2bf(bf2f(*sp) + o[d0][r] * rli[r]); } }
      asm volatile("s_waitcnt lgkmcnt(0)" ::: "memory");
      if (LAST && store_ok) {
#pragma unroll
          for (int i = 0; i < 4; ++i) { const int row = i * 8 + (lane >> 3), ch = lane & 7; const u32x4 v = *(const LAS u32x4*)(stg + row * 64 + ch * 8); *(u32x4*)(Ow + (long)(row >> 3) * DM + (row & 7) * 64 + ch * 8) = v; } } }
    asm volatile("s_waitcnt lgkmcnt(0)\n\ts_barrier" ::: "memory");
#undef NB_TL
#undef NB_DMA_K
#undef NB_DMA_KD
#undef NB_DMA_VD
#undef NB_CMASKD
#undef NB_SHIFT
#undef NB_DMA_V
#undef NB_CMASK
#undef NB_START
#undef NB_RESC
#undef NB_ROT
#undef NB_PKW
#undef NB_PAF
#undef NB_VFR
#undef NB_PIN
#undef NB_MX3
#undef NB_GAPA
#undef NB_EX
#undef NB_GAPB
#undef NB_VRD
#undef NB_KRD
#undef NB_MF
#undef NB_STEP
#undef NB_ENDW
}
}
struct WTask {
    const bf16* Q; int ldq;
    const bf16* gate;
    int pos0, ncw;
    const bf16 *Kc, *Vc; int ncmp;
    const bf16 *Ks, *Vs; int ldks, nsel;
    const bf16 *Kw, *Vw; int ldkw, winbase;
    bf16* O;
};
DI float head_sum8(float x) {
    x += __builtin_bit_cast(float, __builtin_amdgcn_update_dpp(0, __builtin_bit_cast(int, x), 0xB1, 0xF, 0xF, true));
    x += __builtin_bit_cast(float, __builtin_amdgcn_update_dpp(0, __builtin_bit_cast(int, x), 0x4E, 0xF, 0xF, true));
    x += __builtin_bit_cast(float, __builtin_amdgcn_update_dpp(0, __builtin_bit_cast(int, x), 0x141, 0xF, 0xF, true));
    return x;
}
DI void nsa_attend_wg(const WTask& T, const Frame& F) {
    LAS unsigned char* lds = F.lds;
    LAS float* PS = (LAS float*)(lds + 65536 + F.wave * 4096);
    volatile LAS unsigned* UM = (volatile LAS unsigned*)(lds + 98304);
    int lane_ = F.lane; asm volatile("" : "+v"(lane_));
    const int lane = lane_, r = lane & 31, h = lane >> 5, tok = r >> 3, head = r & 7;
    const bool cw = F.wave < T.ncw;
    const int wtok = cw ? 4 * F.wave : 0;
    const int pos0w = T.pos0 + wtok, t = pos0w + tok, tlast = T.pos0 + 4 * T.ncw - 1;
    const int tidl = F.wave * 64 + lane, srow = tidl >> 3, sch = (tidl & 7) ^ ((srow >> 1) & 7);
    const unsigned wbase = (unsigned)F.wave * 1024u;
#define AT_DMA(kp, ldk, vp, ldv, buf) do { \
        __builtin_amdgcn_global_load_lds((const unsigned*)((kp) + (size_t)srow * (ldk) + sch * 8), (LAS unsigned*)(lds + (buf) * 16384 + wbase), 16, 0, 0); \
        __builtin_amdgcn_global_load_lds((const unsigned*)((vp) + (size_t)srow * (ldv) + sch * 8), (LAS unsigned*)(lds + (buf) * 16384 + 8192 + wbase), 16, 0, 0); } while (0)
#define AT_WAITV(n) asm volatile("s_waitcnt vmcnt(" #n ")" ::: "memory")
#define AT_BAR() do { asm volatile("" ::: "memory"); __builtin_amdgcn_s_barrier(); asm volatile("" ::: "memory"); } while (0)
    bf16x8 qf[4];
    { const bf16* qp = T.Q + (size_t)(wtok + tok) * T.ldq + head * 64 + 8 * h;
#pragma unroll
      for (int st = 0; st < 4; ++st) qf[st] = *(const bf16x8*)(qp + 16 * st); }
    float gt[3];
#pragma unroll
    for (int br = 0; br < 3; ++br) gt[br] = sigmoidf_(bf2f(T.gate[(size_t)(wtok + tok) * T.ldq + head * 3 + br]));
    f32x16 out0, out1; for (int e = 0; e < 16; ++e) { out0[e] = 0.f; out1[e] = 0.f; }
    AttnAcc A; attn_reset(A);
    const int nc64 = tlast >= 31 ? ((((tlast - 31) >> 4) >> 6) + 1) : 0;
    for (int i = 0; i < nc64; ++i) AT_DMA(T.Kc + (size_t)i * 64 * 64, 64, T.Vc + (size_t)i * 64 * 64, 64, i);
    for (int n = lane; n < 1024; n += 64) PS[n] = 0.f;
    AT_WAITV(0); LDS_WAIT(); AT_BAR();
    if (cw) {
        float cm = -__builtin_inff(), cl = 0.f;
        const int nmaxl = t >= 31 ? (((t - 31) >> 4) < T.ncmp - 1 ? ((t - 31) >> 4) : T.ncmp - 1) : -1;
        for (int i = 0; i < nc64; ++i) {
            const LAS unsigned char* kt = lds + i * 16384;
            f32x16 s0 = attn_scores(kt, 0, qf, r, h), s1 = attn_scores(kt, 1, qf, r, h);
            attn_mask<false>(s0, nmaxl - 64 * i - 4 * h); attn_mask<false>(s1, nmaxl - 64 * i - 32 - 4 * h);
            float mx = fmaxf(s0[0], s1[0]);
#pragma unroll
            for (int e = 1; e < 16; ++e) mx = fmaxf(mx, fmaxf(s0[e], s1[e]));
            mx = xor32_max(mx) * ATT_C;
            const float mn = fmaxf(cm, mx), mu = (mn == -__builtin_inff()) ? 0.f : mn; float ps = 0.f;
#pragma unroll
            for (int e = 0; e < 16; ++e) ps += __builtin_amdgcn_exp2f(__builtin_fmaf(s0[e], ATT_C, -mu)) + __builtin_amdgcn_exp2f(__builtin_fmaf(s1[e], ATT_C, -mu));
            ps = xor32_sum(ps);
            cl = (cm == -__builtin_inff() ? 0.f : cl * __builtin_amdgcn_exp2f(cm - mn)) + ps; cm = mn;
        }
        const float linv = cl > 0.f ? 1.f / cl : 0.f, cmu = (cm == -__builtin_inff()) ? 0.f : cm;
        for (int i = 0; i < nc64; ++i) {
            const LAS unsigned char* kt = lds + i * 16384;
            f32x16 s0 = attn_scores(kt, 0, qf, r, h), s1 = attn_scores(kt, 1, qf, r, h);
            attn_mask<false>(s0, nmaxl - 64 * i - 4 * h); attn_mask<false>(s1, nmaxl - 64 * i - 32 - 4 * h);
#pragma unroll
            for (int e = 0; e < 16; ++e) { s0[e] = __builtin_amdgcn_exp2f(__builtin_fmaf(s0[e], ATT_C, -cmu)) * linv; s1[e] = __builtin_amdgcn_exp2f(__builtin_fmaf(s1[e], ATT_C, -cmu)) * linv; }
            attn_pv(A, s0, s1, kt + 8192, r, h);
#pragma unroll
            for (int e = 0; e < 16; ++e) { const float pe = head_sum8(s0[e]), pf2 = head_sum8(s1[e]);
                if (head == 0) { PS[tok * 256 + 64 * i + crow(e, h)] = pe; PS[tok * 256 + 64 * i + 32 + crow(e, h)] = pf2; } }
        }
        out0 = A.o0 * gt[0]; out1 = A.o1 * gt[0];
    }
    LDS_WAIT(); __builtin_amdgcn_wave_barrier();
    unsigned long long msk[4] = {0ull, 0ull, 0ull, 0ull};
    if (cw) {
#pragma unroll
        for (int tk = 0; tk < 4; ++tk) {
            const int tt = pos0w + tk, cur = tt >> 6, j = lane;
            float imp = 0.f;
#pragma unroll
            for (int dn = -1; dn <= 3; ++dn) { const int n = 4 * j + dn; if (n >= 0 && n < T.ncmp) imp += PS[tk * 256 + n]; }
            const bool valid = (j <= cur) && (j < T.nsel), forced = (j == 0) || (j == cur) || (j == cur - 1);
            const unsigned key = !valid ? 0u : (forced ? 0xffffffffu : __builtin_bit_cast(unsigned, imp) + 1u);
            unsigned thr = 0u;
#pragma unroll 1
            for (int bit = 31; bit >= 0; --bit) { const unsigned cand = thr | (1u << bit); if (__builtin_popcountll(__ballot(key >= cand)) >= 16) thr = cand; }
            const int need = 16 - __builtin_popcountll(__ballot(key > thr));
            const unsigned long long ties = __ballot(key == thr);
            const bool tie_ok = key == thr && __builtin_popcountll(ties & ((1ull << j) - 1ull)) < need;
            msk[tk] = __ballot(valid && (key > thr || tie_ok));
        }
    }
    { const unsigned long long wu = msk[0] | msk[1] | msk[2] | msk[3];
      if (lane == 0) { UM[2 * F.wave] = (unsigned)wu; UM[2 * F.wave + 1] = (unsigned)(wu >> 32); } }
    LDS_WAIT(); AT_BAR();
    unsigned long long un = 0ull;
#pragma unroll
    for (int w = 0; w < 8; ++w) un |= (unsigned long long)UM[2 * w] | ((unsigned long long)UM[2 * w + 1] << 32);
    un = ((unsigned long long)__builtin_amdgcn_readfirstlane((unsigned)(un >> 32)) << 32) | (unsigned long long)__builtin_amdgcn_readfirstlane((unsigned)un);
    {   int lo = T.pos0 - 512 - T.winbase; lo = lo < 0 ? 0 : lo;
        const int c0 = lo >> 6, nW = ((tlast - T.winbase) >> 6) - c0 + 1;
        int ntw = (nW + 1) & ~1; ntw = ntw < 4 ? 4 : ntw;
        LAS int* tlw = (LAS int*)(lds + nb::LDS_TL);
        { LAS bf16* stg = (LAS bf16*)(lds + nb::LDS_OST + F.wave * 4096) + r * 64 + 4 * h;
#pragma unroll
          for (int q4 = 0; q4 < 4; ++q4) {
              *(LAS u32x2*)(stg + 8 * q4) = (u32x2){pg8::cvt_pk_bf16(out0[4 * q4], out0[4 * q4 + 1]), pg8::cvt_pk_bf16(out0[4 * q4 + 2], out0[4 * q4 + 3])};
              *(LAS u32x2*)(stg + 32 + 8 * q4) = (u32x2){pg8::cvt_pk_bf16(out1[4 * q4], out1[4 * q4 + 1]), pg8::cvt_pk_bf16(out1[4 * q4 + 2], out1[4 * q4 + 3])}; } }
        if (F.wave == 0) for (int i = lane; i < 96; i += 64) tlw[i] = i < nW ? c0 + i : -1;
        asm volatile("s_waitcnt vmcnt(0) lgkmcnt(0)\n\ts_barrier" ::: "memory");
        const int p0w = cw ? pos0w : -(1 << 24);
        nb::ring_unit<8>(0, false, T.Q + (size_t)wtok * T.ldq, T.ldq, T.Kw, T.Vw, T.ldkw, tlw, ntw, T.winbase, p0w, 0ull, 0ull, 0ull, 0ull, T.gate + (size_t)wtok * T.ldq, 2, cw, T.O + (size_t)wtok * DM, (char*)lds);
    }
    { const bf16* qp = T.Q + (size_t)(wtok + tok) * T.ldq + head * 64 + 8 * h; asm volatile("" : "+v"(qp));
#pragma unroll
      for (int st = 0; st < 4; ++st) qf[st] = *(const bf16x8*)(qp + 16 * st); }
    const int nCh = __builtin_popcountll(un);
    unsigned long long rem_i = un, rem_c = un;
#define AT_ISSUE(q) do { const int j_ = __builtin_ctzll(rem_i); rem_i &= rem_i - 1ull; AT_DMA(T.Ks + (size_t)j_ * 64 * T.ldks, T.ldks, T.Vs + (size_t)j_ * 64 * T.ldks, T.ldks, (q) & 3); } while (0)
    for (int q = 0; q < 3 && q < nCh; ++q) AT_ISSUE(q);
    attn_reset(A);
    const unsigned long long mym = tok == 0 ? msk[0] : (tok == 1 ? msk[1] : (tok == 2 ? msk[2] : msk[3]));
    const unsigned long long wany = msk[0] | msk[1] | msk[2] | msk[3];
    for (int i = 0; i < nCh; ++i) {
        const int left = nCh - 1 - i;
        if (left >= 2) AT_WAITV(4); else if (left == 1) AT_WAITV(2); else AT_WAITV(0);
        AT_BAR();
        if (i + 3 < nCh) AT_ISSUE(i + 3);
        const LAS unsigned char* kt = lds + (i & 3) * 16384;
        const int j = __builtin_ctzll(rem_c); rem_c &= rem_c - 1ull;
        if (cw && ((wany >> j) & 1ull) && 64 * j <= pos0w + 3) {
            const bool mine = (mym >> j) & 1ull;
            const bool allv = 64 * j + 63 <= pos0w;
            const int hi = mine ? t - 64 * j - 4 * h : -1;
            attn_chunk<false>(A, kt, qf, hi, mine ? hi - 32 : -1, allv, mine, r, h);
        }
    }
#undef AT_DMA
#undef AT_ISSUE
#undef AT_WAITV
#undef AT_BAR
    if (cw) {
        const float inv = A.l > 0.f ? gt[1] / A.l : 0.f;
        const LAS bf16* stg = (const LAS bf16*)(lds + nb::LDS_OST + F.wave * 4096) + r * 64 + 4 * h;
        bf16* op = T.O + (size_t)(wtok + tok) * DM + head * 64;
#pragma unroll
        for (int q4 = 0; q4 < 4; ++q4) {
            const u32x2 w0 = *(const LAS u32x2*)(stg + 8 * q4), w1 = *(const LAS u32x2*)(stg + 32 + 8 * q4);
            *(u32x2*)(op + 8 * q4 + 4 * h) = (u32x2){pk2(bflo(w0.x) + A.o0[4 * q4] * inv, bfhi(w0.x) + A.o0[4 * q4 + 1] * inv), pk2(bflo(w0.y) + A.o0[4 * q4 + 2] * inv, bfhi(w0.y) + A.o0[4 * q4 + 3] * inv)};
            *(u32x2*)(op + 32 + 8 * q4 + 4 * h) = (u32x2){pk2(bflo(w1.x) + A.o1[4 * q4] * inv, bfhi(w1.x) + A.o1[4 * q4 + 1] * inv), pk2(bflo(w1.y) + A.o1[4 * q4 + 2] * inv, bfhi(w1.y) + A.o1[4 * q4 + 3] * inv)}; }
    }
}
DI void nsa_attention(const P& p, const Frame& F, int li) {
    const bf16* H = (const bf16*)(p.ws + WS_H); bf16* AO = (bf16*)(p.ws + WS_AO);
    constexpr int NT_P = NB * 2 * (SEQ / 32), NT_S = DB * 2;
    for (int id = F.bid; id < NT_P + NT_S; id += F.G) {
        WTask T;
        if (id < NT_P) {
            int g, b, tq; if (F.G == 256) { const int k = id >> 8, w = (id & 255) >> 3; g = id & 1; b = (id & 7) >> 1; tq = k == 0 ? w : (k == 1 ? 63 - w : (k == 2 ? 64 + w : 127 - w)); }
            else { const int q = id >> 1; g = id & 1; b = q >> 7; tq = (b & 1) ? 127 - (q & 127) : (q & 127); }
            const size_t row = (size_t)b * SEQ + 32 * tq;
            T.Q = H + row * NINP + g * 512; T.ldq = NINP; T.gate = H + row * NINP + 1792 + g * 24; T.pos0 = 32 * tq; T.ncw = 8;
            T.Kc = (const bf16*)(p.ws + WS_KC_P) + (size_t)(b * 2 + g) * 256 * 64; T.Vc = (const bf16*)(p.ws + WS_VCT_P) + (size_t)(b * 2 + g) * 256 * 64; T.ncmp = NCMP_P;
            T.Ks = H + (size_t)b * SEQ * NINP + 1280 + g * 64; T.ldks = NINP; T.Vs = H + (size_t)b * SEQ * NINP + 1408 + g * 64; T.nsel = NSEL_P;
            T.Kw = H + (size_t)b * SEQ * NINP + 1536 + g * 64; T.ldkw = NINP; T.Vw = H + (size_t)b * SEQ * NINP + 1664 + g * 64; T.winbase = 0;
            T.O = AO + row * DM + g * 512; }
        else { const int i2 = id - NT_P, g = i2 & 1, b = i2 >> 1; const size_t row = (size_t)MP + b * DS;
            T.Q = H + row * NINP + g * 512; T.ldq = NINP; T.gate = H + row * NINP + 1792 + g * 24; T.pos0 = PAST; T.ncw = 2;
            T.Kc = (const bf16*)(p.ws + WS_KC_S) + (size_t)(b * 2 + g) * 128 * 64; T.Vc = (const bf16*)(p.ws + WS_VCT_S) + (size_t)(b * 2 + g) * 128 * 64; T.ncmp = NCMP_S;
            T.Ks = (const bf16*)(p.ws + WS_KSLC_S + li * SZ_SLC_S) + (size_t)(b * 2 + g) * SLC_S_ROWS * 64; T.ldks = 64; T.Vs = (const bf16*)(p.ws + WS_VSLCT_S + li * SZ_SLC_S) + (size_t)(b * 2 + g) * SLC_S_ROWS * 64; T.nsel = NSEL_S;
            T.Kw = (const bf16*)(p.ws + WS_KWIN_S + li * SZ_WIN_S) + (size_t)(b * 2 + g) * WIN_S_ROWS * 64; T.ldkw = 64; T.Vw = (const bf16*)(p.ws + WS_VWINT_S + li * SZ_WIN_S) + (size_t)(b * 2 + g) * WIN_S_ROWS * 64; T.winbase = PAST - 512;
            T.O = AO + row * DM + g * 512; }
        nsa_attend_wg(T, F);
        __syncthreads();
    }
}

DI void small_gemm_resid(const Frame& F, const bf16* A, const bf16* Bt, int K, float* X) {
    LAS unsigned char* lds = F.lds; LAS float* red = (LAS float*)(F.lds + 98304);
    const int r = F.lane & 31, h = F.lane >> 5, mi = F.wave & 1, ni = (F.wave >> 1) & 1, kh = F.wave >> 2, nst = K >> 7;
    const int p0 = F.tid, p1 = F.tid + 512;
    const int r0 = p0 >> 4, c0 = (p0 & 15) ^ (r0 & 15), r1 = p1 >> 4, c1 = (p1 & 15) ^ (r1 & 15);
    const unsigned wb = (unsigned)F.wave * 1024u;
    for (int tile = F.bid; tile < 256; tile += F.G) {
        const int row0 = MP + (tile >> 4) * 64, col0 = (tile & 15) * 64;
        const bf16* a0 = A + (size_t)(row0 + r0) * K + c0 * 8; const bf16* a1 = A + (size_t)(row0 + r1) * K + c1 * 8;
        const bf16* b0 = Bt + (size_t)(col0 + r0) * K + c0 * 8; const bf16* b1 = Bt + (size_t)(col0 + r1) * K + c1 * 8;
#define SG_DMA(s_) do { const int k_ = (s_) * 128; LAS unsigned char* d_ = lds + ((s_) % 3) * 32768 + wb; \
        __builtin_amdgcn_global_load_lds((const unsigned*)(a0 + k_), (LAS unsigned*)d_, 16, 0, 0); __builtin_amdgcn_global_load_lds((const unsigned*)(a1 + k_), (LAS unsigned*)(d_ + 8192), 16, 0, 0); \
        __builtin_amdgcn_global_load_lds((const unsigned*)(b0 + k_), (LAS unsigned*)(d_ + 16384), 16, 0, 0); __builtin_amdgcn_global_load_lds((const unsigned*)(b1 + k_), (LAS unsigned*)(d_ + 24576), 16, 0, 0); } while (0)
        f32x16 acc; for (int e = 0; e < 16; ++e) acc[e] = 0.f;
        SG_DMA(0); if (nst > 1) SG_DMA(1);
        for (int s = 0; s < nst; ++s) {
            if (s + 1 < nst) asm volatile("s_waitcnt vmcnt(4)" ::: "memory"); else asm volatile("s_waitcnt vmcnt(0)" ::: "memory");
            asm volatile("" ::: "memory"); __builtin_amdgcn_s_barrier(); asm volatile("" ::: "memory");
            if (s + 2 < nst) SG_DMA(s + 2);
            const LAS unsigned char* ia = lds + (s % 3) * 32768; const LAS unsigned char* ib = ia + 16384;
            const int ra = 32 * mi + r, rb = 32 * ni + r;
#pragma unroll
            for (int u = 0; u < 4; ++u) { const int ch = 8 * kh + 2 * u + h;
                acc = MFMA32(*(const LAS bf16x8*)(ia + ra * 256 + ((ch ^ (ra & 15)) << 4)), *(const LAS bf16x8*)(ib + rb * 256 + ((ch ^ (rb & 15)) << 4)), acc); }
        }
#undef SG_DMA
        if (kh == 1) {
#pragma unroll
            for (int e = 0; e < 16; ++e) red[((F.wave & 3) * 16 + e) * 64 + F.lane] = acc[e]; }
        __syncthreads();
        if (kh == 0) {
#pragma unroll
            for (int e = 0; e < 16; ++e) { float* xp = X + (size_t)(row0 + 32 * mi + crow(e, h)) * DM + col0 + 32 * ni + r; *xp = *xp + acc[e] + red[((F.wave & 3) * 16 + e) * 64 + F.lane]; } }
        __syncthreads();
    }
}

DI P load_ptrs(LAS unsigned char* lds) {
    unsigned off = PTAB_OFF; asm volatile("" : "+s"(off));
    const LAS unsigned* t = (const LAS unsigned*)(lds + off);
    P q;
#pragma unroll
    for (int k = 0; k < 28; ++k) { const unsigned lo = __builtin_amdgcn_readfirstlane(t[2 * k]), hi = __builtin_amdgcn_readfirstlane(t[2 * k + 1]);
        void* v = (void*)(GAS char*)(((unsigned long long)hi << 32) | lo);
        if (k < 26) q.in[k] = v; else if (k == 26) q.out = (float*)v; else q.ws = (unsigned char*)v; }
    return q;
}
__global__ void __launch_bounds__(512, 2) hybrid_fwd(P parg) {
    extern __shared__ __attribute__((aligned(16))) unsigned char lds_raw[];
    Frame F;
    F.lds = (LAS unsigned char*)lds_raw; F.tid = threadIdx.x; F.lane = F.tid & 63; F.wave = __builtin_amdgcn_readfirstlane(F.tid >> 6);
    F.bid = blockIdx.x; F.G = gridDim.x; F.gw = F.bid * 8 + F.wave; F.ngw = F.G * 8;
    volatile LAS unsigned* MISC = (volatile LAS unsigned*)(F.lds + MISC_OFF);
    for (int u = F.tid; u < (LDS_BYTES - RING_BYTES) / 4; u += 512) ((LAS unsigned*)(F.lds + RING_BYTES))[u] = 0u;
    __syncthreads();
    if (F.tid < 28) { const void* v = F.tid < 26 ? parg.in[F.tid] : (F.tid == 26 ? (const void*)parg.out : (const void*)parg.ws);
        const unsigned long long w = (unsigned long long)v; LAS unsigned* t = (LAS unsigned*)(F.lds + PTAB_OFF); t[2 * F.tid] = (unsigned)w; t[2 * F.tid + 1] = (unsigned)(w >> 32); }
    __syncthreads();
    XcdBarrier bar = xcd_barrier_post((unsigned*)(parg.ws + WS_CTL) + CW_BAR, MISC + 8);
#define REFRESH() do { int t_ = threadIdx.x, b_ = __builtin_amdgcn_readfirstlane(F.bid), g_ = __builtin_amdgcn_readfirstlane(F.G); asm volatile("" : "+v"(t_), "+s"(b_), "+s"(g_)); F.tid = t_; F.lane = t_ & 63; F.wave = __builtin_amdgcn_readfirstlane(t_ >> 6); F.bid = b_; F.G = g_; F.gw = b_ * 8 + F.wave; F.ngw = g_ * 8; } while (0)
#define GRID_BAR() do { xcd_barrier(bar); REFRESH(); } while (0)
#define PH(...) do { const P p = load_ptrs(F.lds); unsigned char* ws = p.ws; (void)ws; __VA_ARGS__ } while (0)
    PH( p0_cbias(p, F); );
    PH( p0_weights(p, F, 0); );
    PH( rms_phase<0>(p, F, (const float*)p.in[7]); );
    GRID_BAR();
#define LAYER_BODY(layer) { const int li = (layer) >> 1;  \
        if ((layer & 1) == 0) { \
            PH( pg8::Gemm g{DM, DM, 128}; pg8::StaticOrder S; S.init(M, GINP, F.G, F.bid, ws + WS_XN, ws + WS_WG_IN + li * SZ_WG_IN, ws + WS_H, DM, DM); \
                pg8::EpiBf16 E{GINP}; pg8::gemm_phase(F.lds, g, S, E); ); \
            GRID_BAR(); \
            PH( gdn_prep(p, F, li); ); \
            GRID_BAR(); \
            PH( gdn_chunk(p, F, li); ); \
            GRID_BAR(); \
            PH( if (F.G > 64) { if (F.bid < 64) gdn_scan(p, F, li, (((F.bid & 7) + 8 * (F.bid >> 4)) << 1) | ((F.bid >> 3) & 1)); else {     for (int task = F.bid - 64; task < DB * GH; task += F.G - 64) gdn_sample(p, F, li, task); Frame F2 = F; F2.bid = F.bid - 64; F2.G = F.G - 64; F2.gw = F2.bid * 8 + F.wave; F2.ngw = F2.G * 8; p0_cache_win(p, F2, li); if (li == 0) p0_weights(p, F2, 1); } } \
                else { for (int sid = F.bid; sid < 64; sid += F.G) { gdn_scan(p, F, li, sid); __syncthreads(); } for (int task = F.bid; task < DB * GH; task += F.G) gdn_sample(p, F, li, task); p0_cache_win(p, F, li); if (li == 0) p0_weights(p, F, 1); } ); \
            GRID_BAR(); \
            PH( gdn_gate(p, F, li); if (layer == 0) p0_cbias2(p, F); ); \
            GRID_BAR(); \
        } else { \
            PH( pg8::Gemm g{DM, DM, 128}; pg8::StaticOrder S; S.init(M, NINP, F.G, F.bid, ws + WS_XN, ws + WS_WN_IN + li * SZ_WN_IN, ws + WS_H, DM, DM); \
                pg8::EpiNsaIn E{(bf16*)(ws + WS_H), p.out, (bf16*)(ws + WS_CMPP), li}; pg8::gemm_phase(F.lds, g, S, E); \
                if (F.G > 32 && F.bid >= 32) { pg8::Gemm g2{1024, 4096, 512}; CmpOrder S2{F.G - 32, F.bid - 32, li, ws, 320, 224}; pg8::EpiBf16 E2{512}; pg8::gemm_phase(F.lds, g2, S2, E2); } ); \
            GRID_BAR(); \
            PH( nsa_transpose(p, F, li); ); \
            __syncthreads(); REFRESH(); \
            PH( pg8::Gemm g{1024, 4096, 512}; CmpOrder S{F.G, F.bid, li, ws, 0, F.G > 32 ? 320 : 544}; pg8::EpiBf16 E{512}; pg8::gemm_phase(F.lds, g, S, E); ); \
            GRID_BAR(); \
            PH( nsa_cmp2(p, F, li); ); \
            GRID_BAR(); \
            PH( nsa_attention(p, F, li); ); \
            GRID_BAR(); \
        } \
        PH( const bf16* Wout = (const bf16*)(ws + ((layer & 1) ? WS_WN_OUT : WS_WG_OUT) + li * SZ_W1K); \
            pg8::Gemm g{DM, DM, 128}; pg8::StaticOrder S; S.init(MP, DM, F.G, F.bid, ws + WS_AO, Wout, nullptr, DM, DM); \
            pg8::EpiResid E{(float*)(ws + WS_X)}; pg8::gemm_phase(F.lds, g, S, E); small_gemm_resid(F, (const bf16*)(ws + WS_AO), Wout, DM, (float*)(ws + WS_X)); ); \
        GRID_BAR(); \
        PH( rms_phase<1>(p, F, (const float*)p.in[8] + layer * DM); ); \
        GRID_BAR(); \
        PH( pg8::Gemm g{DM, DM, 128}; pg8::StaticOrder S; S.init(M, FF2, F.G, F.bid, ws + WS_XN, ws + WS_WF_IN + layer * SZ_WF_IN, nullptr, DM, DM); \
            pg8::EpiSwiglu E{(bf16*)(ws + WS_FFH), FF}; pg8::gemm_phase(F.lds, g, S, E); ); \
        GRID_BAR(); \
        PH( pg8::Gemm g{FF, FF, 128}; pg8::StaticOrder S; S.init(MP, DM, F.G, F.bid, ws + WS_FFH, ws + WS_WF_OUT + layer * SZ_WF_OUT, nullptr, FF, FF); \
            pg8::EpiResid E{(float*)(ws + WS_X)}; pg8::gemm_phase(F.lds, g, S, E); small_gemm_resid(F, (const bf16*)(ws + WS_FFH), (const bf16*)(ws + WS_WF_OUT + layer * SZ_WF_OUT), FF, (float*)(ws + WS_X)); ); \
        GRID_BAR(); \
        if (layer < 3) { PH( rms_phase<1>(p, F, (const float*)p.in[7] + (layer + 1) * DM); ); GRID_BAR(); } \
     }
    LAYER_BODY(0)
    LAYER_BODY(1)
    LAYER_BODY(2)
    LAYER_BODY(3)
    PH( rms_phase<2>(p, F, (const float*)p.in[9]); );
}

extern "C" void kernel_launch(void* const* d_in, const int* in_sizes, int n_in, void* d_out, int out_size, void* d_ws, size_t ws_size, hipStream_t stream) {
    static int grid = 0;
    if (grid == 0) {
        if (n_in != 26 || ws_size < WS_END) { fprintf(stderr, "kernel_launch: unexpected n_in %d or ws_size %zu (< %zu)\n", n_in, ws_size, (size_t)WS_END); grid = -1; return; }
        int dev = 0, cus = 0, per_cu = 0;
        if (hipGetDevice(&dev) != hipSuccess || hipDeviceGetAttribute(&cus, hipDeviceAttributeMultiprocessorCount, dev) != hipSuccess) { grid = -1; return; }
        if (hipFuncSetAttribute((const void*)hybrid_fwd, hipFuncAttributeMaxDynamicSharedMemorySize, LDS_BYTES) != hipSuccess) { fprintf(stderr, "kernel_launch: hipFuncSetAttribute failed\n"); grid = -1; return; }
        if (hipOccupancyMaxActiveBlocksPerMultiprocessor(&per_cu, (const void*)hybrid_fwd, 512, LDS_BYTES) != hipSuccess || per_cu < 1) fprintf(stderr, "kernel_launch: occupancy query says %d\n", per_cu);
        (void)hipGetLastError();
        grid = cus;
    }
    if (grid < 0) return;
    (void)in_sizes; (void)out_size;
    (void)hipMemsetAsync((char*)d_ws + WS_CTL, 0, CTL_BYTES, stream);
    P p{};
    for (int i = 0; i < 26; ++i) p.in[i] = d_in[i];
    p.out = (float*)d_out; p.ws = (unsigned char*)d_ws;
    hipLaunchKernelGGL(hybrid_fwd, dim3(grid), dim3(512), LDS_BYTES, stream, p);
}
```

```cpp
#include <hip/hip_runtime.h>
#include <cstdio>

#define DI __device__ __forceinline__
#define LAS __attribute__((address_space(3)))
#define GAS __attribute__((address_space(1)))
typedef unsigned short bf16;
typedef short bf16x8 __attribute__((ext_vector_type(8)));
typedef short s16x4 __attribute__((ext_vector_type(4)));
typedef float f32x4 __attribute__((ext_vector_type(4)));
typedef float f32x2 __attribute__((ext_vector_type(2)));
typedef float f32x16 __attribute__((ext_vector_type(16)));
typedef unsigned u32x4 __attribute__((ext_vector_type(4)));
typedef unsigned u32x2 __attribute__((ext_vector_type(2)));

constexpr int DM = 1024, NB = 4, SEQ = 4096, DB = 128, DS = 8, PAST = 2048, PAGE = 128, NPAGE = 16, NPHYS = 2560;
constexpr int MP = NB * SEQ, MS = DB * DS, M = MP + MS;
constexpr int GH = 8, GDK = 128, GQKV = 3072, GIN = 4112, GINP = 4352;
constexpr int NIN = 1840, NINP = 2048;
constexpr int FF = 2816, FF2 = 5632;
constexpr int NCMP_P = 255, NCMP_S = 127, NSEL_P = 64, NSEL_S = 33;
constexpr int SLC_S_ROWS = 2112, WIN_S_ROWS = 576;
constexpr int NCHUNK = NB * GH * 64;

constexpr size_t O_Y = 0, O_KVP = 17825792, O_KVS = 34603008, O_WINP = 35651584, O_WINS = 36700160, O_GSP = 70254592, O_GSS = 71303168, O_GCP = 104857600, O_GCS = 104931328;

constexpr size_t al256(size_t x) { return (x + 255) & ~(size_t)255; }
constexpr size_t WS_CTL = 0, CTL_BYTES = 1u << 20;
constexpr size_t SZ_WG_IN = (size_t)GINP * DM * 2, SZ_W1K = (size_t)DM * DM * 2, SZ_WN_IN = (size_t)NINP * DM * 2, SZ_WF_IN = (size_t)FF2 * DM * 2, SZ_WF_OUT = (size_t)DM * FF * 2, SZ_WC1 = (size_t)512 * 1024 * 2;
constexpr size_t WS_WG_IN = WS_CTL + CTL_BYTES;
constexpr size_t WS_WG_OUT = WS_WG_IN + 2 * SZ_WG_IN;
constexpr size_t WS_WN_IN = WS_WG_OUT + 2 * SZ_W1K;
constexpr size_t WS_WN_OUT = WS_WN_IN + 2 * SZ_WN_IN;
constexpr size_t WS_WF_IN = WS_WN_OUT + 2 * SZ_W1K;
constexpr size_t WS_WF_OUT = WS_WF_IN + 4 * SZ_WF_IN;
constexpr size_t WS_WC1 = WS_WF_OUT + 4 * SZ_WF_OUT;
constexpr size_t WS_CBIAS = WS_WC1 + 4 * SZ_WC1;
constexpr size_t WS_X = WS_CBIAS + 4096;
constexpr size_t WS_XN = WS_X + (size_t)M * DM * 4;
constexpr size_t WS_H = WS_XN + (size_t)M * DM * 2;
constexpr size_t WS_FFH = WS_H + (size_t)M * GINP * 2;
constexpr size_t WS_AO = WS_FFH + (size_t)M * FF * 2;
constexpr size_t WS_QH = WS_AO + (size_t)M * DM * 2;
constexpr size_t WS_KH = WS_QH + (size_t)M * DM * 2;
constexpr size_t WS_VH = WS_KH + (size_t)M * DM * 2;
constexpr size_t WS_BETA = WS_VH + (size_t)M * DM * 2;
constexpr size_t WS_LOGA = WS_BETA + (size_t)M * 8 * 4;
constexpr size_t WS_OG = WS_LOGA + (size_t)M * 8 * 4;
constexpr size_t WS_CW = WS_OG + (size_t)M * DM * 4;
constexpr size_t WS_CUT = WS_CW + (size_t)NCHUNK * 64 * 128 * 2;
constexpr size_t WS_CAQK = WS_CUT + (size_t)NCHUNK * 128 * 64 * 4;
constexpr size_t WS_CQT = WS_CAQK + (size_t)NCHUNK * 64 * 64 * 2;
constexpr size_t WS_CKTT = WS_CQT + (size_t)NCHUNK * 64 * 128 * 2;
constexpr size_t WS_CEGL = WS_CKTT + (size_t)NCHUNK * 128 * 64 * 2;
constexpr size_t WS_CMPP = WS_CEGL + (size_t)NCHUNK * 4;
constexpr size_t SZ_CMPS = (size_t)DB * PAST * 256 * 2;
constexpr size_t WS_CMPS = WS_CMPP + (size_t)MP * 256 * 2;
constexpr size_t SZ_SLC_S = (size_t)DB * 2 * SLC_S_ROWS * 64 * 2;
constexpr size_t WS_KSLC_S = WS_CMPS + 2 * SZ_CMPS;
constexpr size_t WS_VSLCT_S = WS_KSLC_S + 2 * SZ_SLC_S;
constexpr size_t SZ_WIN_S = (size_t)DB * 2 * WIN_S_ROWS * 64 * 2;
constexpr size_t WS_KWIN_S = WS_VSLCT_S + 2 * SZ_SLC_S;
constexpr size_t WS_VWINT_S = WS_KWIN_S + 2 * SZ_WIN_S;
constexpr size_t WS_VSLCT_P = WS_VWINT_S + 2 * SZ_WIN_S;
constexpr size_t WS_VWINT_P = WS_VSLCT_P + (size_t)NB * 2 * 64 * SEQ * 2;
constexpr size_t WS_PC_P = WS_VWINT_P + (size_t)NB * 2 * 64 * SEQ * 2;
constexpr size_t WS_PC_S = WS_PC_P + (size_t)4 * 1024 * 512 * 2;
constexpr size_t WS_KC_P = WS_PC_S + (size_t)4 * 16384 * 512 * 2;
constexpr size_t WS_VCT_P = WS_KC_P + (size_t)NB * 2 * 256 * 64 * 2;
constexpr size_t WS_KC_S = WS_VCT_P + (size_t)NB * 2 * 256 * 64 * 2;
constexpr size_t WS_VCT_S = WS_KC_S + (size_t)DB * 2 * 128 * 64 * 2;
constexpr size_t WS_END = WS_VCT_S + (size_t)DB * 2 * 128 * 64 * 2;

constexpr int CW_BAR = 4096;

constexpr int RING_BYTES = 131072, MISC_OFF = RING_BYTES + 320, LDS_BYTES = 147456;
constexpr int PTAB_OFF = RING_BYTES + 1024;

typedef __bf16 hwbf16x2 __attribute__((ext_vector_type(2)));
DI unsigned pk2(float lo, float hi) { const f32x2 v = {lo, hi}; return __builtin_bit_cast(unsigned, __builtin_convertvector(v, hwbf16x2)); }
DI unsigned f2bf(float f) { return pk2(f, f) & 0xffffu; }
DI float bf2f(unsigned b) { return __builtin_bit_cast(float, b << 16); }
DI float bflo(unsigned w) { return __builtin_bit_cast(float, w << 16); }
DI float bfhi(unsigned w) { return __builtin_bit_cast(float, w & 0xffff0000u); }
template <int CTRL> DI float dppf(float x) { return __builtin_bit_cast(float, __builtin_amdgcn_update_dpp(0, __builtin_bit_cast(int, x), CTRL, 0xF, 0xF, true)); }
DI float sum16(float x) { x += dppf<0xB1>(x); x += dppf<0x4E>(x); x += dppf<0x141>(x); x += dppf<0x140>(x); return x; }
DI float xor16_sum(float x) { auto s = __builtin_amdgcn_permlane16_swap(__float_as_uint(x), __float_as_uint(x), false, false); const unsigned s0 = s[0], s1 = s[1];
    return __uint_as_float(s0) + __uint_as_float(s1); }
DI float xor32_sum(float x) { auto s = __builtin_amdgcn_permlane32_swap(__float_as_uint(x), __float_as_uint(x), false, false); const unsigned s0 = s[0], s1 = s[1];
    return __uint_as_float(s0) + __uint_as_float(s1); }
DI float xor32_max(float x) { auto s = __builtin_amdgcn_permlane32_swap(__float_as_uint(x), __float_as_uint(x), false, false); const unsigned s0 = s[0], s1 = s[1];
    return fmaxf(__uint_as_float(s0), __uint_as_float(s1)); }
DI float sum32(float x) { return xor16_sum(sum16(x)); }
DI float wave_sum(float v) { return xor32_sum(sum32(v)); }
DI float sigmoidf_(float x) { return __builtin_amdgcn_rcpf(1.f + __expf(-x)); }
DI float siluf_(float x) { return x * __builtin_amdgcn_rcpf(1.f + __expf(-x)); }
#define LDS_WAIT() asm volatile("s_waitcnt lgkmcnt(0)" ::: "memory")
#define VM_WAIT() asm volatile("s_waitcnt vmcnt(0)" ::: "memory")

namespace pg8 {
constexpr int BM = 256, BK = 64, HALF = 128, HTB = HALF * BK * 2, STAGE_BYTES = 8 * HTB, NXCD = 8, WGM = 8;
DI int lds_byte(int r, int c) { const int st = (r >> 4) * 2 + (c >> 5), rr = r & 15, cc = c & 31, ob = rr * 64 + cc * 2; return st * 1024 + (ob ^ (((ob >> 9) & 1) << 5)); }
DI void stage_rc(int b, int& R, int& C) { const int st = b / 1024, sb = b % 1024, swz = sb ^ (((sb >> 9) & 1) << 5); R = (st >> 1) * 16 + swz / 64; C = (st & 1) * 32 + (swz % 64) / 2; }
DI int perm32(int rho) { const int n = rho >> 4, i = rho & 15; return 8 * (i >> 2) + 4 * n + (i & 3); }

struct Unit { int pm, pn, z; const char* A; const char* B; char* C; };
struct Gemm { int K; int lda; int kstepA; };

struct StaticOrder {
    int nM, nN, nwg, G, c, K, lda; const char* A; const char* B; char* C;
    DI void init(int M_, int N_, int G_, int c_, const void* A_, const void* B_, void* C_, int K_, int lda_) { nM = M_ / BM; nN = N_ / BM; nwg = nM * nN; G = G_; c = c_; A = (const char*)A_; B = (const char*)B_; C = (char*)C_; K = K_; lda = lda_; }
    DI bool next(int i, Unit& u) const {
        const long L = (long)i * G + c; if (L >= nwg) return false;
        int wgid = (int)L; { const int q = nwg / NXCD, r = nwg % NXCD, xcd = wgid % NXCD, off = wgid / NXCD; wgid = (xcd < r ? xcd * (q + 1) : r * (q + 1) + (xcd - r) * q) + off; }
        const int nig = WGM * nN, gid = wgid / nig, fm = gid * WGM, gsz = (nM - fm) < WGM ? (nM - fm) : WGM;
        u.pm = fm + ((wgid % nig) % gsz); u.pn = (wgid % nig) / gsz; u.z = 0;
        u.A = A + (size_t)u.pm * BM * lda * 2; u.B = B + (size_t)u.pn * BM * K * 2; u.C = C; return true;
    }
};

DI unsigned cvt_pk_bf16(float lo, float hi) { unsigned r; asm volatile("v_cvt_pk_bf16_f32 %0, %1, %2" : "=v"(r) : "v"(lo), "v"(hi)); return r; }

struct EpiBf16 {
    static constexpr bool PERM = true; static constexpr bool INIT = false;
    int ldc;
    DI void operator()(const f32x4 (&acc)[2][2][4][2], const Unit& u, int wr, int wc, int fr, int fq) const {
        const int row0 = u.pm * BM + wr * 64 + fr, col0 = u.pn * BM + wc * 32 + 8 * fq;
#pragma unroll
        for (int ai = 0; ai < 2; ++ai)
#pragma unroll
            for (int m = 0; m < 4; ++m) { bf16* rowp = (bf16*)u.C + (size_t)(row0 + ai * HALF + m * 16) * ldc + col0;
#pragma unroll
                for (int bj = 0; bj < 2; ++bj) { const f32x4 v0 = acc[ai][bj][m][0], v1 = acc[ai][bj][m][1];
                    u32x4 w; w.x = cvt_pk_bf16(v0[0], v0[1]); w.y = cvt_pk_bf16(v0[2], v0[3]); w.z = cvt_pk_bf16(v1[0], v1[1]); w.w = cvt_pk_bf16(v1[2], v1[3]);
                    *(u32x4*)(rowp + bj * HALF) = w; } }
    }
};
struct EpiSwiglu {
    static constexpr bool PERM = true; static constexpr bool INIT = false;
    bf16* O; int ldc;
    DI void operator()(const f32x4 (&acc)[2][2][4][2], const Unit& u, int wr, int wc, int fr, int fq) const {
        const int row0 = u.pm * BM + wr * 64 + fr, col0 = u.pn * HALF + wc * 32 + 8 * fq;
#pragma unroll
        for (int ai = 0; ai < 2; ++ai)
#pragma unroll
            for (int m = 0; m < 4; ++m) { bf16* rowp = O + (size_t)(row0 + ai * HALF + m * 16) * ldc + col0;
                float o[8];
#pragma unroll
                for (int n = 0; n < 2; ++n)
#pragma unroll
                    for (int e = 0; e < 4; ++e) { const float g = acc[ai][0][m][n][e], uu = acc[ai][1][m][n][e]; o[n * 4 + e] = g * __builtin_amdgcn_rcpf(1.f + __expf(-g)) * uu; }
                u32x4 w; w.x = cvt_pk_bf16(o[0], o[1]); w.y = cvt_pk_bf16(o[2], o[3]); w.z = cvt_pk_bf16(o[4], o[5]); w.w = cvt_pk_bf16(o[6], o[7]);
                *(u32x4*)rowp = w; }
    }
};
struct EpiResid {
    static constexpr bool PERM = false;
    static constexpr bool INIT = true;
    float* X;
    DI void init(f32x4 (&acc)[2][2][4][2], const Unit& u, int wr, int wc, int fr, int fq) const {
        const int row0 = u.pm * BM + wr * 64 + fr, col0 = u.pn * BM + wc * 32 + 4 * fq;
#pragma unroll
        for (int ai = 0; ai < 2; ++ai)
#pragma unroll
            for (int m = 0; m < 4; ++m) { const float* rowp = X + (size_t)(row0 + ai * HALF + m * 16) * DM + col0;
#pragma unroll
                for (int bj = 0; bj < 2; ++bj)
#pragma unroll
                    for (int n = 0; n < 2; ++n) acc[ai][bj][m][n] = *(const f32x4*)(rowp + bj * HALF + n * 16); }
    }
    DI void operator()(const f32x4 (&acc)[2][2][4][2], const Unit& u, int wr, int wc, int fr, int fq) const {
        const int row0 = u.pm * BM + wr * 64 + fr, col0 = u.pn * BM + wc * 32 + 4 * fq;
#pragma unroll
        for (int ai = 0; ai < 2; ++ai)
#pragma unroll
            for (int m = 0; m < 4; ++m) { float* rowp = X + (size_t)(row0 + ai * HALF + m * 16) * DM + col0;
#pragma unroll
                for (int bj = 0; bj < 2; ++bj)
#pragma unroll
                    for (int n = 0; n < 2; ++n) *(f32x4*)(rowp + bj * HALF + n * 16) = acc[ai][bj][m][n]; }
    }
};
struct EpiNsaIn {
    static constexpr bool PERM = true; static constexpr bool INIT = false;
    bf16* H; float* out; bf16* cmpp; int li;
    DI void operator()(const f32x4 (&acc)[2][2][4][2], const Unit& u, int wr, int wc, int fr, int fq) const {
        const int row0 = u.pm * BM + wr * 64 + fr, col0 = u.pn * BM + wc * 32 + 8 * fq;
        const bool smp = u.pm >= MP / BM;
#pragma unroll
        for (int ai = 0; ai < 2; ++ai)
#pragma unroll
            for (int m = 0; m < 4; ++m) { const int row = row0 + ai * HALF + m * 16; bf16* rowp = H + (size_t)row * NINP + col0;
                float* o = nullptr;
                if (u.pn == 4 || u.pn == 5) o = (smp ? out + O_KVS + (size_t)li * MS * 512 + (size_t)(row - MP) * 512 : out + O_KVP + (size_t)li * MP * 512 + (size_t)row * 512) + (col0 - 1024);
                else if (u.pn == 6) {
                    if (smp) { const int rs = row - MP; o = out + O_WINS + ((size_t)(li * DB + (rs >> 3)) * 512 + 504 + (rs & 7)) * 256 + (col0 - 1536); }
                    else { const int t = row & 4095; if (t >= SEQ - 512) o = out + O_WINP + ((size_t)(li * NB + (row >> 12)) * 512 + (t - (SEQ - 512))) * 256 + (col0 - 1536); } }
#pragma unroll
                for (int bj = 0; bj < 2; ++bj) { const float qs = u.pn < 4 ? 0.18033688011112042f : 1.f;
                    const f32x4 v0 = acc[ai][bj][m][0] * qs, v1 = acc[ai][bj][m][1] * qs;
                    u32x4 w; w.x = cvt_pk_bf16(v0[0], v0[1]); w.y = cvt_pk_bf16(v0[2], v0[3]); w.z = cvt_pk_bf16(v1[0], v1[1]); w.w = cvt_pk_bf16(v1[2], v1[3]);
                    *(u32x4*)(rowp + bj * HALF) = w;
                    if (o) { *(f32x4*)(o + bj * HALF) = v0; *(f32x4*)(o + bj * HALF + 4) = v1; }
                    if (u.pn == 4 && !smp) *(u32x4*)(cmpp + (size_t)row * 256 + (col0 - 1024) + bj * HALF) = w; } }
    }
};

template <class Epi, class Sched>
DI void gemm_phase(LAS unsigned char* lds, const Gemm g, const Sched& S, const Epi& E) {
    int tid_ = threadIdx.x; asm volatile("" : "+v"(tid_)); const int tid = tid_, wid = __builtin_amdgcn_readfirstlane(tid >> 6), lane = tid & 63, wr = wid >> 2, wc = wid & 3, fr = lane & 15, fq = lane >> 4;
    const int K = g.K, nt = K / BK;
    unsigned voffA[2], voffB[2];
#pragma unroll
    for (int i = 0; i < 2; ++i) { int R, C; stage_rc(tid * 16 + i * 8192, R, C); const int Rb = Epi::PERM ? ((R & ~31) + perm32(R & 31)) : R;
        voffA[i] = (unsigned)(R * g.lda + C) * 2u; voffB[i] = (unsigned)(Rb * K + C) * 2u; }
    const size_t kstepA = (size_t)g.kstepA, kstepB = (size_t)(BK * 2);
    const size_t hstepA = (size_t)HALF * g.lda * 2, hstepB = (size_t)HALF * K * 2;
    const unsigned ldsw = (unsigned)wid * 1024u;
    const int aoff = lds_byte(wr * 64 + fr, fq * 8), boff = lds_byte(wc * 32 + fr, fq * 8);
#define PG8_SA(b, h) (((b) * 2 + (h)) * HTB)
#define PG8_SB(b, h) ((4 + (b) * 2 + (h)) * HTB)
#define PG8_STAGE(bufoff, gbase, voff) do { _Pragma("unroll") for (int _i = 0; _i < 2; ++_i) \
        __builtin_amdgcn_global_load_lds((const unsigned*)((const char*)(gbase) + (voff)[_i]), (LAS unsigned*)(lds + (bufoff) + ldsw + _i * 8192), 16, 0, 0); } while (0)
#define PG8_LDA(dst, b, h) do { _Pragma("unroll") for (int m = 0; m < 4; ++m) _Pragma("unroll") for (int k = 0; k < 2; ++k) dst[m][k] = *(const LAS bf16x8*)(lds + PG8_SA(b, h) + aoff + m * 2048 + k * 1024); } while (0)
#define PG8_LDB(dst, b, h) do { _Pragma("unroll") for (int n = 0; n < 2; ++n) _Pragma("unroll") for (int k = 0; k < 2; ++k) dst[n][k] = *(const LAS bf16x8*)(lds + PG8_SB(b, h) + boff + n * 2048 + k * 1024); } while (0)
#define PG8_MMA(ai, bj, At, Bt) do { __builtin_amdgcn_s_setprio(1); _Pragma("unroll") for (int m = 0; m < 4; ++m) _Pragma("unroll") for (int n = 0; n < 2; ++n) _Pragma("unroll") for (int k = 0; k < 2; ++k) \
        acc[ai][bj][m][n] = __builtin_amdgcn_mfma_f32_16x16x32_bf16(Bt[n][k], At[m][k], acc[ai][bj][m][n], 0, 0, 0); __builtin_amdgcn_s_setprio(0); } while (0)
#define PG8_WAIT_V(n) asm volatile("s_waitcnt vmcnt(" #n ")" ::: "memory")
#define PG8_WAIT_L(n) asm volatile("s_waitcnt lgkmcnt(" #n ")" ::: "memory")
#define PG8_BAR __builtin_amdgcn_s_barrier()
#define PG8_SCHED __builtin_amdgcn_sched_barrier(0)
    Unit cur, nxt; int ui = 0;
    if (!S.next(0, cur)) return;
    f32x4 acc[2][2][4][2];
    if constexpr (Epi::INIT) E.init(acc, cur, wr, wc, fr, fq);
    else {
#pragma unroll
    for (int a = 0; a < 2; ++a)
#pragma unroll
        for (int b = 0; b < 2; ++b)
#pragma unroll
            for (int m = 0; m < 4; ++m)
#pragma unroll
                for (int n = 0; n < 2; ++n) acc[a][b][m][n] = (f32x4){0.f, 0.f, 0.f, 0.f};
    }
    bf16x8 At[4][2], B0[2][2], B1[2][2];
    const char* cA = cur.A; const char* cB = cur.B;
    PG8_STAGE(PG8_SB(0, 0), cB, voffB); PG8_STAGE(PG8_SA(0, 0), cA, voffA); PG8_STAGE(PG8_SB(0, 1), cB + hstepB, voffB); PG8_STAGE(PG8_SA(0, 1), cA + hstepA, voffA);
    if (wr == 1) PG8_BAR;
    PG8_WAIT_V(4); PG8_BAR;
    PG8_STAGE(PG8_SB(1, 0), cB + kstepB, voffB); PG8_STAGE(PG8_SA(1, 0), cA + kstepA, voffA); PG8_STAGE(PG8_SB(1, 1), cB + hstepB + kstepB, voffB);
    if constexpr (Epi::INIT) __builtin_amdgcn_s_waitcnt(0x0F76);
    else PG8_WAIT_V(6);
    PG8_BAR;
    for (;;) {
        const bool has_next = S.next(ui + 1, nxt);
        const char* nA = has_next ? nxt.A : cA; const char* nB = has_next ? nxt.B : cB;
        for (int t = 0; t < nt; t += 2) {
            const bool last = (t == nt - 2);
            const char* a1 = cA + (size_t)(t + 1) * kstepA;
            const char* a2 = last ? nA : cA + (size_t)(t + 2) * kstepA; const char* b2 = last ? nB : cB + (size_t)(t + 2) * kstepB;
            const char* a3 = a2 + kstepA; const char* b3 = b2 + kstepB;
            PG8_LDB(B0, 0, 0); PG8_SCHED; PG8_LDA(At, 0, 0); PG8_STAGE(PG8_SA(1, 1), a1 + hstepA, voffA);
            PG8_WAIT_L(8); PG8_BAR; PG8_WAIT_L(0); PG8_MMA(0, 0, At, B0); PG8_BAR; PG8_SCHED;
            PG8_LDB(B1, 0, 1); PG8_STAGE(PG8_SB(0, 0), b2, voffB);
            PG8_BAR; PG8_WAIT_L(0); PG8_MMA(0, 1, At, B1); PG8_BAR;
            PG8_LDA(At, 0, 1); PG8_STAGE(PG8_SA(0, 0), a2, voffA);
            PG8_BAR; PG8_WAIT_L(0); PG8_MMA(1, 0, At, B0); PG8_BAR; PG8_SCHED;
            PG8_STAGE(PG8_SB(0, 1), b2 + hstepB, voffB);
            PG8_WAIT_V(6); PG8_BAR; PG8_MMA(1, 1, At, B1); PG8_BAR;
            PG8_LDB(B0, 1, 0); PG8_SCHED; PG8_LDA(At, 1, 0); PG8_STAGE(PG8_SA(0, 1), a2 + hstepA, voffA);
            PG8_WAIT_L(8); PG8_BAR; PG8_WAIT_L(0); PG8_MMA(0, 0, At, B0); PG8_BAR; PG8_SCHED;
            PG8_LDB(B1, 1, 1); PG8_STAGE(PG8_SB(1, 0), b3, voffB);
            PG8_BAR; PG8_WAIT_L(0); PG8_MMA(0, 1, At, B1); PG8_BAR;
            PG8_LDA(At, 1, 1); PG8_STAGE(PG8_SA(1, 0), a3, voffA);
            PG8_BAR; PG8_WAIT_L(0); PG8_MMA(1, 0, At, B0); PG8_BAR; PG8_SCHED;
            PG8_STAGE(PG8_SB(1, 1), b3 + hstepB, voffB);
            PG8_WAIT_V(6); PG8_BAR; PG8_MMA(1, 1, At, B1); PG8_BAR;
        }
        E(acc, cur, wr, wc, fr, fq);
        if (!has_next) break;
        if constexpr (Epi::INIT) { E.init(acc, nxt, wr, wc, fr, fq); __builtin_amdgcn_s_waitcnt(0x0070); }
        else {
#pragma unroll
        for (int a = 0; a < 2; ++a)
#pragma unroll
            for (int b = 0; b < 2; ++b)
#pragma unroll
                for (int m = 0; m < 4; ++m)
#pragma unroll
                    for (int n = 0; n < 2; ++n) acc[a][b][m][n] = (f32x4){0.f, 0.f, 0.f, 0.f};
        }
        cur = nxt; cA = nA; cB = nB; ++ui;
    }
    PG8_WAIT_V(0);
    if (wr == 0) PG8_BAR;
    PG8_BAR;
#undef PG8_SA
#undef PG8_SB
#undef PG8_STAGE
#undef PG8_LDA
#undef PG8_LDB
#undef PG8_MMA
#undef PG8_WAIT_V
#undef PG8_WAIT_L
#undef PG8_BAR
#undef PG8_SCHED
}
}

#define XB_TMO      128
#define XB_XCNT(j)  (256  + 64 * (j))
#define XB_XSUB(j)  (1280 + 64 * (j))
#define XB_XGEN(j)  (2304 + 64 * (j))
#define XB_TOP      3328
#define XB_TOPGEN   3392
#define XCD_BAR_WORDS 3456
#define XB_SPIN_CAP (1u << 18)
DI unsigned xb_ld(unsigned* p)              { return __hip_atomic_load(p, __ATOMIC_RELAXED, __HIP_MEMORY_SCOPE_AGENT); }
DI unsigned xb_add(unsigned* p, unsigned v) { return __hip_atomic_fetch_add(p, v, __ATOMIC_RELAXED, __HIP_MEMORY_SCOPE_AGENT); }
DI unsigned xb_xcc_id() { return (unsigned)__builtin_amdgcn_s_getreg((3 << 11) | 20) & 0xFu; }
#define XB_SPIN(cond, bar) do { unsigned _sp = 0; while (cond) { __builtin_amdgcn_s_sleep(1); \
    if ((++_sp & 255u) == 0u) { if (xb_ld(&(bar)[XB_TMO])) break; if (_sp > XB_SPIN_CAP) { atomicAdd(&(bar)[XB_TMO], 1u); break; } } } } while (0)
struct XcdBarrier { unsigned* bar; unsigned x; volatile LAS unsigned* st; };
DI XcdBarrier xcd_barrier_post(unsigned* bar, volatile LAS unsigned* st) {
    XcdBarrier b; b.bar = bar; b.x = xb_xcc_id(); b.st = st;
    if (threadIdx.x == 0) (void)xb_add(&bar[XB_XCNT(b.x)], 1u);
    return b;
}
DI void xcd_barrier_complete(unsigned* bar, unsigned x, unsigned& nloc, unsigned& nx) {
    const unsigned G = gridDim.x * gridDim.y * gridDim.z;
    unsigned sum, cnt, mine, sp = 0u;
    for (;;) {
        sum = 0u; cnt = 0u; mine = 0u;
#pragma unroll
        for (unsigned j = 0; j < 16; ++j) { const unsigned c = xb_ld(&bar[XB_XCNT(j)]); sum += c; cnt += (c > 0u) ? 1u : 0u; mine = (j == x) ? c : mine; }
        if (sum == G) break;
        __builtin_amdgcn_s_sleep(1);
        if ((++sp & 255u) == 0u) { if (xb_ld(&bar[XB_TMO])) break; if (sp > XB_SPIN_CAP) { atomicAdd(&bar[XB_TMO], 1u); break; } }
    }
    nloc = mine > 0u ? mine : 1u; nx = cnt > 0u ? cnt : 1u;
}
DI void xcd_barrier(const XcdBarrier& b) {
    asm volatile("s_waitcnt vmcnt(0)" ::: "memory");
    __syncthreads();
    if (threadIdx.x == 0) {
        unsigned* bar = b.bar;
        __builtin_amdgcn_s_waitcnt(0);
        unsigned nloc = b.st[0], nx = b.st[1];
        if (nloc == 0u) { xcd_barrier_complete(bar, b.x, nloc, nx); b.st[0] = nloc; b.st[1] = nx; }
        const unsigned old = xb_add(&bar[XB_XSUB(b.x)], 1u);
        const unsigned gen = old / nloc;
        if (old + 1u == (gen + 1u) * nloc) {
            __builtin_amdgcn_fence(__ATOMIC_RELEASE, "agent");
            asm volatile("s_waitcnt vmcnt(0)" ::: "memory");
            const unsigned og = xb_add(&bar[XB_TOP], 1u);
            const unsigned tg = og / nx;
            if (og + 1u == (tg + 1u) * nx) xb_add(&bar[XB_TOPGEN], 1u);
            else XB_SPIN(xb_ld(&bar[XB_TOPGEN]) == tg, bar);
            __builtin_amdgcn_fence(__ATOMIC_ACQUIRE, "agent");
            xb_add(&bar[XB_XGEN(b.x)], 1u);
            asm volatile("s_waitcnt vmcnt(0)" ::: "memory");
        } else {
            XB_SPIN(xb_ld(&bar[XB_XGEN(b.x)]) == gen, bar);
            __builtin_amdgcn_fence(__ATOMIC_ACQUIRE, "agent");
            asm volatile("s_waitcnt vmcnt(0)" ::: "memory");
        }
    }
    __syncthreads();
}

struct P { const void* in[26]; float* out; unsigned char* ws; };
struct Frame { LAS unsigned char* lds; int tid, lane, wave, bid, G, gw, ngw; };
#define MFMA32(a, b, c) __builtin_amdgcn_mfma_f32_32x32x16_bf16((a), (b), (c), 0, 0, 0)
#define MFMA16(a, b, c) __builtin_amdgcn_mfma_f32_16x16x32_bf16((a), (b), (c), 0, 0, 0)
DI int crow(int reg, int h) { return (reg & 3) + 8 * (reg >> 2) + 4 * h; }
DI u32x2 pack4(f32x4 v) { u32x2 w; w.x = pk2(v[0], v[1]); w.y = pk2(v[2], v[3]); return w; }

DI void tr_item(const float* W, int K, int N, int ldw, bf16* WT, int dst_row0, LAS float* scr, int k0, int n0, int lane) {
    const int nn = n0 + (lane & 31); const bool ok = nn < N;
    float tv[32];
#pragma unroll
    for (int i = 0; i < 32; ++i) tv[i] = ok ? W[(size_t)(k0 + 2 * i + (lane >> 5)) * ldw + nn] : 0.f;
#pragma unroll
    for (int i = 0; i < 32; ++i) scr[(2 * i + (lane >> 5)) * 33 + (lane & 31)] = tv[i];
    LDS_WAIT();
    const int c = lane & 7;
#pragma unroll
    for (int j = 0; j < 4; ++j) { const int n = (lane >> 3) + 8 * j; const LAS float* s = scr + (8 * c) * 33 + n;
        u32x4 o; o.x = pk2(s[0 * 33], s[1 * 33]); o.y = pk2(s[2 * 33], s[3 * 33]); o.z = pk2(s[4 * 33], s[5 * 33]); o.w = pk2(s[6 * 33], s[7 * 33]);
        *(u32x4*)(WT + (size_t)(dst_row0 + n) * K + k0 + 8 * c) = o; }
    LDS_WAIT();
}
DI void p0_weights(const P& p, const Frame& F, int which) {
    LAS float* scr = (LAS float*)(F.lds + F.wave * 16384);
    constexpr int C_GIN = 16 * (GINP / 32), C_SQ = 16 * 32, C_NIN = 16 * (NINP / 32), C_FIN = 16 * (FF2 / 32), C_FOUT = (FF / 64) * 32, C_C1 = 16 * 8;
    constexpr int TOT = 2 * C_GIN + 2 * C_SQ + 2 * C_NIN + 2 * C_SQ + 4 * C_FIN + 4 * C_FOUT + 8 * C_C1;
    for (int it = F.gw; it < TOT; it += F.ngw) {
        int r = it; const float* W; int K = DM, N, Npad, ldw; bf16* WT; int mode = 0, rowoff = 0;
        bool l0 = false;
        if (r < 2 * C_GIN) { const int li = r / C_GIN; r -= li * C_GIN; l0 = li == 0; W = (const float*)p.in[10] + (size_t)li * DM * GIN; N = GIN; Npad = GINP; ldw = GIN; WT = (bf16*)(p.ws + WS_WG_IN + li * SZ_WG_IN); }
        else if ((r -= 2 * C_GIN) < 2 * C_SQ) { const int li = r / C_SQ; r -= li * C_SQ; l0 = li == 0; W = (const float*)p.in[15] + (size_t)li * DM * DM; N = DM; Npad = DM; ldw = DM; WT = (bf16*)(p.ws + WS_WG_OUT + li * SZ_W1K); }
        else if ((r -= 2 * C_SQ) < 2 * C_NIN) { const int li = r / C_NIN; r -= li * C_NIN; W = (const float*)p.in[16] + (size_t)li * DM * NIN; N = NIN; Npad = NINP; ldw = NIN; WT = (bf16*)(p.ws + WS_WN_IN + li * SZ_WN_IN); }
        else if ((r -= 2 * C_NIN) < 2 * C_SQ) { const int li = r / C_SQ; r -= li * C_SQ; W = (const float*)p.in[23] + (size_t)li * DM * DM; N = DM; Npad = DM; ldw = DM; WT = (bf16*)(p.ws + WS_WN_OUT + li * SZ_W1K); }
        else if ((r -= 2 * C_SQ) < 4 * C_FIN) { const int i = r / C_FIN; r -= i * C_FIN; l0 = i == 0; W = (const float*)p.in[24] + (size_t)i * DM * FF2; N = FF2; Npad = FF2; ldw = FF2; WT = (bf16*)(p.ws + WS_WF_IN + i * SZ_WF_IN); mode = 1; }
        else if ((r -= 4 * C_FIN) < 4 * C_FOUT) { const int i = r / C_FOUT; r -= i * C_FOUT; l0 = i == 0; W = (const float*)p.in[25] + (size_t)i * FF * DM; K = FF; N = DM; Npad = DM; ldw = DM; WT = (bf16*)(p.ws + WS_WF_OUT + i * SZ_WF_OUT); }
        else { r -= 4 * C_FOUT; const int id = r / C_C1; r -= id * C_C1; const int li = id >> 2, kv = (id >> 1) & 1, half = id & 1;
            W = (const float*)(kv ? p.in[21] : p.in[19]) + (size_t)li * 2048 * 256 + (size_t)half * 1024 * 256; N = 256; Npad = 256; ldw = 256; WT = (bf16*)(p.ws + WS_WC1 + (li * 2 + kv) * SZ_WC1); rowoff = half * 256; }
        if (l0 != (which == 0)) continue;
        const int nblk = Npad / 32, kb = r / nblk, nb = r % nblk, n0 = nb * 32;
        int drow = n0 + rowoff;
        if (mode == 1) { const int j = n0 < FF ? n0 : n0 - FF; drow = 256 * (j >> 7) + (j & 127) + (n0 < FF ? 0 : 128); }
        tr_item(W, K, N, ldw, WT, drow, scr, kb * 64, n0, F.lane);
    }
}
DI void p0_cbias(const P& p, const Frame& F) {
    LAS float* red = (LAS float*)F.lds;
    float* part = (float*)(p.ws + WS_PC_P);
    for (int t = F.bid; t < 256; t += F.G) {
        const int id = t >> 6, sl = t & 63, li = id >> 1, kv = id & 1, c = F.tid & 255, half = F.tid >> 8;
        const float* w1 = (const float*)(kv ? p.in[21] : p.in[19]) + (size_t)li * 2048 * 256; const float* pe = (const float*)(kv ? p.in[18] : p.in[17]) + (size_t)li * 2048;
        const int k0 = sl * 32 + half * 16; float acc = 0.f;
#pragma unroll
        for (int kk = 0; kk < 16; ++kk) acc += pe[k0 + kk] * w1[(size_t)(k0 + kk) * 256 + c];
        red[F.tid] = acc; __syncthreads();
        if (F.tid < 256) part[(size_t)t * 256 + c] = red[F.tid] + red[F.tid + 256];
        __syncthreads();
    }
}
DI void p0_cbias2(const P& p, const Frame& F) {
    const float* part = (const float*)(p.ws + WS_PC_P);
    for (int id = F.bid; id < 4; id += F.G) if (F.tid < 256) { float acc = 0.f;
#pragma unroll 16
        for (int sl = 0; sl < 64; ++sl) acc += part[(size_t)(id * 64 + sl) * 256 + F.tid];
        ((float*)(p.ws + WS_CBIAS))[id * 256 + F.tid] = acc; }
}
DI void cache_kv_item(const P& p, int li, int id, int lane, int phys_in = -1) {
    const int* pt = (const int*)p.in[6];
    bf16* cmps = (bf16*)(p.ws + WS_CMPS + li * SZ_CMPS); bf16* kslc = (bf16*)(p.ws + WS_KSLC_S + li * SZ_SLC_S); bf16* vslc = (bf16*)(p.ws + WS_VSLCT_S + li * SZ_SLC_S);
    const int b = id >> 8, pg = (id >> 4) & 15, s8 = id & 15;
    const int phys = phys_in >= 0 ? phys_in : pt[b * NPAGE + pg];
    const float* src = (const float*)p.in[2] + (((size_t)li * NPHYS + phys) * PAGE + s8 * 8) * 512;
    f32x4 a[8], c[8];
#pragma unroll
    for (int rr = 0; rr < 8; ++rr) { a[rr] = *(const f32x4*)(src + (size_t)rr * 512 + lane * 4); c[rr] = *(const f32x4*)(src + (size_t)rr * 512 + 256 + lane * 4); }
    const int kind = lane >> 5, g = (lane >> 4) & 1, d = (lane & 15) * 4;
    bf16* dst2 = (kind ? vslc : kslc) + (size_t)(b * 2 + g) * SLC_S_ROWS * 64 + d;
#pragma unroll
    for (int rr = 0; rr < 8; ++rr) { const int pos = pg * PAGE + s8 * 8 + rr;
        *(u32x2*)(cmps + ((size_t)b * PAST + pos) * 256 + lane * 4) = pack4(a[rr]);
        *(u32x2*)(dst2 + (size_t)pos * 64) = pack4(c[rr]); }
}
DI void p0_cache_win(const P& p, const Frame& F, int li) {
    bf16* kwin = (bf16*)(p.ws + WS_KWIN_S + li * SZ_WIN_S); bf16* vwin = (bf16*)(p.ws + WS_VWINT_S + li * SZ_WIN_S);
    for (int id = F.gw; id < DB * 64; id += F.ngw) {
        const int b = id >> 6, r8 = id & 63;
        const float* src = (const float*)p.in[3] + (((size_t)li * DB + b) * 512 + r8 * 8) * 256;
        float* outw = p.out + O_WINS + (size_t)(li * DB + b) * 512 * 256;
        f32x4 a[8];
#pragma unroll
        for (int rr = 0; rr < 8; ++rr) a[rr] = *(const f32x4*)(src + (size_t)rr * 256 + F.lane * 4);
        const int kind = F.lane >> 5, g = (F.lane >> 4) & 1, d = (F.lane & 15) * 4;
        bf16* dst2 = (kind ? vwin : kwin) + (size_t)(b * 2 + g) * WIN_S_ROWS * 64 + d;
#pragma unroll
        for (int rr = 0; rr < 8; ++rr) { const int idx = r8 * 8 + rr;
            if (idx >= 8) *(f32x4*)(outw + (size_t)(idx - 8) * 256 + F.lane * 4) = a[rr];
            *(u32x2*)(dst2 + (size_t)idx * 64) = pack4(a[rr]); }
    }
}
template <int MODE> DI void rms_phase(const P& p, const Frame& F, const float* w) {
    float* X = (float*)(p.ws + WS_X); bf16* XN = (bf16*)(p.ws + WS_XN);
    f32x4 wv[4];
#pragma unroll
    for (int j = 0; j < 4; ++j) wv[j] = ((const f32x4*)w)[F.lane + 64 * j];
    for (int row = F.gw; row < M; row += F.ngw) {
        const float* src = MODE == 0 ? (row < MP ? (const float*)p.in[0] + (size_t)row * DM : (const float*)p.in[1] + (size_t)(row - MP) * DM) : X + (size_t)row * DM;
        f32x4 v[4]; float ss = 0.f;
#pragma unroll
        for (int j = 0; j < 4; ++j) { v[j] = ((const f32x4*)src)[F.lane + 64 * j]; ss += (v[j][0] * v[j][0] + v[j][1] * v[j][1]) + (v[j][2] * v[j][2] + v[j][3] * v[j][3]); }
        const float rstd = __builtin_amdgcn_rsqf(wave_sum(ss) * (1.f / DM) + 1e-6f);
#pragma unroll
        for (int j = 0; j < 4; ++j) { const f32x4 o = v[j] * rstd * wv[j];
            if (MODE == 2) ((f32x4*)(p.out + O_Y + (size_t)row * DM))[F.lane + 64 * j] = o;
            else ((u32x2*)(XN + (size_t)row * DM))[F.lane + 64 * j] = pack4(o);
            if (MODE == 0) ((f32x4*)(X + (size_t)row * DM))[F.lane + 64 * j] = v[j]; }
    }
}

DI void gdn_prep(const P& p, const Frame& F, int li) {
    const bf16* H = (const bf16*)(p.ws + WS_H);
    bf16* QH = (bf16*)(p.ws + WS_QH); bf16* KH = (bf16*)(p.ws + WS_KH); bf16* VH = (bf16*)(p.ws + WS_VH);
    float* BETA = (float*)(p.ws + WS_BETA); float* LOGA = (float*)(p.ws + WS_LOGA);
    const float* cw = (const float*)p.in[11] + (size_t)li * 4 * GQKV;
    const float* cbuf = (const float*)p.in[5] + (size_t)li * DB * 3 * GQKV;
    const float* Alog = (const float*)p.in[12] + li * 8; const float* dtb = (const float*)p.in[13] + li * 8;
    LAS float* wl = (LAS float*)F.lds;
    for (int i = F.tid; i < 4 * GQKV / 4; i += 512) ((LAS f32x4*)wl)[i] = ((const f32x4*)cw)[i];
    __syncthreads();
    for (int row = F.gw; row < M; row += F.ngw) {
        int b, t; const bool smp = row >= MP;
        if (!smp) { b = row >> 12; t = row & 4095; } else { b = (row - MP) >> 3; t = (row - MP) & 7; }
        u32x4 xr[4][6];
#pragma unroll
        for (int k = 0; k < 4; ++k) { const int tt = t - 3 + k;
#pragma unroll
            for (int cc = 0; cc < 6; ++cc) { const int c = (cc >> 1) * 1024 + ((cc & 1) * 64 + F.lane) * 8;
                if (tt >= 0) xr[k][cc] = *(const u32x4*)(H + (size_t)(row - 3 + k) * GINP + c);
                else if (smp) { const float* s = cbuf + ((size_t)b * 3 + (3 + tt)) * GQKV + c; const f32x4 v0 = *(const f32x4*)s, v1 = *(const f32x4*)(s + 4);
                    xr[k][cc] = (u32x4){pk2(v0[0], v0[1]), pk2(v0[2], v0[3]), pk2(v1[0], v1[1]), pk2(v1[2], v1[3])}; }
                else xr[k][cc] = (u32x4){0u, 0u, 0u, 0u}; } }
#pragma unroll
        for (int part = 0; part < 3; ++part) {
            asm volatile("" ::: "memory");
            float y[2][8]; float ss[2];
#pragma unroll
            for (int k2 = 0; k2 < 2; ++k2) { const int cc = part * 2 + k2, c = part * 1024 + (k2 * 64 + F.lane) * 8;
#pragma unroll
                for (int e = 0; e < 8; ++e) y[k2][e] = 0.f;
#pragma unroll
                for (int k = 0; k < 4; ++k) { const f32x4 w0 = *(const LAS f32x4*)(wl + k * GQKV + c), w1 = *(const LAS f32x4*)(wl + k * GQKV + c + 4); const u32x4 x = xr[k][cc];
                    y[k2][0] += w0[0] * bflo(x.x); y[k2][1] += w0[1] * bfhi(x.x); y[k2][2] += w0[2] * bflo(x.y); y[k2][3] += w0[3] * bfhi(x.y);
                    y[k2][4] += w1[0] * bflo(x.z); y[k2][5] += w1[1] * bfhi(x.z); y[k2][6] += w1[2] * bflo(x.w); y[k2][7] += w1[3] * bfhi(x.w); }
                float s2 = 0.f;
#pragma unroll
                for (int e = 0; e < 8; ++e) { y[k2][e] = siluf_(y[k2][e]); s2 += y[k2][e] * y[k2][e]; }
                s2 = sum16(s2);
                ss[k2] = s2;
                const int jo = smp ? t - (DS - 3) : t - (SEQ - 3);
                if (jo >= 0) { float* o = p.out + (smp ? O_GCS + ((size_t)(li * DB + b) * 3 + jo) * GQKV : O_GCP + ((size_t)(li * NB + b) * 3 + jo) * GQKV) + c; const u32x4 x = xr[3][cc];
                    *(f32x4*)o = (f32x4){bflo(x.x), bfhi(x.x), bflo(x.y), bfhi(x.y)}; *(f32x4*)(o + 4) = (f32x4){bflo(x.z), bfhi(x.z), bflo(x.w), bfhi(x.w)}; }
            }
            bf16* dst = part == 0 ? QH : (part == 1 ? KH : VH);
#pragma unroll
            for (int k2 = 0; k2 < 2; ++k2) { const float sc = part == 0 ? __builtin_amdgcn_rsqf(ss[k2] + 1e-6f) * 0.08838834764831845f : (part == 1 ? __builtin_amdgcn_rsqf(ss[k2] + 1e-6f) : 1.f);
                *(u32x4*)(dst + (size_t)row * DM + (k2 * 64 + F.lane) * 8) = (u32x4){pk2(y[k2][0] * sc, y[k2][1] * sc), pk2(y[k2][2] * sc, y[k2][3] * sc), pk2(y[k2][4] * sc, y[k2][5] * sc), pk2(y[k2][6] * sc, y[k2][7] * sc)}; }
        }
        if (F.lane < 8) { const int hh = F.lane;
            const float bb = bf2f(H[(size_t)row * GINP + 4096 + hh]), aa = bf2f(H[(size_t)row * GINP + 4104 + hh]) + dtb[hh];
            const float sp = aa > 20.f ? aa : log1pf(__expf(aa));
            BETA[(size_t)row * 8 + hh] = sigmoidf_(bb); LOGA[(size_t)row * 8 + hh] = -__expf(Alog[hh]) * sp; }
    }
}
DI void gdn_chunk(const P& p, const Frame& F, int li) {
    const bf16* QH = (const bf16*)(p.ws + WS_QH); const bf16* KH = (const bf16*)(p.ws + WS_KH); const bf16* VH = (const bf16*)(p.ws + WS_VH);
    const float* BETA = (const float*)(p.ws + WS_BETA); const float* LOGA = (const float*)(p.ws + WS_LOGA);
    bf16* CW = (bf16*)(p.ws + WS_CW); float* CUT = (float*)(p.ws + WS_CUT); bf16* CAQK = (bf16*)(p.ws + WS_CAQK); bf16* CQT = (bf16*)(p.ws + WS_CQT); bf16* CKTT = (bf16*)(p.ws + WS_CKTT); float* CEGL = (float*)(p.ws + WS_CEGL);
    LAS float* Gs = (LAS float*)F.lds; LAS float* bs = Gs + 64; LAS float* Lm = Gs + 128;
    for (int task = F.bid; task < NCHUNK; task += F.G) {
        const int b = task >> 9, hh = (task >> 6) & 7, c = task & 63, r0 = b * SEQ + c * 64;
        if (F.wave == 0) { float la = LOGA[(size_t)(r0 + F.lane) * 8 + hh];
#pragma unroll
            for (int o = 1; o < 64; o <<= 1) { const float tq = __shfl_up(la, o); if (F.lane >= o) la += tq; }
            const float bt = BETA[(size_t)(r0 + F.lane) * 8 + hh]; Gs[F.lane] = la; bs[F.lane] = bt; Gs[64 * 66 + F.lane] = bt * __expf(la); }
        __syncthreads();
        { const int which = F.wave >> 2, ti = (F.wave >> 1) & 1, tj = F.wave & 1, r = F.lane & 31, h = F.lane >> 5;
          const bf16* Ar = (which ? QH : KH) + (size_t)(r0 + 32 * ti + r) * DM + hh * 128 + 8 * h;
          const bf16* Br = KH + (size_t)(r0 + 32 * tj + r) * DM + hh * 128 + 8 * h;
          f32x16 cc; for (int e = 0; e < 16; ++e) cc[e] = 0.f;
#pragma unroll
          for (int ks = 0; ks < 8; ++ks) cc = MFMA32(*(const bf16x8*)(Ar + 16 * ks), *(const bf16x8*)(Br + 16 * ks), cc);
          const int j = 32 * tj + r; const float Gj = Gs[j];
#pragma unroll
          for (int reg = 0; reg < 16; ++reg) { const int i = 32 * ti + crow(reg, h); const float dec = (j <= i) ? __expf(Gs[i] - Gj) : 0.f;
              if (which == 0) Lm[i * 64 + j] = (j < i) ? bs[i] * cc[reg] * dec : 0.f;
              else CAQK[(size_t)task * 4096 + i * 64 + j] = (bf16)f2bf(cc[reg] * dec); } }
        __syncthreads();
        if (F.tid < 256) {
            const int col = F.tid; const bool isk = col < 128;
            const bf16* src = (isk ? KH : VH) + (size_t)r0 * DM + hh * 128 + (col & 127);
            const LAS float* sc2 = isk ? (Gs + 64 * 66) : bs;
            float x[64];
#pragma unroll
            for (int i = 0; i < 64; ++i) x[i] = bf2f(src[(size_t)i * DM]);
            asm volatile("" ::: "memory");
#pragma unroll
            for (int i = 0; i < 64; ++i) { float acc = x[i] * sc2[i];
#pragma unroll
                for (int j4 = 0; j4 < (i + 3) / 4; ++j4) { const f32x4 L4 = *(const LAS f32x4*)(Lm + i * 64 + 4 * j4);
                    acc -= L4[0] * x[4 * j4] + L4[1] * x[4 * j4 + 1] + L4[2] * x[4 * j4 + 2] + L4[3] * x[4 * j4 + 3]; }
                x[i] = acc; if ((i & 3) == 3) asm volatile("" ::: "memory"); }
            if (isk) {
#pragma unroll
                for (int i = 0; i < 64; ++i) CW[(size_t)task * 8192 + i * 128 + col] = (bf16)f2bf(x[i]); }
            else { float* d = CUT + ((size_t)task * 128 + (col - 128)) * 64;
#pragma unroll
                for (int i4 = 0; i4 < 16; ++i4) *(f32x4*)(d + 4 * i4) = (f32x4){x[4 * i4], x[4 * i4 + 1], x[4 * i4 + 2], x[4 * i4 + 3]}; }
        } else {
            const int t2 = F.tid - 256, dk = t2 & 127, half = t2 >> 7;
            { const bf16* sp = (half == 0 ? QH : KH) + (size_t)r0 * DM + hh * 128 + dk; const float Gl = Gs[63];
#pragma unroll
              for (int hb = 0; hb < 2; ++hb) { bf16 raw[32];
#pragma unroll
                for (int i = 0; i < 32; ++i) raw[i] = sp[(size_t)(32 * hb + i) * DM];
                if (half == 0) {
#pragma unroll
                    for (int i = 0; i < 32; ++i) CQT[(size_t)task * 8192 + (32 * hb + i) * 128 + dk] = (bf16)f2bf(__expf(Gs[32 * hb + i]) * bf2f(raw[i]));
                } else {
#pragma unroll
                    for (int i8 = 0; i8 < 4; ++i8) { float v[8];
#pragma unroll
                        for (int e = 0; e < 8; ++e) v[e] = bf2f(raw[8 * i8 + e]) * __expf(Gl - Gs[32 * hb + 8 * i8 + e]);
                        *(u32x4*)(CKTT + ((size_t)task * 128 + dk) * 64 + 32 * hb + 8 * i8) = (u32x4){pk2(v[0], v[1]), pk2(v[2], v[3]), pk2(v[4], v[5]), pk2(v[6], v[7])}; } }
                asm volatile("" ::: "memory"); } }
            if (t2 == 0) CEGL[task] = __expf(Gs[63]);
{ const int id0 = (task * 4 + (F.wave - 4)) * 4; const int ph = ((const int*)p.in[6])[(id0 >> 8) * NPAGE + ((id0 >> 4) & 15)];
#pragma unroll 1
            for (int k = 0; k < 4; ++k) cache_kv_item(p, li, id0 + k, F.lane, ph); }
        }
        __syncthreads();
    }
}
DI int sw16(int row, int ch) { return row * 256 + ((ch ^ (row & 15)) << 4); }
DI int sw8(int row, int ch) { return row * 128 + ((ch ^ ((row >> 1) & 7)) << 4); }
DI void gdn_scan(const P& p, const Frame& F, int li, int sid) {
    const bf16* CW = (const bf16*)(p.ws + WS_CW); const float* CUT = (const float*)(p.ws + WS_CUT); const bf16* CAQK = (const bf16*)(p.ws + WS_CAQK); const bf16* CQT = (const bf16*)(p.ws + WS_CQT); const bf16* CKTT = (const bf16*)(p.ws + WS_CKTT); const float* CEGL = (const float*)(p.ws + WS_CEGL);
    float* OG = (float*)(p.ws + WS_OG);
    constexpr int SBUF = 57344;
    LAS bf16* St = (LAS bf16*)(F.lds + ((F.wave & 3) < 2 ? 2 * SBUF + (F.wave & 3) * 6656 : PTAB_OFF + 256 + ((F.wave & 3) - 2) * 6656)); LAS bf16* uT = St + 16 * 136;
    const int a16 = F.lane & 15, kg = F.lane >> 4, sl = (sid & 1) * 4 + (F.wave & 3), b = sid >> 4, hh = (sid >> 1) & 7; const bool cwv = F.wave < 4;
    sid >>= 1;
    int so[4];
    { const int q0 = F.tid, q1 = F.tid + 512;
      so[0] = (q0 >> 4) * 128 + (((q0 & 15) ^ ((q0 >> 4) & 15)) << 3); so[1] = (q1 >> 4) * 128 + (((q1 & 15) ^ ((q1 >> 4) & 15)) << 3);
      so[2] = (q0 >> 3) * 64 + (((q0 & 7) ^ ((q0 >> 4) & 7)) << 3); so[3] = (q1 >> 3) * 64 + (((q1 & 7) ^ ((q1 >> 4) & 7)) << 3); }
    const unsigned wbase = (unsigned)F.wave * 1024u;
    f32x4 utn[4]; float egn;
#define SCAN_G2L(srcp, off) __builtin_amdgcn_global_load_lds((const unsigned*)(srcp), (LAS unsigned*)(F.lds + (off) + wbase), 16, 0, 0)
#define SCAN_DMA(c_, buf_) do { const size_t task_ = (size_t)sid * 64 + (c_); const int bo_ = (buf_) * SBUF; \
        SCAN_G2L(CW + task_ * 8192 + so[0], bo_); SCAN_G2L(CW + task_ * 8192 + so[1], bo_ + 8192); \
        SCAN_G2L(CQT + task_ * 8192 + so[0], bo_ + 16384); SCAN_G2L(CQT + task_ * 8192 + so[1], bo_ + 16384 + 8192); \
        SCAN_G2L(CKTT + task_ * 8192 + so[2], bo_ + 32768); SCAN_G2L(CKTT + task_ * 8192 + so[3], bo_ + 32768 + 8192); \
        SCAN_G2L(CAQK + task_ * 4096 + so[2], bo_ + 49152); } while (0)
#define SCAN_UT(c_) do { const size_t task_ = (size_t)sid * 64 + (c_); \
        _Pragma("unroll") for (int mt = 0; mt < 4; ++mt) utn[mt] = *(const f32x4*)(CUT + task_ * 8192 + (16 * sl + a16) * 64 + 16 * mt + 4 * kg); \
        egn = CEGL[task_]; } while (0)
    f32x4 S[8];
#pragma unroll
    for (int m = 0; m < 8; ++m) { S[m] = (f32x4){0.f, 0.f, 0.f, 0.f}; if (cwv) *(LAS u32x2*)(St + a16 * 136 + 16 * m + 4 * kg) = (u32x2){0u, 0u}; }
    SCAN_DMA(0, 0);
    if (cwv) SCAN_UT(0);
    __builtin_amdgcn_s_waitcnt(0x0070);
    f32x4 ut[4]; float egl;
    if (!cwv) {
        for (int c = 0; c < 64; ++c) {
            asm volatile("" ::: "memory"); __builtin_amdgcn_s_waitcnt(0x0070); __builtin_amdgcn_s_barrier(); asm volatile("" ::: "memory");
            if (c + 1 < 64) SCAN_DMA(c + 1, (c + 1) & 1);
        }
    } else
    for (int c = 0; c < 64; ++c) {
        asm volatile("" ::: "memory"); __builtin_amdgcn_s_waitcnt(0x4070); __builtin_amdgcn_s_barrier(); asm volatile("" ::: "memory");
        if (c + 1 < 64) SCAN_DMA(c + 1, (c + 1) & 1);
        {
#pragma unroll
        for (int mt = 0; mt < 4; ++mt)
#pragma unroll
            for (int e = 0; e < 4; ++e) { float t_; asm volatile("v_mov_b32 %0, %1" : "=v"(t_) : "v"(utn[mt][e])); ut[mt][e] = t_; }
        { float t_; asm volatile("v_mov_b32 %0, %1" : "=v"(t_) : "v"(egn)); egl = t_; }
        if (c + 1 < 64) SCAN_UT(c + 1);
        LAS unsigned char* sW = F.lds + (c & 1) * SBUF; LAS unsigned char* sQ = sW + 16384; LAS unsigned char* sK = sW + 32768; LAS unsigned char* sA = sW + 49152;
        bf16x8 sb[4];
#pragma unroll
        for (int ks = 0; ks < 4; ++ks) sb[ks] = *(const LAS bf16x8*)(St + a16 * 136 + 32 * ks + 8 * kg);
        f32x4 u[4];
#pragma unroll
        for (int mt = 0; mt < 4; ++mt) { f32x4 acc = (f32x4){0.f, 0.f, 0.f, 0.f};
#pragma unroll
            for (int ks = 0; ks < 4; ++ks) acc = MFMA16(*(const LAS bf16x8*)(sW + sw16(16 * mt + a16, 4 * ks + kg)), sb[ks], acc);
            u[mt] = ut[mt] - acc; }
#pragma unroll
        for (int mt = 0; mt < 4; ++mt) *(LAS u32x2*)(uT + a16 * 72 + 16 * mt + 4 * kg) = pack4(u[mt]);
        bf16x8 ub[2];
#pragma unroll
        for (int k2 = 0; k2 < 2; ++k2) ub[k2] = *(const LAS bf16x8*)(uT + a16 * 72 + 32 * k2 + 8 * kg);
#pragma unroll
        for (int mt = 0; mt < 4; ++mt) { f32x4 acc = (f32x4){0.f, 0.f, 0.f, 0.f};
#pragma unroll
            for (int ks = 0; ks < 4; ++ks) acc = MFMA16(*(const LAS bf16x8*)(sQ + sw16(16 * mt + a16, 4 * ks + kg)), sb[ks], acc);
#pragma unroll
            for (int k2 = 0; k2 < 2; ++k2) acc = MFMA16(*(const LAS bf16x8*)(sA + sw8(16 * mt + a16, 4 * k2 + kg)), ub[k2], acc);
#pragma unroll
            for (int e = 0; e < 4; ++e) OG[(size_t)(b * SEQ + 64 * c + 16 * mt + 4 * kg + e) * DM + hh * 128 + 16 * sl + a16] = acc[e]; }
#pragma unroll
        for (int m = 0; m < 8; ++m) { f32x4 acc = S[m] * egl;
#pragma unroll
            for (int k2 = 0; k2 < 2; ++k2) acc = MFMA16(*(const LAS bf16x8*)(sK + sw8(16 * m + a16, 4 * k2 + kg)), ub[k2], acc);
            S[m] = acc; *(LAS u32x2*)(St + a16 * 136 + 16 * m + 4 * kg) = pack4(acc); }
        }
    }
#undef SCAN_DMA
#undef SCAN_UT
#undef SCAN_G2L
    asm volatile("s_waitcnt vmcnt(0) lgkmcnt(0)" ::: "memory"); __builtin_amdgcn_s_barrier(); asm volatile("" ::: "memory");
    float* gs = p.out + O_GSP + (size_t)((li * NB + b) * GH + hh) * 128 * 128;
    if (cwv)
#pragma unroll
    for (int m = 0; m < 8; ++m)
#pragma unroll
        for (int e = 0; e < 4; ++e) gs[(size_t)(16 * m + 4 * kg + e) * 128 + 16 * sl + a16] = S[m][e];
}
DI void gdn_sample(const P& p, const Frame& F, int li, int task) {
    const bf16* QH = (const bf16*)(p.ws + WS_QH); const bf16* KH = (const bf16*)(p.ws + WS_KH); const bf16* VH = (const bf16*)(p.ws + WS_VH);
    const float* BETA = (const float*)(p.ws + WS_BETA); const float* LOGA = (const float*)(p.ws + WS_LOGA); float* OG = (float*)(p.ws + WS_OG);
    LAS float* ks = (LAS float*)F.lds; LAS float* qs = ks + 1024; LAS float* vs = qs + 1024; LAS float* Gs = vs + 1024; LAS float* bs = Gs + 8; LAS float* KK = bs + 8; LAS float* QK = KK + 64; LAS float* red = QK + 64;
    const int b = task >> 3, hh = task & 7, rb = MP + b * 8;
#pragma unroll
    for (int e = 0; e < 6; ++e) { const int idx = F.tid + 512 * e, part = idx >> 10, i = (idx >> 7) & 7, d = idx & 127;
        const bf16* s = part == 0 ? KH : (part == 1 ? QH : VH);
        ks[idx] = bf2f(s[(size_t)(rb + i) * DM + hh * 128 + d]); }
    if (F.tid == 0) { float g = 0.f; for (int i = 0; i < 8; ++i) { g += LOGA[(size_t)(rb + i) * 8 + hh]; Gs[i] = g; bs[i] = BETA[(size_t)(rb + i) * 8 + hh]; } }
    __syncthreads();
    if (F.tid < 128) { const int which = F.tid >> 6, i = (F.tid >> 3) & 7, j = F.tid & 7; const LAS float* a = (which ? qs : ks) + i * 128; const LAS float* bb = ks + j * 128; float acc = 0.f;
        for (int d = 0; d < 128; ++d) acc += a[d] * bb[d];
        KK[which * 64 + i * 8 + j] = acc; }
    const int dv = F.tid & 127, qt = F.tid >> 7, dk0 = qt * 32;
    const float* st = (const float*)p.in[4] + ((size_t)((li * DB + b) * GH + hh) * 128 + dk0) * 128 + dv;
    float s0[32];
#pragma unroll
    for (int e = 0; e < 32; ++e) s0[e] = st[(size_t)e * 128];
    float pk[8], pq[8];
#pragma unroll
    for (int i = 0; i < 8; ++i) { pk[i] = 0.f; pq[i] = 0.f; }
#pragma unroll
    for (int e = 0; e < 32; ++e)
#pragma unroll
        for (int i = 0; i < 8; ++i) { pk[i] += ks[i * 128 + dk0 + e] * s0[e]; pq[i] += qs[i * 128 + dk0 + e] * s0[e]; }
#pragma unroll
    for (int i = 0; i < 8; ++i) { red[(qt * 16 + i) * 128 + dv] = pk[i]; red[(qt * 16 + 8 + i) * 128 + dv] = pq[i]; }
    __syncthreads();
    float u[8], eg[8];
#pragma unroll
    for (int i = 0; i < 8; ++i) { eg[i] = __expf(Gs[i]);
        const float kS = red[(0 * 16 + i) * 128 + dv] + red[(1 * 16 + i) * 128 + dv] + red[(2 * 16 + i) * 128 + dv] + red[(3 * 16 + i) * 128 + dv];
        float acc = bs[i] * (vs[i * 128 + dv] - eg[i] * kS);
#pragma unroll
        for (int j = 0; j < i; ++j) acc -= bs[i] * KK[i * 8 + j] * __expf(Gs[i] - Gs[j]) * u[j];
        u[i] = acc; }
    if (qt == 0) {
#pragma unroll
        for (int i = 0; i < 8; ++i) { const float qS = red[(0 * 16 + 8 + i) * 128 + dv] + red[(1 * 16 + 8 + i) * 128 + dv] + red[(2 * 16 + 8 + i) * 128 + dv] + red[(3 * 16 + 8 + i) * 128 + dv];
            float acc = eg[i] * qS;
#pragma unroll
            for (int j = 0; j <= i; ++j) acc += QK[i * 8 + j] * __expf(Gs[i] - Gs[j]) * u[j];
            OG[(size_t)(rb + i) * DM + hh * 128 + dv] = acc; } }
    float* so = p.out + O_GSS + ((size_t)((li * DB + b) * GH + hh) * 128 + dk0) * 128 + dv;
    float tl[8];
#pragma unroll
    for (int i = 0; i < 8; ++i) tl[i] = __expf(Gs[7] - Gs[i]) * u[i];
#pragma unroll
    for (int e = 0; e < 32; ++e) { float acc = eg[7] * s0[e];
#pragma unroll
        for (int i = 0; i < 8; ++i) acc += ks[i * 128 + dk0 + e] * tl[i];
        so[(size_t)e * 128] = acc; }
    __syncthreads();
}
DI void gdn_gate(const P& p, const Frame& F, int li) {
    const float* OG = (const float*)(p.ws + WS_OG); const bf16* H = (const bf16*)(p.ws + WS_H); bf16* AO = (bf16*)(p.ws + WS_AO);
    const f32x4 nw = *(const f32x4*)((const float*)p.in[14] + li * 128 + ((4 * F.lane) & 127));
    for (int row = F.gw; row < M; row += F.ngw) {
        f32x4 v[4]; u32x2 z[4];
#pragma unroll
        for (int k = 0; k < 4; ++k) { const int c = (k * 64 + F.lane) * 4; v[k] = *(const f32x4*)(OG + (size_t)row * DM + c); z[k] = *(const u32x2*)(H + (size_t)row * GINP + 3072 + c); }
#pragma unroll
        for (int k = 0; k < 4; ++k) { const int c = (k * 64 + F.lane) * 4;
            float s2 = (v[k][0] * v[k][0] + v[k][1] * v[k][1]) + (v[k][2] * v[k][2] + v[k][3] * v[k][3]);
            s2 = sum32(s2);
            const float rs = __builtin_amdgcn_rsqf(s2 * (1.f / 128.f) + 1e-6f);
            *(u32x2*)(AO + (size_t)row * DM + c) = (u32x2){pk2(v[k][0] * rs * nw[0] * siluf_(bflo(z[k].x)), v[k][1] * rs * nw[1] * siluf_(bfhi(z[k].x))), pk2(v[k][2] * rs * nw[2] * siluf_(bflo(z[k].y)), v[k][3] * rs * nw[3] * siluf_(bfhi(z[k].y)))}; }
    }
}

DI void nsa_transpose(const P& p, const Frame& F, int li) {
    const bf16* H = (const bf16*)(p.ws + WS_H);
    bf16* kslc = (bf16*)(p.ws + WS_KSLC_S + li * SZ_SLC_S); bf16* vslc = (bf16*)(p.ws + WS_VSLCT_S + li * SZ_SLC_S);
    bf16* kwin = (bf16*)(p.ws + WS_KWIN_S + li * SZ_WIN_S); bf16* vwin = (bf16*)(p.ws + WS_VWINT_S + li * SZ_WIN_S);
    for (int idx = F.gw * 64 + F.lane; idx < DB * DS * 512; idx += F.ngw * 64) {
        const int c = idx & 511, rs = idx >> 9, b = rs >> 3, t = rs & 7, kind = c >> 7, g = (c >> 6) & 1, d = c & 63;
        const bf16 v = H[(size_t)(MP + rs) * NINP + 1280 + c];
        if (kind == 0) kslc[((size_t)(b * 2 + g) * SLC_S_ROWS + PAST + t) * 64 + d] = v;
        else if (kind == 1) vslc[((size_t)(b * 2 + g) * SLC_S_ROWS + PAST + t) * 64 + d] = v;
        else if (kind == 2) kwin[((size_t)(b * 2 + g) * WIN_S_ROWS + 512 + t) * 64 + d] = v;
        else vwin[((size_t)(b * 2 + g) * WIN_S_ROWS + 512 + t) * 64 + d] = v;
    }
}
struct CmpOrder {
    int G, c, li; unsigned char* ws; int base, count;
    DI bool next(int i, pg8::Unit& u) const {
        const int L = base + i * G + c; if (i * G + c >= count) return false;
        if (L < 32) { u.z = L >> 3; u.pm = (L >> 1) & 3; u.pn = L & 1;
            u.A = (const char*)(ws + WS_CMPP) + ((size_t)u.pm * 256 * 4096 + (u.z >> 1) * 128 + (u.z & 1) * 64) * 2; u.C = (char*)(ws + WS_PC_P) + (size_t)u.z * 1024 * 512 * 2; }
        else { const int L2 = L - 32; u.z = L2 >> 7; u.pm = (L2 >> 1) & 63; u.pn = L2 & 1;
            u.A = (const char*)(ws + WS_CMPS + li * SZ_CMPS) + ((size_t)u.pm * 256 * 4096 + (u.z >> 1) * 128 + (u.z & 1) * 64) * 2; u.C = (char*)(ws + WS_PC_S) + (size_t)u.z * 16384 * 512 * 2; }
        u.B = (const char*)(ws + WS_WC1 + (li * 2 + (u.z >> 1)) * SZ_WC1) + (size_t)u.pn * 256 * 1024 * 2;
        return true;
    }
};
DI void nsa_cmp2(const P& p, const Frame& F, int li) {
    constexpr int WP = 264;
    LAS bf16* w2t = (LAS bf16*)F.lds;
    LAS bf16* hid = (LAS bf16*)(F.lds + 36864 + F.wave * 8704);
    const float* cb = (const float*)(p.ws + WS_CBIAS);
    constexpr int NH_P = NB * 2 * 16, NH_S = DB * 2 * 8, NH = NH_P + NH_S;
    const int a16 = F.lane & 15, kg = F.lane >> 4;
#pragma unroll 1
    for (int kv = 0; kv < 2; ++kv) {
        __syncthreads();
        { const float* w2g = (const float*)(kv ? p.in[22] : p.in[20]) + (size_t)li * 256 * 64;
          for (int i = F.tid; i < 256 * 64; i += 512) w2t[(i & 63) * WP + (i >> 6)] = (bf16)f2bf(w2g[i]); }
        __syncthreads();
        const f32x4 bv = *(const f32x4*)(cb + (li * 2 + kv) * 256 + 4 * F.lane);
        for (int id = F.gw; id < NH; id += F.ngw) {
            int b, n0, g, segs, npad, ncmp; const bf16* PC; bf16* DST;
            if (id < NH_P) { n0 = (id & 15) * 16; g = (id >> 4) & 1; b = id >> 5; segs = 256; npad = 256; ncmp = NCMP_P; PC = (const bf16*)(p.ws + WS_PC_P) + (size_t)(kv * 2 + g) * 1024 * 512; DST = (bf16*)(p.ws + (kv ? WS_VCT_P : WS_KC_P)); }
            else { const int i2 = id - NH_P; n0 = (i2 & 7) * 16; g = (i2 >> 3) & 1; b = i2 >> 4; segs = 128; npad = 128; ncmp = NCMP_S; PC = (const bf16*)(p.ws + WS_PC_S) + (size_t)(kv * 2 + g) * 16384 * 512; DST = (bf16*)(p.ws + (kv ? WS_VCT_S : WS_KC_S)); }
            const size_t ri = (size_t)b * segs + n0;
#pragma unroll
            for (int hb = 0; hb < 2; ++hb) { u32x2 a0[8], a1[8];
#pragma unroll
                for (int e = 0; e < 8; ++e) { const int n = 8 * hb + e; const bool ok = n0 + n < ncmp; a0[e] = ok ? *(const u32x2*)(PC + (ri + n) * 512 + 4 * F.lane) : (u32x2){0u, 0u}; a1[e] = ok ? *(const u32x2*)(PC + (ri + n + 1) * 512 + 256 + 4 * F.lane) : (u32x2){0u, 0u}; }
#pragma unroll
                for (int e = 0; e < 8; ++e) { const float h0 = siluf_(bflo(a0[e].x) + bflo(a1[e].x) + bv[0]), h1 = siluf_(bfhi(a0[e].x) + bfhi(a1[e].x) + bv[1]), h2 = siluf_(bflo(a0[e].y) + bflo(a1[e].y) + bv[2]), h3 = siluf_(bfhi(a0[e].y) + bfhi(a1[e].y) + bv[3]);
                    *(LAS u32x2*)(hid + (8 * hb + e) * WP + 4 * F.lane) = (u32x2){pk2(h0, h1), pk2(h2, h3)}; } }
            LDS_WAIT();
            f32x4 acc[4];
#pragma unroll
            for (int dt = 0; dt < 4; ++dt) acc[dt] = (f32x4){0.f, 0.f, 0.f, 0.f};
#pragma unroll
            for (int ks = 0; ks < 8; ++ks) { const bf16x8 af = *(const LAS bf16x8*)(hid + a16 * WP + 32 * ks + 8 * kg);
#pragma unroll
                for (int dt = 0; dt < 4; ++dt) acc[dt] = MFMA16(af, *(const LAS bf16x8*)(w2t + (16 * dt + a16) * WP + 32 * ks + 8 * kg), acc[dt]); }
#pragma unroll
            for (int dt = 0; dt < 4; ++dt)
#pragma unroll
                for (int e = 0; e < 4; ++e) { const int n = n0 + 4 * kg + e; if (n < ncmp) DST[((size_t)(b * 2 + g) * npad + n) * 64 + 16 * dt + a16] = (bf16)f2bf(acc[dt][e]); }
            LDS_WAIT();
        }
    }
}

struct AttnAcc { f32x16 o0, o1; float m, l; };
DI void attn_reset(AttnAcc& a) { for (int e = 0; e < 16; ++e) { a.o0[e] = 0.f; a.o1[e] = 0.f; } a.m = -__builtin_inff(); a.l = 0.f; }
constexpr float ATT_C = 1.0f;
constexpr float ATT_QS = 0.18033688011112042f;
DI f32x16 attn_scores(const LAS unsigned char* kt, int sb, const bf16x8 (&qf)[4], int r, int h) {
    f32x16 s; for (int e = 0; e < 16; ++e) s[e] = 0.f;
    const int row = 32 * sb + r, swz = (row >> 1) & 7; const LAS unsigned char* base = kt + row * 128;
#pragma unroll
    for (int st = 0; st < 4; ++st) s = MFMA32(*(const LAS bf16x8*)(base + (((2 * st + h) ^ swz) << 4)), qf[st], s);
    return s;
}
template <bool WIN> DI void attn_mask(f32x16& s, int hi) {
#pragma unroll
    for (int e = 0; e < 16; ++e) { const int ce = (e & 3) + 8 * (e >> 2); const bool v = WIN ? ((unsigned)(hi - ce) <= 512u) : (ce <= hi); s[e] = v ? s[e] : -__builtin_inff(); }
}
typedef short v4i16_t __attribute__((ext_vector_type(4)));
DI s16x4 vtr(const LAS unsigned char* p) { return __builtin_bit_cast(s16x4, __builtin_amdgcn_ds_read_tr16_b64_v4i16((LAS v4i16_t*)p)); }
DI void attn_pv(AttnAcc& a, const f32x16& p0, const f32x16& p1, const LAS unsigned char* vt, int r, int h) {
    const int q = (r >> 2) & 3, pp4 = r & 3, dg = r >> 4;
#pragma unroll
    for (int s4 = 0; s4 < 4; ++s4) {
        const f32x16& pp = s4 < 2 ? p0 : p1; const int o = 8 * (s4 & 1);
        u32x4 pw; pw.x = pg8::cvt_pk_bf16(pp[o], pp[o + 1]); pw.y = pg8::cvt_pk_bf16(pp[o + 2], pp[o + 3]); pw.z = pg8::cvt_pk_bf16(pp[o + 4], pp[o + 5]); pw.w = pg8::cvt_pk_bf16(pp[o + 6], pp[o + 7]);
        const bf16x8 pf = __builtin_bit_cast(bf16x8, pw);
        const int k1 = 16 * s4 + 4 * h + q, k2 = k1 + 8;
        const LAS unsigned char* r1 = vt + k1 * 128 + 8 * (pp4 & 1); const LAS unsigned char* r2 = vt + k2 * 128 + 8 * (pp4 & 1);
        const int z1 = (k1 >> 1) & 7, z2 = (k2 >> 1) & 7;
        { const int ch = 2 * dg + (pp4 >> 1);
          const s16x4 lo = vtr(r1 + ((ch ^ z1) << 4)), hi = vtr(r2 + ((ch ^ z2) << 4));
          a.o0 = MFMA32(__builtin_shufflevector(lo, hi, 0, 1, 2, 3, 4, 5, 6, 7), pf, a.o0); }
        { const int ch = 4 + 2 * dg + (pp4 >> 1);
          const s16x4 lo = vtr(r1 + ((ch ^ z1) << 4)), hi = vtr(r2 + ((ch ^ z2) << 4));
          a.o1 = MFMA32(__builtin_shufflevector(lo, hi, 0, 1, 2, 3, 4, 5, 6, 7), pf, a.o1); }
    }
}
template <bool WIN> DI void attn_chunk(AttnAcc& a, const LAS unsigned char* kt, const bf16x8 (&qf)[4], int hi0, int hi1, bool allv, bool lv, int r, int h) {
    f32x16 s0 = attn_scores(kt, 0, qf, r, h), s1 = attn_scores(kt, 1, qf, r, h);
    if (!allv) { attn_mask<WIN>(s0, hi0); attn_mask<WIN>(s1, hi1); }
    float mx = fmaxf(s0[0], s1[0]);
#pragma unroll
    for (int e = 1; e < 16; ++e) mx = fmaxf(mx, fmaxf(s0[e], s1[e]));
    mx = xor32_max(mx) * ATT_C; mx = lv ? mx : -__builtin_inff();
    const float mn = fmaxf(a.m, mx), mu = lv ? ((mn == -__builtin_inff()) ? 0.f : mn) : __builtin_inff();
    float ps = 0.f;
#pragma unroll
    for (int e = 0; e < 16; ++e) { s0[e] = __builtin_amdgcn_exp2f(__builtin_fmaf(s0[e], ATT_C, -mu)); s1[e] = __builtin_amdgcn_exp2f(__builtin_fmaf(s1[e], ATT_C, -mu)); ps += s0[e] + s1[e]; }
    ps = xor32_sum(ps);
    if (__ballot(mn != a.m) != 0ull) {
        const float sc = (a.m == -__builtin_inff()) ? 0.f : __builtin_amdgcn_exp2f(a.m - mn);
        a.l = a.l * sc + ps; a.o0 = a.o0 * sc; a.o1 = a.o1 * sc;
    } else a.l += ps;
    a.m = mn;
    attn_pv(a, s0, s1, kt + 8192, r, h);
}

namespace nb {
typedef __attribute__((address_space(3))) const char* lds_cptr;
constexpr int NSLOT = 3, SLOTB = 8192;
constexpr int LDS_K = 0, LDS_V = NSLOT * SLOTB, LDS_WS = 2 * NSLOT * SLOTB, LDS_OST = 65536, LDS_END = LDS_OST + 8 * 4096;
constexpr int LDS_TL = 98304 + 256;
#define NB_SBAR() __builtin_amdgcn_sched_barrier(0)
#define NB_WAIT_BAR(N) asm volatile("s_waitcnt vmcnt(" #N ") lgkmcnt(0)\n\ts_barrier" ::: "memory")
DI void glds16(const void* gsrc, unsigned lds_dst) { unsigned keep;
    asm volatile("s_mov_b32 %0, m0\n\ts_mov_b32 m0, %2\n\ts_nop 0\n\tglobal_load_lds_dwordx4 %1, off\n\ts_mov_b32 m0, %0" : "=&s"(keep) : "v"(gsrc), "s"(lds_dst) : "memory"); }
DI float max3f(float a, float b, float c) { float r; asm("v_max3_f32 %0, %1, %2, %3" : "=v"(r) : "v"(a), "v"(b), "v"(c)); return r; }
DI float max2f(float a, float b) { float r; asm("v_max_f32_e32 %0, %1, %2" : "=v"(r) : "v"(a), "v"(b)); return r; }
DI float fadd_s(float a, float b) { float r; asm("v_add_f32_e32 %0, %1, %2" : "=v"(r) : "v"(a), "v"(b)); return r; }
DI float fsub_s(float a, float b) { float r; asm("v_sub_f32_e32 %0, %1, %2" : "=v"(r) : "v"(a), "v"(b)); return r; }
typedef float f32x2_t __attribute__((ext_vector_type(2))); typedef __bf16 bf16x2_t __attribute__((ext_vector_type(2)));
DI unsigned cvtpk_s(float lo, float hi) { f32x2_t v = {lo, hi}; bf16x2_t b = __builtin_convertvector(v, bf16x2_t); return __builtin_bit_cast(unsigned, b); }
DI void qkt(f32x16& p0, f32x16& p1, lds_cptr Kslot, const bf16x8* qr, const f32x16& negm, int r32, int hi) {
    const lds_cptr kb = Kslot + hi * 1024 + r32 * 16;
#pragma unroll
    for (int d0 = 0; d0 < 4; ++d0) {
        const bf16x8 b0 = *(const LAS bf16x8*)(kb + d0 * 2048);
        const bf16x8 b1 = *(const LAS bf16x8*)(kb + d0 * 2048 + 512);
        if (d0 == 0) { p0 = __builtin_amdgcn_mfma_f32_32x32x16_bf16(b0, qr[0], negm, 0, 0, 0); p1 = __builtin_amdgcn_mfma_f32_32x32x16_bf16(b1, qr[0], negm, 0, 0, 0); }
        else { p0 = __builtin_amdgcn_mfma_f32_32x32x16_bf16(b0, qr[d0], p0, 0, 0, 0); p1 = __builtin_amdgcn_mfma_f32_32x32x16_bf16(b1, qr[d0], p1, 0, 0, 0); } }
}
DI void kload8(bf16x8* kf, lds_cptr kp) {
    kf[0] = *(const LAS bf16x8*)(kp);        kf[1] = *(const LAS bf16x8*)(kp + 512);
    kf[2] = *(const LAS bf16x8*)(kp + 2048); kf[3] = *(const LAS bf16x8*)(kp + 2560);
    kf[4] = *(const LAS bf16x8*)(kp + 4096); kf[5] = *(const LAS bf16x8*)(kp + 4608);
    kf[6] = *(const LAS bf16x8*)(kp + 6144); kf[7] = *(const LAS bf16x8*)(kp + 6656);
}
DI void kload2(bf16x8* kf, lds_cptr kp, int j) { kf[2 * j] = *(const LAS bf16x8*)(kp + j * 2048); kf[2 * j + 1] = *(const LAS bf16x8*)(kp + j * 2048 + 512); }
typedef short v4i16_t __attribute__((ext_vector_type(4)));
DI s16x4 vtr(lds_cptr p) { return __builtin_bit_cast(s16x4, __builtin_amdgcn_ds_read_tr16_b64_v4i16((LAS v4i16_t*)p)); }
DI float rowmax(const f32x16& p0, const f32x16& p1) {
    float a = max3f(p0[0], p0[1], p1[0]), b = max3f(p0[2], p0[3], p1[1]); a = max3f(a, p1[2], p1[3]);
#pragma unroll
    for (int r = 4; r < 16; r += 4) { a = max3f(a, p0[r], p0[r + 1]); b = max3f(b, p0[r + 2], p0[r + 3]); a = max3f(a, p1[r], p1[r + 1]); b = max3f(b, p1[r + 2], p1[r + 3]); }
    const float m = max2f(a, b);
    auto rr = __builtin_amdgcn_permlane32_swap(__float_as_uint(m), __float_as_uint(m), false, false);
    return max2f(__uint_as_float(rr[0]), __uint_as_float(rr[1]));
}
DI void pv(f32x16* o, int vb, bf16x8 pa0, bf16x8 pa1, bf16x8 pa2, bf16x8 pa3) {
#pragma unroll
    for (int d0 = 0; d0 < 2; ++d0) { s16x4 lo[4], hi[4];
#pragma unroll
        for (int ks = 0; ks < 4; ++ks) {
            asm volatile("ds_read_b64_tr_b16 %0,%1 offset:%c2" : "=&v"(lo[ks]) : "v"(vb), "i"(d0 * 4096 + ks * 1024) : "memory");
            asm volatile("ds_read_b64_tr_b16 %0,%1 offset:%c2" : "=&v"(hi[ks]) : "v"(vb), "i"(d0 * 4096 + ks * 1024 + 512) : "memory"); }
        asm volatile("s_waitcnt lgkmcnt(0)" ::: "memory"); NB_SBAR();
#define NB_PK(k) (bf16x8){lo[k][0], lo[k][1], lo[k][2], lo[k][3], hi[k][0], hi[k][1], hi[k][2], hi[k][3]}
        o[d0] = __builtin_amdgcn_mfma_f32_32x32x16_bf16(pa0, NB_PK(0), o[d0], 0, 0, 0);
        o[d0] = __builtin_amdgcn_mfma_f32_32x32x16_bf16(pa1, NB_PK(1), o[d0], 0, 0, 0);
        o[d0] = __builtin_amdgcn_mfma_f32_32x32x16_bf16(pa2, NB_PK(2), o[d0], 0, 0, 0);
        o[d0] = __builtin_amdgcn_mfma_f32_32x32x16_bf16(pa3, NB_PK(3), o[d0], 0, 0, 0);
#undef NB_PK
    }
}
DI void gmask(f32x16& p0, f32x16& p1, int hl, unsigned wd) {
    const float NEG = -__builtin_inff();
#pragma unroll
    for (int r = 0; r < 16; ++r) { const int ce = (r & 3) + 8 * (r >> 2); if ((unsigned)(hl - ce) > wd) p0[r] = NEG; if ((unsigned)(hl - 32 - ce) > wd) p1[r] = NEG; }
}
template <int THRL> DI void ring_unit(const int MODE, const bool LAST, const bf16* Qw, int ldq, const bf16* Kt, const bf16* Vt, int ld, const LAS int* tl, int NT, int posbase,
                                                          int pos0w  , unsigned long long m0, unsigned long long m1, unsigned long long m2, unsigned long long m3  ,
                                                          const bf16* gatep  , int br, bool store_ok, bf16* Ow, char* shm) {
    int tid_ = threadIdx.x; asm volatile("" : "+v"(tid_));
    const int tid = tid_, lane = tid & 63, r32 = lane & 31, hi = lane >> 5; const int wid = __builtin_amdgcn_readfirstlane(tid >> 6);
    const unsigned lds0 = (unsigned)(uintptr_t)shm;
    const bf16* ksrc = Kt + (long)lane * ld + wid * 8;
    const bf16* vsrc = Vt + (long)(16 * (wid & 3) + (lane >> 2)) * ld + (wid >> 2) * 32 + (lane & 3) * 8;
    const unsigned kdst = lds0 + LDS_K + wid * 1024, vdst = lds0 + LDS_V + wid * 1024;
#define NB_TL(t) __builtin_amdgcn_readfirstlane(tl[(t)])
    int dq0, dq1, dq2, dq3;
#define NB_DMA_KD(dd, slot) do { int d_ = (dd); d_ = d_ < 0 ? 0 : d_; nb::glds16(ksrc + (long)d_ * 64 * ld, (unsigned)__builtin_amdgcn_readfirstlane(kdst + (slot))); } while (0)
#define NB_DMA_VD(dd, slot) do { int d_ = (dd); d_ = d_ < 0 ? 0 : d_; nb::glds16(vsrc + (long)d_ * 64 * ld, (unsigned)__builtin_amdgcn_readfirstlane(vdst + (slot))); } while (0)
#define NB_DMA_K(t, slot) do { int d_ = NB_TL(t); d_ = d_ < 0 ? 0 : d_; nb::glds16(ksrc + (long)d_ * 64 * ld, (unsigned)__builtin_amdgcn_readfirstlane(kdst + (slot))); } while (0)
#define NB_DMA_V(t, slot) do { int d_ = NB_TL(t); d_ = d_ < 0 ? 0 : d_; nb::glds16(vsrc + (long)d_ * 64 * ld, (unsigned)__builtin_amdgcn_readfirstlane(vdst + (slot))); } while (0)
    const int vb0 = (int)(lds0 + LDS_V) + ((lane >> 4) & 1) * 32 + (lane & 3) * 8 + (4 * hi + ((lane & 15) >> 2)) * 64;
    bf16x8 kf[8];
    const lds_cptr shm3 = (lds_cptr)shm; const lds_cptr Kbase = shm3 + LDS_K;
    LAS float* wsf = (LAS float*)((LAS char*)shm3 + LDS_WS) + wid * 64; const lds_cptr kp0 = shm3 + LDS_K + hi * 1024 + r32 * 16; const lds_cptr vp0 = shm3 + LDS_V + ((lane >> 4) & 1) * 32 + (lane & 3) * 8 + (4 * hi + ((lane & 15) >> 2)) * 64;
    NB_DMA_K(0, 0); NB_DMA_V(0, 0); NB_DMA_K(1, SLOTB);
    bf16x8 qr[4];
    { const bf16* qp = Qw + (long)(r32 >> 3) * ldq + (r32 & 7) * 64 + hi * 8;
#pragma unroll
      for (int d0 = 0; d0 < 4; ++d0) qr[d0] = *reinterpret_cast<const bf16x8*>(qp + d0 * 16); }
    float mhat = 0.f, l_reg = 0.f; f32x16 o[2]; o[0] = f32x16{}; o[1] = f32x16{}; f32x16 negm = f32x16{}; asm volatile("" : "+v"(negm));
#define NB_CMASK(P0, P1, t) NB_CMASKD(P0, P1, NB_TL(t))
#define NB_CMASKD(P0, P1, dd) do { const int d_ = (dd); int hl_; unsigned wd_; bool full_; \
        const int trow_ = pos0w + (r32 >> 3); \
        if (MODE == 0) { const int pb_ = 64 * d_ + posbase; full_ = d_ >= 0 && pb_ + 63 <= pos0w && pb_ >= pos0w + 3 - 512; } \
        else { const int ds_ = d_ & 63; full_ = d_ >= 0 && ((m0 & m1 & m2 & m3) >> ds_ & 1ull) && 64 * d_ + 63 <= pos0w; } \
        if (full_) break; \
        if (MODE == 0) { hl_ = d_ < 0 ? -1 : trow_ - (64 * d_ + posbase) - 4 * hi; wd_ = 512u; } \
        else { const int ds_ = d_ & 63; const unsigned b4_ = (unsigned)((m0 >> ds_) & 1ull) | ((unsigned)((m1 >> ds_) & 1ull) << 1) | ((unsigned)((m2 >> ds_) & 1ull) << 2) | ((unsigned)((m3 >> ds_) & 1ull) << 3); \
               const bool mine_ = d_ >= 0 && ((b4_ >> (r32 >> 3)) & 1u); hl_ = mine_ ? trow_ - 64 * d_ - 4 * hi : -1; wd_ = 0x7fffffffu; } \
        nb::gmask(P0, P1, hl_, wd_); } while (0)
    bool resc = false;
#define NB_START(P0, P1) do { const float rm = nb::rowmax(P0, P1); resc = false; \
    { const float dl = (rm == -__builtin_inff()) ? 0.f : rm; mhat = nb::fadd_s(mhat, dl); \
      _Pragma("unroll") for (int r = 0; r < 16; ++r) { P0[r] = nb::fsub_s(P0[r], dl); P1[r] = nb::fsub_s(P1[r], dl); } \
      _Pragma("unroll") for (int r = 0; r < 16; ++r) negm[r] = -mhat; asm volatile("" : "+v"(negm)); } \
    _Pragma("unroll") for (int r = 0; r < 16; ++r) P0[r] = __builtin_amdgcn_exp2f(P0[r]); } while (0)
#define NB_RESC() do { if (resc) { asm volatile("s_waitcnt lgkmcnt(0)" ::: "memory"); \
      _Pragma("unroll") for (int d_ = 0; d_ < 2; ++d_) _Pragma("unroll") for (int r = 0; r < 16; ++r) o[d_][r] *= wsf[crow(r, hi)]; } } while (0)
    f32x16 pA0, pA1, pB0, pB1;
    int sl_prev = 0, sl_cur = 0, sl_next = SLOTB;
#define NB_ROT() do { sl_prev = sl_cur; sl_cur = sl_next; sl_next = (sl_next == (NSLOT - 1) * SLOTB) ? 0 : sl_next + SLOTB; } while (0)
#define NB_SHIFT(tn) do { dq0 = dq1; dq1 = dq2; dq2 = dq3; dq3 = NB_TL((tn) + 3 < 95 ? (tn) + 3 : 95); } while (0)
    NB_DMA_K(2, 2 * SLOTB);
    NB_WAIT_BAR(3);
    nb::qkt(pA0, pA1, Kbase, qr, negm, r32, hi); asm volatile("s_nop 15\n\ts_nop 7" : "+v"(pA0), "+v"(pA1)); NB_CMASK(pA0, pA1, 0);
    NB_START(pA0, pA1);
    _Pragma("unroll") for (int r = 0; r < 16; ++r) pA1[r] = __builtin_amdgcn_exp2f(pA1[r]);
    NB_WAIT_BAR(0);
    NB_DMA_K(3, 0); NB_DMA_V(1, SLOTB);
    NB_ROT();
    nb::kload8(kf, kp0 + sl_cur);
    NB_WAIT_BAR(2);
    dq0 = NB_TL(1); dq1 = NB_TL(2); dq2 = NB_TL(3); dq3 = NB_TL(4);
    s16x4 vlo[8], vhi[8]; u32x4 pw0, pw1, pw2, pw3;
#define NB_PKW(P, B) nb::cvtpk_s(P[B], P[B + 1])
#define NB_PAF(k) __builtin_bit_cast(bf16x8, pw##k)
#define NB_VFR(i) (bf16x8){vlo[i][0], vlo[i][1], vlo[i][2], vlo[i][3], vhi[i][0], vhi[i][1], vhi[i][2], vhi[i][3]}
#define NB_PIN(x) asm volatile("" : "+v"(x))
#define NB_MX3(a, b, c) __builtin_fmaxf(__builtin_fmaxf((a), (b)), (c))
#define NB_GAPA(MF, A0, A1, A2, A3, W0, W1, PW) do { MF; sacc += A0; sacc += A1; sacc += A2; sacc += A3; NB_PIN(sacc); W0; W1; NB_PIN(PW); NB_SBAR(); } while (0)
#define NB_EX(v) __builtin_amdgcn_exp2f(v)
#define NB_GAPB(MF, X, B) do { MF; X[B] = NB_EX(X[B]); X[B + 1] = NB_EX(X[B + 1]); X[B + 2] = NB_EX(X[B + 2]); X[B + 3] = NB_EX(X[B + 3]); NB_PIN(X); NB_SBAR(); } while (0)
#define NB_VRD(i) do { vlo[i] = nb::vtr(vp_ + (((i) >> 2) * 4096 + ((i) & 3) * 1024)); vhi[i] = nb::vtr(vp_ + (((i) >> 2) * 4096 + ((i) & 3) * 1024 + 512)); } while (0)
#define NB_KRD(G, j) do { if (G) { nb::kload2(kf, kp0 + sl_next, j); NB_SBAR(); } } while (0)
#define NB_MF(...) __builtin_amdgcn_mfma_f32_32x32x16_bf16(__VA_ARGS__, 0, 0, 0)
#define NB_STEP(C0, C1, P0, P1, t, GK, GV, GL) do { NB_SBAR(); \
    const lds_cptr vp_ = vp0 + sl_prev; \
    NB_VRD(0); NB_SBAR(); float sacc = (P0[0] + P0[1]); \
    NB_GAPA(C0 = NB_MF(kf[0], qr[0], negm), P0[2], P0[3], P0[4], P0[5],     pw0[0] = NB_PKW(P0, 0), pw0[1] = NB_PKW(P0, 2), pw0); \
    NB_VRD(4); NB_SBAR(); NB_GAPA(C1 = NB_MF(kf[1], qr[0], negm), P0[6], P0[7], P0[8], P0[9],     pw0[2] = NB_PKW(P0, 4), pw0[3] = NB_PKW(P0, 6), pw0); \
    NB_VRD(1); NB_SBAR(); NB_GAPA(C0 = NB_MF(kf[2], qr[1], C0),   P0[10], P0[11], P0[12], P0[13], pw1[0] = NB_PKW(P0, 8), pw1[1] = NB_PKW(P0, 10), pw1); \
    NB_VRD(5); NB_SBAR(); NB_GAPA(C1 = NB_MF(kf[3], qr[1], C1),   P0[14], P0[15], P1[0], P1[1],   pw1[2] = NB_PKW(P0, 12), pw1[3] = NB_PKW(P0, 14), pw1); \
    NB_VRD(2); NB_SBAR(); NB_GAPA(C0 = NB_MF(kf[4], qr[2], C0),   P1[2], P1[3], P1[4], P1[5],     pw2[0] = NB_PKW(P1, 0), pw2[1] = NB_PKW(P1, 2), pw2); \
    NB_VRD(6); NB_SBAR(); NB_GAPA(C1 = NB_MF(kf[5], qr[2], C1),   P1[6], P1[7], P1[8], P1[9],     pw2[2] = NB_PKW(P1, 4), pw2[3] = NB_PKW(P1, 6), pw2); \
    NB_VRD(3); NB_SBAR(); NB_GAPA(C0 = NB_MF(kf[6], qr[3], C0),   P1[10], P1[11], P1[12], P1[13], pw3[0] = NB_PKW(P1, 8), pw3[1] = NB_PKW(P1, 10), pw3); \
    NB_VRD(7); NB_SBAR(); NB_GAPA(C1 = NB_MF(kf[7], qr[3], C1),   P1[14], P1[15], 0.f, 0.f,       pw3[2] = NB_PKW(P1, 12), pw3[3] = NB_PKW(P1, 14), pw3); \
    l_reg += sacc; \
    if (GK) { NB_DMA_KD(dq3, sl_cur); } if (GV) { NB_DMA_VD(dq1, sl_next); } \
    NB_CMASKD(C0, C1, dq0); \
    { float a = NB_MX3(C0[0], C0[1], C1[0]), b = NB_MX3(C0[2], C0[3], C1[1]); a = NB_MX3(a, C1[2], C1[3]); \
      _Pragma("unroll") for (int r = 4; r < 16; r += 4) { a = NB_MX3(a, C0[r], C0[r + 1]); b = NB_MX3(b, C0[r + 2], C0[r + 3]); a = NB_MX3(a, C1[r], C1[r + 1]); b = NB_MX3(b, C1[r + 2], C1[r + 3]); } \
      float rm = __builtin_fmaxf(a, b); { auto rr = __builtin_amdgcn_permlane32_swap(__float_as_uint(rm), __float_as_uint(rm), false, false); rm = __builtin_fmaxf(__uint_as_float(rr[0]), __uint_as_float(rr[1])); } \
      resc = false; \
      if (__builtin_expect(__any(rm > (float)THRL), 0)) { const float dl = __builtin_fmaxf(rm, 0.f); mhat += dl; \
        _Pragma("unroll") for (int r = 0; r < 16; ++r) { C0[r] -= dl; C1[r] -= dl; } \
        _Pragma("unroll") for (int r = 0; r < 16; ++r) negm[r] = -mhat; asm volatile("" : "+v"(negm)); \
        const float f = __builtin_amdgcn_exp2f(-dl); l_reg *= f; if (hi == 0) wsf[r32] = f; resc = true; } } \
    NB_SBAR(); \
    NB_GAPB(o[0] = NB_MF(NB_PAF(0), NB_VFR(0), o[0]), C0, 0); \
    NB_GAPB(o[1] = NB_MF(NB_PAF(0), NB_VFR(4), o[1]), C0, 4); \
    NB_KRD(GL, 0); NB_GAPB(o[0] = NB_MF(NB_PAF(1), NB_VFR(1), o[0]), C0, 8); \
    NB_KRD(GL, 1); NB_GAPB(o[1] = NB_MF(NB_PAF(1), NB_VFR(5), o[1]), C0, 12); \
    NB_KRD(GL, 2); NB_GAPB(o[0] = NB_MF(NB_PAF(2), NB_VFR(2), o[0]), C1, 0); \
    NB_KRD(GL, 3); NB_GAPB(o[1] = NB_MF(NB_PAF(2), NB_VFR(6), o[1]), C1, 4); \
    NB_GAPB(o[0] = NB_MF(NB_PAF(3), NB_VFR(3), o[0]), C1, 8); \
    NB_GAPB(o[1] = NB_MF(NB_PAF(3), NB_VFR(7), o[1]), C1, 12); \
    } while (0)
    int t = 1;
    for (; t + 5 < NT; t += 2) {
        NB_STEP(pB0, pB1, pA0, pA1, t, true, true, true);     NB_WAIT_BAR(2); NB_SHIFT(t + 1); NB_RESC(); NB_ROT();
        NB_STEP(pA0, pA1, pB0, pB1, t + 1, true, true, true); NB_WAIT_BAR(2); NB_SHIFT(t + 2); NB_RESC(); NB_ROT();
    }
#define NB_ENDW(tt) do { if ((tt) + 3 < NT) { NB_WAIT_BAR(2); } else if ((tt) + 2 < NT) { NB_WAIT_BAR(1); } else { NB_WAIT_BAR(0); } } while (0)
    for (; t + 1 < NT; t += 2) {
        NB_STEP(pB0, pB1, pA0, pA1, t, (t + 3 < NT), (t + 1 < NT), (t + 1 < NT));         NB_ENDW(t);     NB_SHIFT(t + 1); NB_RESC(); NB_ROT();
        NB_STEP(pA0, pA1, pB0, pB1, t + 1, (t + 4 < NT), (t + 2 < NT), (t + 2 < NT));     NB_ENDW(t + 1); NB_SHIFT(t + 2); NB_RESC(); NB_ROT();
    }
    NB_STEP(pB0, pB1, pA0, pA1, NT - 1, false, false, false); NB_RESC();
    { float sacc = pB0[0] + pB0[1]; _Pragma("unroll") for (int r = 2; r < 16; ++r) sacc += pB0[r]; _Pragma("unroll") for (int r = 0; r < 16; ++r) sacc += pB1[r]; l_reg += sacc;
      pw0 = (u32x4){NB_PKW(pB0, 0), NB_PKW(pB0, 2), NB_PKW(pB0, 4), NB_PKW(pB0, 6)}; pw1 = (u32x4){NB_PKW(pB0, 8), NB_PKW(pB0, 10), NB_PKW(pB0, 12), NB_PKW(pB0, 14)};
      pw2 = (u32x4){NB_PKW(pB1, 0), NB_PKW(pB1, 2), NB_PKW(pB1, 4), NB_PKW(pB1, 6)}; pw3 = (u32x4){NB_PKW(pB1, 8), NB_PKW(pB1, 10), NB_PKW(pB1, 12), NB_PKW(pB1, 14)};
      NB_SBAR(); nb::pv(o, vb0 + sl_cur, NB_PAF(0), NB_PAF(1), NB_PAF(2), NB_PAF(3)); }
    { auto rr = __builtin_amdgcn_permlane32_swap(__float_as_uint(l_reg), __float_as_uint(l_reg), false, false); l_reg = __uint_as_float(rr[0]) + __uint_as_float(rr[1]); }
    if (hi == 0) { const float gate = sigmoidf_(bf2f(gatep[(long)(r32 >> 3) * ldq + (r32 & 7) * 3 + br])); wsf[32 + r32] = l_reg > 0.f ? gate / l_reg : 0.f; } asm volatile("s_waitcnt lgkmcnt(0)" ::: "memory");
    float rli[16];
#pragma unroll
    for (int r = 0; r < 16; ++r) rli[r] = wsf[32 + crow(r, hi)];
    { LAS bf16* stg = (LAS bf16*)((LAS char*)shm3 + LDS_OST) + wid * 2048;
#pragma unroll
      for (int r = 0; r < 16; ++r) { const int orow = crow(r, hi);
#pragma unroll
          for (int d0 = 0; d0 < 2; ++d0) { LAS bf16* sp = stg + orow * 64 + d0 * 32 + r32; *sp = (bf16)f2bf(bf2f(*sp) + o[d0][r] * rli[r]); } }
      asm volatile("s_waitcnt lgkmcnt(0)" ::: "memory");
      if (LAST && store_ok) {
#pragma unroll
          for (int i = 0; i < 4; ++i) { const int row = i * 8 + (lane >> 3), ch = lane & 7; const u32x4 v = *(const LAS u32x4*)(stg + row * 64 + ch * 8); *(u32x4*)(Ow + (long)(row >> 3) * DM + (row & 7) * 64 + ch * 8) = v; } } }
    asm volatile("s_waitcnt lgkmcnt(0)\n\ts_barrier" ::: "memory");
#undef NB_TL
#undef NB_DMA_K
#undef NB_DMA_KD
#undef NB_DMA_VD
#undef NB_CMASKD
#undef NB_SHIFT
#undef NB_DMA_V
#undef NB_CMASK
#undef NB_START
#undef NB_RESC
#undef NB_ROT
#undef NB_PKW
#undef NB_PAF
#undef NB_VFR
#undef NB_PIN
#undef NB_MX3
#undef NB_GAPA
#undef NB_EX
#undef NB_GAPB
#undef NB_VRD
#undef NB_KRD
#undef NB_MF
#undef NB_STEP
#undef NB_ENDW
}
}
struct WTask {
    const bf16* Q; int ldq;
    const bf16* gate;
    int pos0, ncw;
    const bf16 *Kc, *Vc; int ncmp;
    const bf16 *Ks, *Vs; int ldks, nsel;
    const bf16 *Kw, *Vw; int ldkw, winbase;
    bf16* O;
};
DI float head_sum8(float x) {
    x += __builtin_bit_cast(float, __builtin_amdgcn_update_dpp(0, __builtin_bit_cast(int, x), 0xB1, 0xF, 0xF, true));
    x += __builtin_bit_cast(float, __builtin_amdgcn_update_dpp(0, __builtin_bit_cast(int, x), 0x4E, 0xF, 0xF, true));
    x += __builtin_bit_cast(float, __builtin_amdgcn_update_dpp(0, __builtin_bit_cast(int, x), 0x141, 0xF, 0xF, true));
    return x;
}
DI void nsa_attend_wg(const WTask& T, const Frame& F) {
    LAS unsigned char* lds = F.lds;
    LAS float* PS = (LAS float*)(lds + 65536 + F.wave * 4096);
    volatile LAS unsigned* UM = (volatile LAS unsigned*)(lds + 98304);
    int lane_ = F.lane; asm volatile("" : "+v"(lane_));
    const int lane = lane_, r = lane & 31, h = lane >> 5, tok = r >> 3, head = r & 7;
    const bool cw = F.wave < T.ncw;
    const int wtok = cw ? 4 * F.wave : 0;
    const int pos0w = T.pos0 + wtok, t = pos0w + tok, tlast = T.pos0 + 4 * T.ncw - 1;
    const int tidl = F.wave * 64 + lane, srow = tidl >> 3, sch = (tidl & 7) ^ ((srow >> 1) & 7);
    const unsigned wbase = (unsigned)F.wave * 1024u;
#define AT_DMA(kp, ldk, vp, ldv, buf) do { \
        __builtin_amdgcn_global_load_lds((const unsigned*)((kp) + (size_t)srow * (ldk) + sch * 8), (LAS unsigned*)(lds + (buf) * 16384 + wbase), 16, 0, 0); \
        __builtin_amdgcn_global_load_lds((const unsigned*)((vp) + (size_t)srow * (ldv) + sch * 8), (LAS unsigned*)(lds + (buf) * 16384 + 8192 + wbase), 16, 0, 0); } while (0)
#define AT_WAITV(n) asm volatile("s_waitcnt vmcnt(" #n ")" ::: "memory")
#define AT_BAR() do { asm volatile("" ::: "memory"); __builtin_amdgcn_s_barrier(); asm volatile("" ::: "memory"); } while (0)
    bf16x8 qf[4];
    { const bf16* qp = T.Q + (size_t)(wtok + tok) * T.ldq + head * 64 + 8 * h;
#pragma unroll
      for (int st = 0; st < 4; ++st) qf[st] = *(const bf16x8*)(qp + 16 * st); }
    float gt[3];
#pragma unroll
    for (int br = 0; br < 3; ++br) gt[br] = sigmoidf_(bf2f(T.gate[(size_t)(wtok + tok) * T.ldq + head * 3 + br]));
    f32x16 out0, out1; for (int e = 0; e < 16; ++e) { out0[e] = 0.f; out1[e] = 0.f; }
    AttnAcc A; attn_reset(A);
    const int nc64 = tlast >= 31 ? ((((tlast - 31) >> 4) >> 6) + 1) : 0;
    for (int i = 0; i < nc64; ++i) AT_DMA(T.Kc + (size_t)i * 64 * 64, 64, T.Vc + (size_t)i * 64 * 64, 64, i);
    for (int n = lane; n < 1024; n += 64) PS[n] = 0.f;
    AT_WAITV(0); LDS_WAIT(); AT_BAR();
    if (cw) {
        float cm = -__builtin_inff(), cl = 0.f;
        const int nmaxl = t >= 31 ? (((t - 31) >> 4) < T.ncmp - 1 ? ((t - 31) >> 4) : T.ncmp - 1) : -1;
        for (int i = 0; i < nc64; ++i) {
            const LAS unsigned char* kt = lds + i * 16384;
            f32x16 s0 = attn_scores(kt, 0, qf, r, h), s1 = attn_scores(kt, 1, qf, r, h);
            attn_mask<false>(s0, nmaxl - 64 * i - 4 * h); attn_mask<false>(s1, nmaxl - 64 * i - 32 - 4 * h);
            float mx = fmaxf(s0[0], s1[0]);
#pragma unroll
            for (int e = 1; e < 16; ++e) mx = fmaxf(mx, fmaxf(s0[e], s1[e]));
            mx = xor32_max(mx) * ATT_C;
            const float mn = fmaxf(cm, mx), mu = (mn == -__builtin_inff()) ? 0.f : mn; float ps = 0.f;
#pragma unroll
            for (int e = 0; e < 16; ++e) ps += __builtin_amdgcn_exp2f(__builtin_fmaf(s0[e], ATT_C, -mu)) + __builtin_amdgcn_exp2f(__builtin_fmaf(s1[e], ATT_C, -mu));
            ps = xor32_sum(ps);
            cl = (cm == -__builtin_inff() ? 0.f : cl * __builtin_amdgcn_exp2f(cm - mn)) + ps; cm = mn;
        }
        const float linv = cl > 0.f ? 1.f / cl : 0.f, cmu = (cm == -__builtin_inff()) ? 0.f : cm;
        for (int i = 0; i < nc64; ++i) {
            const LAS unsigned char* kt = lds + i * 16384;
            f32x16 s0 = attn_scores(kt, 0, qf, r, h), s1 = attn_scores(kt, 1, qf, r, h);
            attn_mask<false>(s0, nmaxl - 64 * i - 4 * h); attn_mask<false>(s1, nmaxl - 64 * i - 32 - 4 * h);
#pragma unroll
            for (int e = 0; e < 16; ++e) { s0[e] = __builtin_amdgcn_exp2f(__builtin_fmaf(s0[e], ATT_C, -cmu)) * linv; s1[e] = __builtin_amdgcn_exp2f(__builtin_fmaf(s1[e], ATT_C, -cmu)) * linv; }
            attn_pv(A, s0, s1, kt + 8192, r, h);
#pragma unroll
            for (int e = 0; e < 16; ++e) { const float pe = head_sum8(s0[e]), pf2 = head_sum8(s1[e]);
                if (head == 0) { PS[tok * 256 + 64 * i + crow(e, h)] = pe; PS[tok * 256 + 64 * i + 32 + crow(e, h)] = pf2; } }
        }
        out0 = A.o0 * gt[0]; out1 = A.o1 * gt[0];
    }
    LDS_WAIT(); __builtin_amdgcn_wave_barrier();
    unsigned long long msk[4] = {0ull, 0ull, 0ull, 0ull};
    if (cw) {
#pragma unroll
        for (int tk = 0; tk < 4; ++tk) {
            const int tt = pos0w + tk, cur = tt >> 6, j = lane;
            float imp = 0.f;
#pragma unroll
            for (int dn = -1; dn <= 3; ++dn) { const int n = 4 * j + dn; if (n >= 0 && n < T.ncmp) imp += PS[tk * 256 + n]; }
            const bool valid = (j <= cur) && (j < T.nsel), forced = (j == 0) || (j == cur) || (j == cur - 1);
            const unsigned key = !valid ? 0u : (forced ? 0xffffffffu : __builtin_bit_cast(unsigned, imp) + 1u);
            unsigned thr = 0u;
#pragma unroll 1
            for (int bit = 31; bit >= 0; --bit) { const unsigned cand = thr | (1u << bit); if (__builtin_popcountll(__ballot(key >= cand)) >= 16) thr = cand; }
            const int need = 16 - __builtin_popcountll(__ballot(key > thr));
            const unsigned long long ties = __ballot(key == thr);
            const bool tie_ok = key == thr && __builtin_popcountll(ties & ((1ull << j) - 1ull)) < need;
            msk[tk] = __ballot(valid && (key > thr || tie_ok));
        }
    }
    { const unsigned long long wu = msk[0] | msk[1] | msk[2] | msk[3];
      if (lane == 0) { UM[2 * F.wave] = (unsigned)wu; UM[2 * F.wave + 1] = (unsigned)(wu >> 32); } }
    LDS_WAIT(); AT_BAR();
    unsigned long long un = 0ull;
#pragma unroll
    for (int w = 0; w < 8; ++w) un |= (unsigned long long)UM[2 * w] | ((unsigned long long)UM[2 * w + 1] << 32);
    un = ((unsigned long long)__builtin_amdgcn_readfirstlane((unsigned)(un >> 32)) << 32) | (unsigned long long)__builtin_amdgcn_readfirstlane((unsigned)un);
    {   int lo = T.pos0 - 512 - T.winbase; lo = lo < 0 ? 0 : lo;
        const int c0 = lo >> 6, nW = ((tlast - T.winbase) >> 6) - c0 + 1;
        int ntw = (nW + 1) & ~1; ntw = ntw < 4 ? 4 : ntw;
        LAS int* tlw = (LAS int*)(lds + nb::LDS_TL);
        { LAS bf16* stg = (LAS bf16*)(lds + nb::LDS_OST + F.wave * 4096) + r * 64 + 4 * h;
#pragma unroll
          for (int q4 = 0; q4 < 4; ++q4) {
              *(LAS u32x2*)(stg + 8 * q4) = (u32x2){pg8::cvt_pk_bf16(out0[4 * q4], out0[4 * q4 + 1]), pg8::cvt_pk_bf16(out0[4 * q4 + 2], out0[4 * q4 + 3])};
              *(LAS u32x2*)(stg + 32 + 8 * q4) = (u32x2){pg8::cvt_pk_bf16(out1[4 * q4], out1[4 * q4 + 1]), pg8::cvt_pk_bf16(out1[4 * q4 + 2], out1[4 * q4 + 3])}; } }
        if (F.wave == 0) for (int i = lane; i < 96; i += 64) tlw[i] = i < nW ? c0 + i : -1;
        asm volatile("s_waitcnt vmcnt(0) lgkmcnt(0)\n\ts_barrier" ::: "memory");
        const int p0w = cw ? pos0w : -(1 << 24);
        nb::ring_unit<8>(0, false, T.Q + (size_t)wtok * T.ldq, T.ldq, T.Kw, T.Vw, T.ldkw, tlw, ntw, T.winbase, p0w, 0ull, 0ull, 0ull, 0ull, T.gate + (size_t)wtok * T.ldq, 2, cw, T.O + (size_t)wtok * DM, (char*)lds);
    }
    { const bf16* qp = T.Q + (size_t)(wtok + tok) * T.ldq + head * 64 + 8 * h; asm volatile("" : "+v"(qp));
#pragma unroll
      for (int st = 0; st < 4; ++st) qf[st] = *(const bf16x8*)(qp + 16 * st); }
    const int nCh = __builtin_popcountll(un);
    unsigned long long rem_i = un, rem_c = un;
#define AT_ISSUE(q) do { const int j_ = __builtin_ctzll(rem_i); rem_i &= rem_i - 1ull; AT_DMA(T.Ks + (size_t)j_ * 64 * T.ldks, T.ldks, T.Vs + (size_t)j_ * 64 * T.ldks, T.ldks, (q) & 3); } while (0)
    for (int q = 0; q < 3 && q < nCh; ++q) AT_ISSUE(q);
    attn_reset(A);
    const unsigned long long mym = tok == 0 ? msk[0] : (tok == 1 ? msk[1] : (tok == 2 ? msk[2] : msk[3]));
    const unsigned long long wany = msk[0] | msk[1] | msk[2] | msk[3];
    for (int i = 0; i < nCh; ++i) {
        const int left = nCh - 1 - i;
        if (left >= 2) AT_WAITV(4); else if (left == 1) AT_WAITV(2); else AT_WAITV(0);
        AT_BAR();
        if (i + 3 < nCh) AT_ISSUE(i + 3);
        const LAS unsigned char* kt = lds + (i & 3) * 16384;
        const int j = __builtin_ctzll(rem_c); rem_c &= rem_c - 1ull;
        if (cw && ((wany >> j) & 1ull) && 64 * j <= pos0w + 3) {
            const bool mine = (mym >> j) & 1ull;
            const bool allv = 64 * j + 63 <= pos0w;
            const int hi = mine ? t - 64 * j - 4 * h : -1;
            attn_chunk<false>(A, kt, qf, hi, mine ? hi - 32 : -1, allv, mine, r, h);
        }
    }
#undef AT_DMA
#undef AT_ISSUE
#undef AT_WAITV
#undef AT_BAR
    if (cw) {
        const float inv = A.l > 0.f ? gt[1] / A.l : 0.f;
        const LAS bf16* stg = (const LAS bf16*)(lds + nb::LDS_OST + F.wave * 4096) + r * 64 + 4 * h;
        bf16* op = T.O + (size_t)(wtok + tok) * DM + head * 64;
#pragma unroll
        for (int q4 = 0; q4 < 4; ++q4) {
            const u32x2 w0 = *(const LAS u32x2*)(stg + 8 * q4), w1 = *(const LAS u32x2*)(stg + 32 + 8 * q4);
            *(u32x2*)(op + 8 * q4 + 4 * h) = (u32x2){pk2(bflo(w0.x) + A.o0[4 * q4] * inv, bfhi(w0.x) + A.o0[4 * q4 + 1] * inv), pk2(bflo(w0.y) + A.o0[4 * q4 + 2] * inv, bfhi(w0.y) + A.o0[4 * q4 + 3] * inv)};
            *(u32x2*)(op + 32 + 8 * q4 + 4 * h) = (u32x2){pk2(bflo(w1.x) + A.o1[4 * q4] * inv, bfhi(w1.x) + A.o1[4 * q4 + 1] * inv), pk2(bflo(w1.y) + A.o1[4 * q4 + 2] * inv, bfhi(w1.y) + A.o1[4 * q4 + 3] * inv)}; }
    }
}
DI void nsa_attention(const P& p, const Frame& F, int li) {
    const bf16* H = (const bf16*)(p.ws + WS_H); bf16* AO = (bf16*)(p.ws + WS_AO);
    constexpr int NT_P = NB * 2 * (SEQ / 32), NT_S = DB * 2;
    for (int id = F.bid; id < NT_P + NT_S; id += F.G) {
        WTask T;
        if (id < NT_P) {
            int g, b, tq; if (F.G == 256) { const int k = id >> 8, w = (id & 255) >> 3; g = id & 1; b = (id & 7) >> 1; tq = k == 0 ? w : (k == 1 ? 63 - w : (k == 2 ? 64 + w : 127 - w)); }
            else { const int q = id >> 1; g = id & 1; b = q >> 7; tq = (b & 1) ? 127 - (q & 127) : (q & 127); }
            const size_t row = (size_t)b * SEQ + 32 * tq;
            T.Q = H + row * NINP + g * 512; T.ldq = NINP; T.gate = H + row * NINP + 1792 + g * 24; T.pos0 = 32 * tq; T.ncw = 8;
            T.Kc = (const bf16*)(p.ws + WS_KC_P) + (size_t)(b * 2 + g) * 256 * 64; T.Vc = (const bf16*)(p.ws + WS_VCT_P) + (size_t)(b * 2 + g) * 256 * 64; T.ncmp = NCMP_P;
            T.Ks = H + (size_t)b * SEQ * NINP + 1280 + g * 64; T.ldks = NINP; T.Vs = H + (size_t)b * SEQ * NINP + 1408 + g * 64; T.nsel = NSEL_P;
            T.Kw = H + (size_t)b * SEQ * NINP + 1536 + g * 64; T.ldkw = NINP; T.Vw = H + (size_t)b * SEQ * NINP + 1664 + g * 64; T.winbase = 0;
            T.O = AO + row * DM + g * 512; }
        else { const int i2 = id - NT_P, g = i2 & 1, b = i2 >> 1; const size_t row = (size_t)MP + b * DS;
            T.Q = H + row * NINP + g * 512; T.ldq = NINP; T.gate = H + row * NINP + 1792 + g * 24; T.pos0 = PAST; T.ncw = 2;
            T.Kc = (const bf16*)(p.ws + WS_KC_S) + (size_t)(b * 2 + g) * 128 * 64; T.Vc = (const bf16*)(p.ws + WS_VCT_S) + (size_t)(b * 2 + g) * 128 * 64; T.ncmp = NCMP_S;
            T.Ks = (const bf16*)(p.ws + WS_KSLC_S + li * SZ_SLC_S) + (size_t)(b * 2 + g) * SLC_S_ROWS * 64; T.ldks = 64; T.Vs = (const bf16*)(p.ws + WS_VSLCT_S + li * SZ_SLC_S) + (size_t)(b * 2 + g) * SLC_S_ROWS * 64; T.nsel = NSEL_S;
            T.Kw = (const bf16*)(p.ws + WS_KWIN_S + li * SZ_WIN_S) + (size_t)(b * 2 + g) * WIN_S_ROWS * 64; T.ldkw = 64; T.Vw = (const bf16*)(p.ws + WS_VWINT_S + li * SZ_WIN_S) + (size_t)(b * 2 + g) * WIN_S_ROWS * 64; T.winbase = PAST - 512;
            T.O = AO + row * DM + g * 512; }
        nsa_attend_wg(T, F);
        __syncthreads();
    }
}

DI void small_gemm_resid(const Frame& F, const bf16* A, const bf16* Bt, int K, float* X) {
    LAS unsigned char* lds = F.lds; LAS float* red = (LAS float*)(F.lds + 98304);
    const int r = F.lane & 31, h = F.lane >> 5, mi = F.wave & 1, ni = (F.wave >> 1) & 1, kh = F.wave >> 2, nst = K >> 7;
    const int p0 = F.tid, p1 = F.tid + 512;
    const int r0 = p0 >> 4, c0 = (p0 & 15) ^ (r0 & 15), r1 = p1 >> 4, c1 = (p1 & 15) ^ (r1 & 15);
    const unsigned wb = (unsigned)F.wave * 1024u;
    for (int tile = F.bid; tile < 256; tile += F.G) {
        const int row0 = MP + (tile >> 4) * 64, col0 = (tile & 15) * 64;
        const bf16* a0 = A + (size_t)(row0 + r0) * K + c0 * 8; const bf16* a1 = A + (size_t)(row0 + r1) * K + c1 * 8;
        const bf16* b0 = Bt + (size_t)(col0 + r0) * K + c0 * 8; const bf16* b1 = Bt + (size_t)(col0 + r1) * K + c1 * 8;
#define SG_DMA(s_) do { const int k_ = (s_) * 128; LAS unsigned char* d_ = lds + ((s_) % 3) * 32768 + wb; \
        __builtin_amdgcn_global_load_lds((const unsigned*)(a0 + k_), (LAS unsigned*)d_, 16, 0, 0); __builtin_amdgcn_global_load_lds((const unsigned*)(a1 + k_), (LAS unsigned*)(d_ + 8192), 16, 0, 0); \
        __builtin_amdgcn_global_load_lds((const unsigned*)(b0 + k_), (LAS unsigned*)(d_ + 16384), 16, 0, 0); __builtin_amdgcn_global_load_lds((const unsigned*)(b1 + k_), (LAS unsigned*)(d_ + 24576), 16, 0, 0); } while (0)
        f32x16 acc;
        if (kh == 0) {
#pragma unroll
            for (int e = 0; e < 16; ++e) acc[e] = X[(size_t)(row0 + 32 * mi + crow(e, h)) * DM + col0 + 32 * ni + r]; }
        else for (int e = 0; e < 16; ++e) acc[e] = 0.f;
        SG_DMA(0); if (nst > 1) SG_DMA(1);
        for (int s = 0; s < nst; ++s) {
            asm volatile("" ::: "memory");
            if (s + 1 < nst) __builtin_amdgcn_s_waitcnt(0x0F74); else __builtin_amdgcn_s_waitcnt(0x0F70);
            asm volatile("" ::: "memory"); __builtin_amdgcn_s_barrier(); asm volatile("" ::: "memory");
            if (s + 2 < nst) SG_DMA(s + 2);
            const LAS unsigned char* ia = lds + (s % 3) * 32768; const LAS unsigned char* ib = ia + 16384;
            const int ra = 32 * mi + r, rb = 32 * ni + r;
#pragma unroll
            for (int u = 0; u < 4; ++u) { const int ch = 8 * kh + 2 * u + h;
                acc = MFMA32(*(const LAS bf16x8*)(ia + ra * 256 + ((ch ^ (ra & 15)) << 4)), *(const LAS bf16x8*)(ib + rb * 256 + ((ch ^ (rb & 15)) << 4)), acc); }
        }
#undef SG_DMA
        if (kh == 1) {
#pragma unroll
            for (int e = 0; e < 16; ++e) red[((F.wave & 3) * 16 + e) * 64 + F.lane] = acc[e]; }
        __syncthreads();
        if (kh == 0) {
#pragma unroll
            for (int e = 0; e < 16; ++e) { float* xp = X + (size_t)(row0 + 32 * mi + crow(e, h)) * DM + col0 + 32 * ni + r; *xp = acc[e] + red[((F.wave & 3) * 16 + e) * 64 + F.lane]; } }
        __syncthreads();
    }
}

DI P load_ptrs(LAS unsigned char* lds) {
    unsigned off = PTAB_OFF; asm volatile("" : "+s"(off));
    const LAS unsigned* t = (const LAS unsigned*)(lds + off);
    P q;
#pragma unroll
    for (int k = 0; k < 28; ++k) { const unsigned lo = __builtin_amdgcn_readfirstlane(t[2 * k]), hi = __builtin_amdgcn_readfirstlane(t[2 * k + 1]);
        void* v = (void*)(GAS char*)(((unsigned long long)hi << 32) | lo);
        if (k < 26) q.in[k] = v; else if (k == 26) q.out = (float*)v; else q.ws = (unsigned char*)v; }
    return q;
}
__global__ void __launch_bounds__(512, 2) hybrid_fwd(P parg) {
    extern __shared__ __attribute__((aligned(16))) unsigned char lds_raw[];
    Frame F;
    F.lds = (LAS unsigned char*)lds_raw; F.tid = threadIdx.x; F.lane = F.tid & 63; F.wave = __builtin_amdgcn_readfirstlane(F.tid >> 6);
    F.bid = blockIdx.x; F.G = gridDim.x; F.gw = F.bid * 8 + F.wave; F.ngw = F.G * 8;
    volatile LAS unsigned* MISC = (volatile LAS unsigned*)(F.lds + MISC_OFF);
    for (int u = F.tid; u < (LDS_BYTES - RING_BYTES) / 4; u += 512) ((LAS unsigned*)(F.lds + RING_BYTES))[u] = 0u;
    __syncthreads();
    if (F.tid < 28) { const void* v = F.tid < 26 ? parg.in[F.tid] : (F.tid == 26 ? (const void*)parg.out : (const void*)parg.ws);
        const unsigned long long w = (unsigned long long)v; LAS unsigned* t = (LAS unsigned*)(F.lds + PTAB_OFF); t[2 * F.tid] = (unsigned)w; t[2 * F.tid + 1] = (unsigned)(w >> 32); }
    __syncthreads();
    XcdBarrier bar = xcd_barrier_post((unsigned*)(parg.ws + WS_CTL) + CW_BAR, MISC + 8);
#define REFRESH() do { int t_ = threadIdx.x, b_ = __builtin_amdgcn_readfirstlane(F.bid), g_ = __builtin_amdgcn_readfirstlane(F.G); asm volatile("" : "+v"(t_), "+s"(b_), "+s"(g_)); F.tid = t_; F.lane = t_ & 63; F.wave = __builtin_amdgcn_readfirstlane(t_ >> 6); F.bid = b_; F.G = g_; F.gw = b_ * 8 + F.wave; F.ngw = g_ * 8; } while (0)
#define GRID_BAR() do { xcd_barrier(bar); REFRESH(); } while (0)
#define PH(...) do { const P p = load_ptrs(F.lds); unsigned char* ws = p.ws; (void)ws; __VA_ARGS__ } while (0)
    PH( p0_cbias(p, F); );
    PH( p0_weights(p, F, 0); );
    PH( rms_phase<0>(p, F, (const float*)p.in[7]); );
    GRID_BAR();
#define LAYER_BODY(layer) { const int li = (layer) >> 1;  \
        if ((layer & 1) == 0) { \
            PH( pg8::Gemm g{DM, DM, 128}; pg8::StaticOrder S; S.init(M, GINP, F.G, F.bid, ws + WS_XN, ws + WS_WG_IN + li * SZ_WG_IN, ws + WS_H, DM, DM); \
                pg8::EpiBf16 E{GINP}; pg8::gemm_phase(F.lds, g, S, E); ); \
            GRID_BAR(); \
            PH( gdn_prep(p, F, li); ); \
            GRID_BAR(); \
            PH( gdn_chunk(p, F, li); ); \
            GRID_BAR(); \
            PH( if (F.G > 64) { if (F.bid < 64) gdn_scan(p, F, li, (((F.bid & 7) + 8 * (F.bid >> 4)) << 1) | ((F.bid >> 3) & 1)); else {     for (int task = F.bid - 64; task < DB * GH; task += F.G - 64) gdn_sample(p, F, li, task); Frame F2 = F; F2.bid = F.bid - 64; F2.G = F.G - 64; F2.gw = F2.bid * 8 + F.wave; F2.ngw = F2.G * 8; p0_cache_win(p, F2, li); if (li == 0) p0_weights(p, F2, 1); } } \
                else { for (int sid = F.bid; sid < 64; sid += F.G) { gdn_scan(p, F, li, sid); __syncthreads(); } for (int task = F.bid; task < DB * GH; task += F.G) gdn_sample(p, F, li, task); p0_cache_win(p, F, li); if (li == 0) p0_weights(p, F, 1); } ); \
            GRID_BAR(); \
            PH( gdn_gate(p, F, li); if (layer == 0) p0_cbias2(p, F); ); \
            GRID_BAR(); \
        } else { \
            PH( pg8::Gemm g{DM, DM, 128}; pg8::StaticOrder S; S.init(M, NINP, F.G, F.bid, ws + WS_XN, ws + WS_WN_IN + li * SZ_WN_IN, ws + WS_H, DM, DM); \
                pg8::EpiNsaIn E{(bf16*)(ws + WS_H), p.out, (bf16*)(ws + WS_CMPP), li}; pg8::gemm_phase(F.lds, g, S, E); \
                if (F.G > 32 && F.bid >= 32) { pg8::Gemm g2{1024, 4096, 512}; CmpOrder S2{F.G - 32, F.bid - 32, li, ws, 320, 224}; pg8::EpiBf16 E2{512}; pg8::gemm_phase(F.lds, g2, S2, E2); } ); \
            GRID_BAR(); \
            PH( nsa_transpose(p, F, li); ); \
            __syncthreads(); REFRESH(); \
            PH( pg8::Gemm g{1024, 4096, 512}; CmpOrder S{F.G, F.bid, li, ws, 0, F.G > 32 ? 320 : 544}; pg8::EpiBf16 E{512}; pg8::gemm_phase(F.lds, g, S, E); ); \
            GRID_BAR(); \
            PH( nsa_cmp2(p, F, li); ); \
            GRID_BAR(); \
            PH( nsa_attention(p, F, li); ); \
            GRID_BAR(); \
        } \
        PH( const bf16* Wout = (const bf16*)(ws + ((layer & 1) ? WS_WN_OUT : WS_WG_OUT) + li * SZ_W1K); \
            pg8::Gemm g{DM, DM, 128}; pg8::StaticOrder S; S.init(MP, DM, F.G, F.bid, ws + WS_AO, Wout, nullptr, DM, DM); \
            pg8::EpiResid E{(float*)(ws + WS_X)}; pg8::gemm_phase(F.lds, g, S, E); small_gemm_resid(F, (const bf16*)(ws + WS_AO), Wout, DM, (float*)(ws + WS_X)); ); \
        GRID_BAR(); \
        PH( rms_phase<1>(p, F, (const float*)p.in[8] + layer * DM); ); \
        GRID_BAR(); \
        PH( pg8::Gemm g{DM, DM, 128}; pg8::StaticOrder S; S.init(M, FF2, F.G, F.bid, ws + WS_XN, ws + WS_WF_IN + layer * SZ_WF_IN, nullptr, DM, DM); \
            pg8::EpiSwiglu E{(bf16*)(ws + WS_FFH), FF}; pg8::gemm_phase(F.lds, g, S, E); ); \
        GRID_BAR(); \
        PH( pg8::Gemm g{FF, FF, 128}; pg8::StaticOrder S; S.init(MP, DM, F.G, F.bid, ws + WS_FFH, ws + WS_WF_OUT + layer * SZ_WF_OUT, nullptr, FF, FF); \
            pg8::EpiResid E{(float*)(ws + WS_X)}; pg8::gemm_phase(F.lds, g, S, E); small_gemm_resid(F, (const bf16*)(ws + WS_FFH), (const bf16*)(ws + WS_WF_OUT + layer * SZ_WF_OUT), FF, (float*)(ws + WS_X)); ); \
        GRID_BAR(); \
        if (layer < 3) { PH( rms_phase<1>(p, F, (const float*)p.in[7] + (layer + 1) * DM); ); GRID_BAR(); } \
     }
    LAYER_BODY(0)
    LAYER_BODY(1)
    LAYER_BODY(2)
    LAYER_BODY(3)
    PH( rms_phase<2>(p, F, (const float*)p.in[9]); );
}

extern "C" void kernel_launch(void* const* d_in, const int* in_sizes, int n_in, void* d_out, int out_size, void* d_ws, size_t ws_size, hipStream_t stream) {
    static int grid = 0;
    if (grid == 0) {
        if (n_in != 26 || ws_size < WS_END) { fprintf(stderr, "kernel_launch: unexpected n_in %d or ws_size %zu (< %zu)\n", n_in, ws_size, (size_t)WS_END); grid = -1; return; }
        int dev = 0, cus = 0, per_cu = 0;
        if (hipGetDevice(&dev) != hipSuccess || hipDeviceGetAttribute(&cus, hipDeviceAttributeMultiprocessorCount, dev) != hipSuccess) { grid = -1; return; }
        if (hipFuncSetAttribute((const void*)hybrid_fwd, hipFuncAttributeMaxDynamicSharedMemorySize, LDS_BYTES) != hipSuccess) { fprintf(stderr, "kernel_launch: hipFuncSetAttribute failed\n"); grid = -1; return; }
        if (hipOccupancyMaxActiveBlocksPerMultiprocessor(&per_cu, (const void*)hybrid_fwd, 512, LDS_BYTES) != hipSuccess || per_cu < 1) fprintf(stderr, "kernel_launch: occupancy query says %d\n", per_cu);
        (void)hipGetLastError();
        grid = cus;
    }
    if (grid < 0) return;
    (void)in_sizes; (void)out_size;
    (void)hipMemsetAsync((char*)d_ws + WS_CTL, 0, CTL_BYTES, stream);
    P p{};
    for (int i = 0; i < 26; ++i) p.in[i] = d_in[i];
    p.out = (float*)d_out; p.ws = (unsigned char*)d_ws;
    hipLaunchKernelGGL(hybrid_fwd, dim3(grid), dim3(512), LDS_BYTES, stream, p);
}
```
